# Optimizing an MI355X kernel written in HIP

```python
import jax, jax.numpy as jnp
from jax import lax
import numpy as np

D_MODEL = 1024
BATCH = 16
SEQ = 2048
DEPTH = 1

HEAD_DIM = 64
N_Q_HEADS = 8
N_KV_HEADS = 2
GROUP = N_Q_HEADS // N_KV_HEADS
ATTN_WIDTH = N_Q_HEADS * HEAD_DIM
KV_WIDTH = N_KV_HEADS * HEAD_DIM
WINDOW = 128
BLOCK = 128
ROPE_THETA = 10000.0
LRU_WIDTH = D_MODEL // 2
LRU_HEADS = 8
LRU_BLOCK = LRU_WIDTH // LRU_HEADS
LRU_C = 8.0
CONV_WIDTH = 4
N_EXPERTS = 32
TOP_K = 4
D_EXPERT = D_MODEL
SWIGLU_LIMIT = 7.0
SWIGLU_ALPHA = 1.702
MOE_CHUNK = 128
NORM_EPS = 1e-6
NEG_INF = -1e30
IN_SPLITS = (ATTN_WIDTH, KV_WIDTH, KV_WIDTH, LRU_WIDTH, LRU_WIDTH, D_MODEL, D_MODEL)
IN_WIDTH = sum(IN_SPLITS)

kernel_name = "hybrid_swa_sink_rglru_moe_block"


def rmsnorm(x, g):
    x32 = x.astype(jnp.float32)
    y = x32 * lax.rsqrt(jnp.mean(x32 * x32, axis=-1, keepdims=True) + NORM_EPS)
    return (y * g.astype(jnp.float32)).astype(x.dtype)


def split_cols(p):
    outs, o = [], 0
    for w in IN_SPLITS:
        outs.append(p[..., o:o + w])
        o += w
    return outs


def rope(t, positions):
    hd = t.shape[-1]
    inv_freq = 1.0 / (ROPE_THETA ** (jnp.arange(0, hd, 2, dtype=jnp.float32) / hd))
    ang = positions[..., None].astype(jnp.float32) * inv_freq
    cos = jnp.cos(ang)[:, :, None, :]
    sin = jnp.sin(ang)[:, :, None, :]
    t32 = t.astype(jnp.float32)
    t1, t2 = t32[..., :hd // 2], t32[..., hd // 2:]
    out = jnp.concatenate([t1 * cos - t2 * sin, t2 * cos + t1 * sin], axis=-1)
    return out.astype(t.dtype)


def sliding_window_attention(q, k, v, sinks):
    bsz, s = q.shape[0], q.shape[1]
    nb = s // BLOCK
    qb = q.reshape(bsz, nb, BLOCK, N_KV_HEADS, GROUP, HEAD_DIM)

    def with_prev(t):
        tb = t.reshape(bsz, nb, BLOCK, N_KV_HEADS, HEAD_DIM)
        prev = jnp.concatenate([jnp.zeros_like(tb[:, :1]), tb[:, :-1]], axis=1)
        return jnp.concatenate([prev, tb], axis=2)

    kk, vv = with_prev(k), with_prev(v)
    scores = jnp.einsum('bnqhgd,bnkhd->bhgnqk', qb, kk).astype(jnp.float32) * (HEAD_DIM ** -0.5)
    blk = jnp.arange(nb)[:, None, None]
    qpos = blk * BLOCK + jnp.arange(BLOCK)[None, :, None]
    kpos = (blk - 1) * BLOCK + jnp.arange(2 * BLOCK)[None, None, :]
    diff = qpos - kpos
    mask = (diff >= 0) & (diff < WINDOW) & (kpos >= 0)
    scores = jnp.where(mask, scores, NEG_INF)
    sink = sinks.astype(jnp.float32).reshape(N_KV_HEADS, GROUP)[None, :, :, None, None, None]
    m = jnp.maximum(jnp.max(scores, axis=-1, keepdims=True), sink)
    p = jnp.exp(scores - m)
    p = p / (jnp.sum(p, axis=-1, keepdims=True) + jnp.exp(sink - m))
    o = jnp.einsum('bhgnqk,bnkhd->bnqhgd', p.astype(v.dtype), vv)
    return o.reshape(bsz, s, ATTN_WIDTH)


def causal_depthwise_conv(xr, w, b):
    y = lax.conv_general_dilated(xr, w[:, None, :].astype(xr.dtype), window_strides=(1,),
                                 padding=[(CONV_WIDTH - 1, 0)],
                                 dimension_numbers=('NWC', 'WIO', 'NWC'),
                                 feature_group_count=LRU_WIDTH)
    return y + b


def rg_lru(xb, w_rg, b_rg, w_ig, b_ig, lam):
    bsz, s, _ = xb.shape
    x32 = xb.astype(jnp.float32)
    xh = x32.reshape(bsz, s, LRU_HEADS, LRU_BLOCK)
    r = jax.nn.sigmoid(jnp.einsum('bshi,hij->bshj', xh, w_rg.astype(jnp.float32)).reshape(bsz, s, LRU_WIDTH) + b_rg.astype(jnp.float32))
    i = jax.nn.sigmoid(jnp.einsum('bshi,hij->bshj', xh, w_ig.astype(jnp.float32)).reshape(bsz, s, LRU_WIDTH) + b_ig.astype(jnp.float32))
    log_a = -LRU_C * r * jax.nn.softplus(-lam.astype(jnp.float32))
    a = jnp.exp(log_a)
    u = jnp.sqrt(-jnp.expm1(2.0 * log_a)) * (i * x32)

    def combine(c1, c2):
        a1, b1 = c1
        a2, b2 = c2
        return a1 * a2, a2 * b1 + b2

    _, h = lax.associative_scan(combine, (a, u), axis=1)
    return h.astype(xb.dtype)


def mixer(h, positions, w_in, conv_w, conv_b, w_rg, b_rg, w_ig, b_ig, lru_lambda,
          attn_sinks, w_attn_o, w_lru_o, w_out):
    bsz, s, _ = h.shape
    q, k, v, xr, yr, ga, gl = split_cols(h @ w_in)
    q = rope(q.reshape(bsz, s, N_Q_HEADS, HEAD_DIM), positions)
    k = rope(k.reshape(bsz, s, N_KV_HEADS, HEAD_DIM), positions)
    v = v.reshape(bsz, s, N_KV_HEADS, HEAD_DIM)
    y_attn = sliding_window_attention(q, k, v, attn_sinks) @ w_attn_o
    xr = causal_depthwise_conv(xr, conv_w, conv_b)
    y_lru = (rg_lru(xr, w_rg, b_rg, w_ig, b_ig, lru_lambda) * jax.nn.gelu(yr)) @ w_lru_o
    merged = jax.nn.sigmoid(ga) * y_attn + jax.nn.sigmoid(gl) * y_lru
    return merged @ w_out


def moe(h, w_router, b_router, w_gate_up, b_gate_up, w_down, b_down):
    bsz, s, d = h.shape
    n = bsz * s
    t = h.reshape(n, d)
    logits = (t @ w_router + b_router).astype(jnp.float32)
    top_val, top_idx = lax.top_k(logits, TOP_K)
    gate = jax.nn.softmax(top_val, axis=-1)
    nk = n * TOP_K
    flat_e = top_idx.reshape(-1).astype(jnp.int32)
    flat_tok = jnp.repeat(jnp.arange(n, dtype=jnp.int32), TOP_K)
    flat_w = gate.reshape(-1)
    order = jnp.argsort(flat_e)
    se = flat_e[order]
    counts = jnp.zeros((N_EXPERTS,), jnp.int32).at[flat_e].add(1)
    starts = jnp.cumsum(counts) - counts
    pcounts = (counts + MOE_CHUNK - 1) // MOE_CHUNK * MOE_CHUNK
    pends = jnp.cumsum(pcounts)
    pstarts = pends - pcounts
    dest = pstarts[se] + (jnp.arange(nk, dtype=jnp.int32) - starts[se])
    n_chunks = -(-nk // MOE_CHUNK) + N_EXPERTS
    n_slots = n_chunks * MOE_CHUNK
    slot_tok = jnp.zeros((n_slots,), jnp.int32).at[dest].set(flat_tok[order])
    slot_w = jnp.zeros((n_slots,), jnp.float32).at[dest].set(flat_w[order])
    chunk_start = jnp.arange(n_chunks, dtype=jnp.int32) * MOE_CHUNK
    chunk_e = jnp.clip(jnp.searchsorted(pends, chunk_start, side='right'), 0, N_EXPERTS - 1)
    xs = t[slot_tok].reshape(n_chunks, MOE_CHUNK, d)

    def expert_block(args):
        xc, e = args
        gu = xc @ w_gate_up[e] + b_gate_up[e]
        g, u = gu[:, :D_EXPERT], gu[:, D_EXPERT:]
        g = jnp.minimum(g, SWIGLU_LIMIT)
        u = jnp.clip(u, -SWIGLU_LIMIT, SWIGLU_LIMIT)
        act = (u + 1.0) * (g * jax.nn.sigmoid(SWIGLU_ALPHA * g))
        return act @ w_down[e] + b_down[e]

    ys = lax.map(expert_block, (xs, chunk_e)).reshape(n_slots, d)
    out = jnp.zeros((n, d), jnp.float32).at[slot_tok].add(ys.astype(jnp.float32) * slot_w[:, None])
    return out.astype(h.dtype).reshape(bsz, s, d)


def setup_inputs(seed: int = 0) -> dict:
    key = jax.random.key(seed)
    ks = jax.random.split(key, 24)
    f32 = jnp.float32
    nrm = lambda k, shape, scale: jax.random.normal(k, shape, f32) * scale
    a0 = jax.random.uniform(ks[9], (DEPTH, LRU_WIDTH), f32, 0.9, 0.999)
    s0 = a0 ** (1.0 / LRU_C)
    lru_lambda = jnp.log(s0) - jnp.log1p(-s0)
    return {
        "x": nrm(ks[0], (BATCH, SEQ, D_MODEL), 1.0),
        "positions": jnp.broadcast_to(jnp.arange(SEQ, dtype=jnp.int32), (BATCH, SEQ)),
        "norm_mix_g": 1.0 + nrm(ks[1], (DEPTH, D_MODEL), 0.02),
        "w_in": nrm(ks[2], (DEPTH, D_MODEL, IN_WIDTH), D_MODEL ** -0.5),
        "conv_w": nrm(ks[3], (DEPTH, CONV_WIDTH, LRU_WIDTH), CONV_WIDTH ** -0.5),
        "conv_b": nrm(ks[4], (DEPTH, LRU_WIDTH), 0.01),
        "w_rg": nrm(ks[5], (DEPTH, LRU_HEADS, LRU_BLOCK, LRU_BLOCK), LRU_BLOCK ** -0.5),
        "b_rg": nrm(ks[6], (DEPTH, LRU_WIDTH), 0.01),
        "w_ig": nrm(ks[7], (DEPTH, LRU_HEADS, LRU_BLOCK, LRU_BLOCK), LRU_BLOCK ** -0.5),
        "b_ig": nrm(ks[8], (DEPTH, LRU_WIDTH), 0.01),
        "lru_lambda": lru_lambda,
        "attn_sinks": nrm(ks[10], (DEPTH, N_Q_HEADS), 0.5),
        "w_attn_o": nrm(ks[11], (DEPTH, ATTN_WIDTH, D_MODEL), ATTN_WIDTH ** -0.5),
        "w_lru_o": nrm(ks[12], (DEPTH, LRU_WIDTH, D_MODEL), LRU_WIDTH ** -0.5),
        "w_out": nrm(ks[13], (DEPTH, D_MODEL, D_MODEL), D_MODEL ** -0.5),
        "norm_ffn_g": 1.0 + nrm(ks[14], (DEPTH, D_MODEL), 0.02),
        "w_router": nrm(ks[15], (DEPTH, D_MODEL, N_EXPERTS), D_MODEL ** -0.5),
        "b_router": nrm(ks[16], (DEPTH, N_EXPERTS), 0.01),
        "w_gate_up": nrm(ks[17], (DEPTH, N_EXPERTS, D_MODEL, 2 * D_EXPERT), D_MODEL ** -0.5),
        "b_gate_up": nrm(ks[18], (DEPTH, N_EXPERTS, 2 * D_EXPERT), 0.01),
        "w_down": nrm(ks[19], (DEPTH, N_EXPERTS, D_EXPERT, D_MODEL), D_EXPERT ** -0.5),
        "b_down": nrm(ks[20], (DEPTH, N_EXPERTS, D_MODEL), 0.01),
        "norm_final_g": 1.0 + nrm(ks[21], (D_MODEL,), 0.02),
    }


def reference(x, positions, norm_mix_g, w_in, conv_w, conv_b, w_rg, b_rg, w_ig, b_ig,
              lru_lambda, attn_sinks, w_attn_o, w_lru_o, w_out, norm_ffn_g, w_router,
              b_router, w_gate_up, b_gate_up, w_down, b_down, norm_final_g):
    for l in range(DEPTH):
        h = rmsnorm(x, norm_mix_g[l])
        x = x + mixer(h, positions, w_in[l], conv_w[l], conv_b[l], w_rg[l], b_rg[l],
                      w_ig[l], b_ig[l], lru_lambda[l], attn_sinks[l], w_attn_o[l],
                      w_lru_o[l], w_out[l])
        h = rmsnorm(x, norm_ffn_g[l])
        x = x + moe(h, w_router[l], b_router[l], w_gate_up[l], b_gate_up[l],
                    w_down[l], b_down[l])
    return rmsnorm(x, norm_final_g)
```

```cpp
#include <hip/hip_runtime.h>
#include <stdint.h>
#include <stdio.h>

typedef unsigned short bf16_t;
typedef unsigned u32x4 __attribute__((ext_vector_type(4)));

constexpr int NB = 16, SEQ = 2048, NTOK = NB * SEQ, DM = 1024;
constexpr int NQH = 8, NKVH = 2, HD = 64, AW = 512, KVW = 128, LW = 512, LH = 8, LB = 64;
constexpr int INW = 3840, NE = 32, TOPK = 4, DE = 1024;
constexpr int CAP = NTOK;
constexpr int MAXTILES = NTOK * TOPK / 256 + NE;
constexpr int MAXROWS = MAXTILES * 256;

constexpr size_t MiB = 1u << 20;
constexpr size_t WS_CTL = 0, CTL_BYTES = 1 * MiB;
constexpr size_t WS_WRG = 1 * MiB;
constexpr size_t WS_WIG = WS_WRG + 65536;
constexpr size_t WS_TOKE = 2 * MiB;
constexpr size_t WS_TOKW = 2 * MiB + 512 * 1024;
constexpr size_t WS_TOKP = 3 * MiB;
constexpr size_t WS_SLOT = 4 * MiB;
constexpr size_t WS_LOGIT = 8 * MiB;
constexpr size_t WS_RSTD = 12 * MiB;
constexpr size_t WS_WIN = 16 * MiB;
constexpr size_t WS_WCAT = 24 * MiB;
constexpr size_t WS_WOUT = 26 * MiB;
constexpr size_t WS_WGU = 28 * MiB;
constexpr size_t WS_WD = 156 * MiB;
constexpr size_t WS_X1 = 220 * MiB;
constexpr size_t WS_H2 = 348 * MiB;
constexpr size_t WS_ACT = 412 * MiB;
constexpr size_t WS_Y = 684 * MiB;
constexpr size_t WS_H = 412 * MiB;
constexpr size_t WS_Q = 476 * MiB;
constexpr size_t WS_K = 508 * MiB;
constexpr size_t WS_V = 516 * MiB;
constexpr size_t WS_XR = 524 * MiB;
constexpr size_t WS_YG = 556 * MiB;
constexpr size_t WS_RATIO = 588 * MiB;
constexpr size_t WS_GLS = 652 * MiB;
constexpr size_t WS_AO = 716 * MiB;
constexpr size_t WS_MERGED = 780 * MiB;
constexpr size_t WS_XC = 844 * MiB;
constexpr size_t WS_END = 956 * MiB;
constexpr int CW_GCOUNT = 8192;

__device__ __forceinline__ float bf2f(bf16_t b) { return __uint_as_float(((unsigned)b) << 16); }
__device__ __forceinline__ bf16_t f2bf(float f) { return __builtin_bit_cast(unsigned short, (__bf16)f); }
__device__ __forceinline__ float sigmoidf_(float x) { return 1.0f / (1.0f + __expf(-x)); }
__device__ __forceinline__ float gelu_tanh(float x) { const float u = 0.7978845608028654f * (x + 0.044715f * x * x * x); return 0.5f * x * (1.0f + tanhf(u)); }

__host__ __device__ __forceinline__ int g1_orig(int g) {
    const int tile = g >> 8, w = g & 255, bj = w >> 7, wc = (w >> 5) & 3, j = w & 31;
    if (tile < 2) return tile * 256 + wc * 64 + bj * 32 + j;
    if (tile == 2) return wc < 2 ? 512 + wc * 64 + bj * 32 + j : 640 + (wc - 2) * 64 + bj * 32 + j;
    if (tile < 5) return 768 + (tile - 3) * 256 + w;
    if (tile < 7) return 1280 + (tile - 5) * 256 + w;
    const int t = tile - 7; return (bj ? 2816 : 1792) + 128 * t + (w & 127);
}
__host__ __device__ __forceinline__ int gu_orig(int g) { const int tile = g >> 8, w = g & 255, bj = w >> 7; return bj * 1024 + tile * 128 + (w & 127); }

__device__ __forceinline__ float dot_bf16(const bf16_t* a, const bf16_t* b, int K) {
    float s = 0.f;
    for (int k = 0; k < K; k += 8) {
        const u32x4 av = *(const u32x4*)(a + k), bv = *(const u32x4*)(b + k);
#pragma unroll
        for (int j = 0; j < 4; ++j) {
            s += __uint_as_float(av[j] << 16) * __uint_as_float(bv[j] << 16);
            s += __uint_as_float(av[j] & 0xffff0000u) * __uint_as_float(bv[j] & 0xffff0000u);
        }
    }
    return s;
}
__device__ __forceinline__ float wave_sum(float v) {
#pragma unroll
    for (int o = 1; o < 64; o <<= 1) v += __shfl_xor(v, o);
    return v;
}

#define GSTRIDE(i, n) for (size_t i = (size_t)blockIdx.x * blockDim.x + threadIdx.x; i < (size_t)(n); i += (size_t)gridDim.x * blockDim.x)

__global__ void __launch_bounds__(256) nv_transpose(const float* W, int K, int N, bf16_t* dst, int ldd, int koff, int Ng, int mode, int batch) {
    GSTRIDE(idx, (size_t)batch * Ng * K) {
        const int k = (int)(idx % K); const int g = (int)((idx / K) % Ng); const int b = (int)(idx / ((size_t)K * Ng));
        const int o = mode == 1 ? g1_orig(g) : mode == 2 ? gu_orig(g) : g;
        dst[(size_t)b * Ng * ldd + (size_t)g * ldd + koff + k] = f2bf(W[(size_t)b * K * N + (size_t)k * N + o]);
    }
}
__global__ void __launch_bounds__(256) nv_rmsnorm_bf16(const float* x, const float* g, bf16_t* out, float* rstd_out) {
    const int lane = threadIdx.x & 63; const int w = (blockIdx.x * blockDim.x + threadIdx.x) >> 6, nw = (gridDim.x * blockDim.x) >> 6;
    for (int m = w; m < NTOK; m += nw) {
        const float* xr = x + (size_t)m * DM; float v[16]; float s = 0.f;
#pragma unroll
        for (int j = 0; j < 16; ++j) { v[j] = xr[lane + 64 * j]; s += v[j] * v[j]; }
        const float r = rsqrtf(wave_sum(s) * (1.0f / DM) + 1e-6f);
#pragma unroll
        for (int j = 0; j < 16; ++j) out[(size_t)m * DM + lane + 64 * j] = f2bf(v[j] * r * g[lane + 64 * j]);
        if (rstd_out && lane == 0) rstd_out[m] = r;
    }
}
__device__ __forceinline__ void rope_cs(int pos, int j, float& c, float& s) {
    const float inv = exp2f(-(float)j * (13.287712379549449f / 32.0f));
    const double rev = (double)pos * (double)inv * 0.15915494309189535;
    const float fr = (float)(rev - floor(rev));
    s = __builtin_amdgcn_sinf(fr); c = __builtin_amdgcn_cosf(fr);
}
__global__ void __launch_bounds__(256) nv_gemm1(const bf16_t* h, const bf16_t* Wt, const int* positions, bf16_t* q, bf16_t* k, bf16_t* v, bf16_t* xr, bf16_t* yg, bf16_t* ratio, bf16_t* gls) {
    GSTRIDE(idx, (size_t)NTOK * 15 * 128) {
        const int r = (int)(idx % 128), tile = (int)((idx / 128) % 15), m = (int)(idx / (128 * 15));
        const int g0 = tile * 256 + r, g1 = g0 + 128;
        const float v0 = dot_bf16(h + (size_t)m * DM, Wt + (size_t)g0 * DM, DM), v1 = dot_bf16(h + (size_t)m * DM, Wt + (size_t)g1 * DM, DM);
        const int wc = r >> 5, j = r & 31;
        if (tile < 2 || (tile == 2 && wc < 2)) {
            float c, s; rope_cs(positions[m], j, c, s);
            const float o0 = v0 * c - v1 * s, o1 = v1 * c + v0 * s;
            if (tile < 2) { const int hq = tile * 4 + wc; q[(size_t)m * AW + hq * 64 + j] = f2bf(o0); q[(size_t)m * AW + hq * 64 + 32 + j] = f2bf(o1); }
            else { k[(size_t)m * KVW + wc * 64 + j] = f2bf(o0); k[(size_t)m * KVW + wc * 64 + 32 + j] = f2bf(o1); }
        } else if (tile == 2) { const int hv = wc - 2; v[(size_t)m * KVW + hv * 64 + j] = f2bf(v0); v[(size_t)m * KVW + hv * 64 + 32 + j] = f2bf(v1); }
        else if (tile < 5) { const int c0 = (tile - 3) * 256 + r; xr[(size_t)m * LW + c0] = f2bf(v0); xr[(size_t)m * LW + c0 + 128] = f2bf(v1); }
        else if (tile < 7) { const int c0 = (tile - 5) * 256 + r; yg[(size_t)m * LW + c0] = f2bf(gelu_tanh(v0)); yg[(size_t)m * LW + c0 + 128] = f2bf(gelu_tanh(v1)); }
        else { const int c0 = (tile - 7) * 128 + r; const float ea = __expf(-v0), eb = __expf(-v1);
            ratio[(size_t)m * DM + c0] = f2bf((1.0f + eb) / (1.0f + ea)); gls[(size_t)m * DM + c0] = f2bf(1.0f / (1.0f + eb)); }
    }
}
__global__ void __launch_bounds__(256) nv_attn(const bf16_t* q, const bf16_t* k, const bf16_t* v, const float* sinks, bf16_t* ao) {
    GSTRIDE(idx, (size_t)NTOK * NQH) {
        const int hq = (int)(idx % NQH), n = (int)(idx / NQH), s = n % SEQ, kvh = hq / 4;
        float qv[64], o[64];
#pragma unroll
        for (int d = 0; d < 64; ++d) { qv[d] = bf2f(q[(size_t)n * AW + hq * 64 + d]) * 0.125f; o[d] = 0.f; }
        const int lo = s - 127 > 0 ? s - 127 : 0; const float sink = sinks[hq];
        float mx = sink;
        for (int kp = lo; kp <= s; ++kp) { const bf16_t* kr = k + (size_t)(n - s + kp) * KVW + kvh * 64; float sc = 0.f;
#pragma unroll
            for (int d = 0; d < 64; ++d) sc += qv[d] * bf2f(kr[d]);
            mx = fmaxf(mx, sc); }
        float l = __expf(sink - mx);
        for (int kp = lo; kp <= s; ++kp) { const bf16_t* kr = k + (size_t)(n - s + kp) * KVW + kvh * 64; const bf16_t* vr = v + (size_t)(n - s + kp) * KVW + kvh * 64; float sc = 0.f;
#pragma unroll
            for (int d = 0; d < 64; ++d) sc += qv[d] * bf2f(kr[d]);
            const float p = __expf(sc - mx); l += p;
#pragma unroll
            for (int d = 0; d < 64; ++d) o[d] += p * bf2f(vr[d]); }
        const float il = 1.0f / l;
#pragma unroll
        for (int d = 0; d < 64; ++d) ao[(size_t)n * DM + hq * 64 + d] = f2bf(o[d] * il);
    }
}
__global__ void __launch_bounds__(256) nv_conv(const bf16_t* xr, const float* cw, const float* cb, float* xc) {
    GSTRIDE(idx, (size_t)NTOK * LW) {
        const int C = (int)(idx % LW), n = (int)(idx / LW), s = n % SEQ; float a = cb[C];
#pragma unroll
        for (int j = 0; j < 4; ++j) { const int ss = s - 3 + j; if (ss >= 0) a += bf2f(xr[(size_t)(n - 3 + j) * LW + C]) * cw[j * LW + C]; }
        xc[idx] = a;
    }
}
__global__ void __launch_bounds__(256) nv_scan(const float* xc, const float* w_rg, const float* b_rg, const float* w_ig, const float* b_ig, const float* lam, const bf16_t* yg, bf16_t* ao) {
    GSTRIDE(idx, (size_t)NB * LW) {
        const int C = (int)(idx % LW), b = (int)(idx / LW), hh = C / 64, cc = C % 64;
        const float sp = log1pf(__expf(-lam[C])); float hs = 0.f;
        for (int t = 0; t < SEQ; ++t) {
            const size_t n = (size_t)b * SEQ + t; const float* xrow = xc + n * LW + hh * 64; float rg = b_rg[C], ig = b_ig[C];
            for (int c = 0; c < 64; ++c) { const float x = xrow[c]; rg += x * w_rg[(hh * 64 + c) * 64 + cc]; ig += x * w_ig[(hh * 64 + c) * 64 + cc]; }
            const float r = sigmoidf_(rg), i = sigmoidf_(ig), la = -8.0f * r * sp, a = __expf(la), u = sqrtf(-expm1f(2.0f * la)) * (i * xrow[cc]);
            hs = a * hs + u;
            ao[n * DM + 512 + C] = f2bf(hs * bf2f(yg[n * LW + C]));
        }
    }
}
__global__ void __launch_bounds__(256) nv_merged(const bf16_t* ao, const bf16_t* Wcat, const bf16_t* ratio, const bf16_t* gls, bf16_t* merged) {
    GSTRIDE(idx, (size_t)NTOK * DM) {
        const int n = (int)(idx % DM), m = (int)(idx / DM);
        const float ya = dot_bf16(ao + (size_t)m * DM, Wcat + (size_t)n * DM, 512), yl = dot_bf16(ao + (size_t)m * DM + 512, Wcat + (size_t)n * DM + 512, 512);
        merged[idx] = f2bf((ya * bf2f(ratio[idx]) + yl) * bf2f(gls[idx]));
    }
}
__global__ void __launch_bounds__(256) nv_wout(const bf16_t* merged, const bf16_t* Wout, const float* x, float* x1) {
    GSTRIDE(idx, (size_t)NTOK * DM) {
        const int n = (int)(idx % DM), m = (int)(idx / DM);
        x1[idx] = x[idx] + dot_bf16(merged + (size_t)m * DM, Wout + (size_t)n * DM, DM);
    }
}
__global__ void __launch_bounds__(256) nv_logits(const float* x1, const float* rstd, const float* g, const float* Wr, const float* br, float* logits) {
    GSTRIDE(idx, (size_t)NTOK * NE) {
        const int e = (int)(idx % NE), m = (int)(idx / NE); const float r = rstd[m]; float s = 0.f;
        for (int k = 0; k < DM; ++k) s += (x1[(size_t)m * DM + k] * r * g[k]) * Wr[k * NE + e];
        logits[idx] = s + br[e];
    }
}
__global__ void __launch_bounds__(256) nv_topk(const float* logits, unsigned* ctl, int* tok_e, float* tok_w, int* tok_p, int* slot_tok) {
    GSTRIDE(idx, (size_t)NTOK) {
        const float* lg = logits + idx * NE; unsigned used = 0; float tv[4]; int te[4];
#pragma unroll
        for (int kk = 0; kk < 4; ++kk) { float best = -3.0e38f; int bi = 0;
            for (int e = 0; e < NE; ++e) { const float vv = lg[e]; if (!((used >> e) & 1u) && vv > best) { best = vv; bi = e; } }
            used |= 1u << bi; tv[kk] = best; te[kk] = bi; }
        float ex[4], sum = 0.f;
#pragma unroll
        for (int kk = 0; kk < 4; ++kk) { ex[kk] = __expf(tv[kk] - tv[0]); sum += ex[kk]; }
#pragma unroll
        for (int kk = 0; kk < 4; ++kk) { const int e = te[kk]; const unsigned p = atomicAdd(&ctl[CW_GCOUNT + 64 * e], 1u);
            tok_e[idx * 4 + kk] = e; tok_w[idx * 4 + kk] = ex[kk] / sum; tok_p[idx * 4 + kk] = (int)p; slot_tok[(size_t)e * CAP + p] = (int)idx; }
    }
}
__device__ __forceinline__ bool row_lookup(const unsigned* ctl, int row, int& e, int& pos, int& cnt) {
    int base = 0;
    for (int ee = 0; ee < NE; ++ee) { const int c = (int)ctl[CW_GCOUNT + 64 * ee]; const int pr = ((c + 255) >> 8) << 8; if (row < base + pr) { e = ee; pos = row - base; cnt = c; return true; } base += pr; }
    return false;
}
__global__ void __launch_bounds__(256) nv_moe1(const unsigned* ctl, const int* slot_tok, const bf16_t* h2, const bf16_t* Wgu, const float* bgu, bf16_t* act) {
    GSTRIDE(idx, (size_t)MAXROWS * DE) {
        const int j = (int)(idx % DE), row = (int)(idx / DE); int e, pos, cnt;
        if (!row_lookup(ctl, row, e, pos, cnt)) continue;
        const int tok = pos < cnt ? slot_tok[(size_t)e * CAP + pos] : 0;
        const int tile = j >> 7, r = j & 127, gg = tile * 256 + r, gu = gg + 128;
        float g = dot_bf16(h2 + (size_t)tok * DM, Wgu + ((size_t)e * 2048 + gg) * DM, DM) + bgu[e * 2048 + j];
        float u = dot_bf16(h2 + (size_t)tok * DM, Wgu + ((size_t)e * 2048 + gu) * DM, DM) + bgu[e * 2048 + 1024 + j];
        g = fminf(g, 7.0f); u = fminf(fmaxf(u, -7.0f), 7.0f);
        act[idx] = f2bf((u + 1.0f) * (g * sigmoidf_(1.702f * g)));
    }
}
__global__ void __launch_bounds__(256) nv_moe2(const unsigned* ctl, const bf16_t* act, const bf16_t* Wd, const float* bd, bf16_t* y) {
    GSTRIDE(idx, (size_t)MAXROWS * DM) {
        const int n = (int)(idx % DM), row = (int)(idx / DM); int e, pos, cnt;
        if (!row_lookup(ctl, row, e, pos, cnt)) continue;
        y[idx] = f2bf(dot_bf16(act + (size_t)row * DE, Wd + ((size_t)e * DM + n) * DE, DE) + bd[e * DM + n]);
    }
}
__global__ void __launch_bounds__(256) nv_final(const unsigned* ctl, const float* x1, const int* tok_e, const float* tok_w, const int* tok_p, const bf16_t* y, const float* g, float* out) {
    const int lane = threadIdx.x & 63; const int w = (blockIdx.x * blockDim.x + threadIdx.x) >> 6, nw = (gridDim.x * blockDim.x) >> 6;
    for (int m = w; m < NTOK; m += nw) {
        int yrow[4]; float ww[4];
#pragma unroll
        for (int kk = 0; kk < 4; ++kk) { const int e = tok_e[m * 4 + kk]; int base = 0; for (int ee = 0; ee < e; ++ee) base += (((int)ctl[CW_GCOUNT + 64 * ee] + 255) >> 8) << 8; yrow[kk] = base + tok_p[m * 4 + kk]; ww[kk] = tok_w[m * 4 + kk]; }
        float v[16]; float s = 0.f;
#pragma unroll
        for (int j = 0; j < 16; ++j) { const int c = lane + 64 * j; float a = x1[(size_t)m * DM + c];
#pragma unroll
            for (int kk = 0; kk < 4; ++kk) a += ww[kk] * bf2f(y[(size_t)yrow[kk] * DM + c]);
            v[j] = a; s += a * a; }
        const float r = rsqrtf(wave_sum(s) * (1.0f / DM) + 1e-6f);
#pragma unroll
        for (int j = 0; j < 16; ++j) out[(size_t)m * DM + lane + 64 * j] = v[j] * r * g[lane + 64 * j];
    }
}

extern "C" void kernel_launch(void* const* d_in, const int* in_sizes, int n_in, void* d_out, int out_size, void* d_ws, size_t ws_size, hipStream_t stream) {
    if (n_in != 23 || ws_size < WS_END) { fprintf(stderr, "kernel_launch: unexpected inputs (%d) or workspace (%zu)\n", n_in, ws_size); return; }
    const float* x = (const float*)d_in[0]; const int* positions = (const int*)d_in[1]; const float* norm_mix_g = (const float*)d_in[2]; const float* w_in = (const float*)d_in[3];
    const float* conv_w = (const float*)d_in[4]; const float* conv_b = (const float*)d_in[5]; const float* w_rg = (const float*)d_in[6]; const float* b_rg = (const float*)d_in[7];
    const float* w_ig = (const float*)d_in[8]; const float* b_ig = (const float*)d_in[9]; const float* lam = (const float*)d_in[10]; const float* sinks = (const float*)d_in[11];
    const float* w_attn_o = (const float*)d_in[12]; const float* w_lru_o = (const float*)d_in[13]; const float* w_out = (const float*)d_in[14]; const float* norm_ffn_g = (const float*)d_in[15];
    const float* w_router = (const float*)d_in[16]; const float* b_router = (const float*)d_in[17]; const float* w_gu = (const float*)d_in[18]; const float* b_gu = (const float*)d_in[19];
    const float* w_down = (const float*)d_in[20]; const float* b_down = (const float*)d_in[21]; const float* norm_final_g = (const float*)d_in[22];
    unsigned char* ws = (unsigned char*)d_ws; float* out = (float*)d_out;
    unsigned* ctl = (unsigned*)(ws + WS_CTL);
    bf16_t* Win_t = (bf16_t*)(ws + WS_WIN); bf16_t* Wcat_t = (bf16_t*)(ws + WS_WCAT); bf16_t* Wout_t = (bf16_t*)(ws + WS_WOUT); bf16_t* Wgu_t = (bf16_t*)(ws + WS_WGU); bf16_t* Wd_t = (bf16_t*)(ws + WS_WD);
    float* x1 = (float*)(ws + WS_X1); bf16_t* h2 = (bf16_t*)(ws + WS_H2); bf16_t* act = (bf16_t*)(ws + WS_ACT); bf16_t* y = (bf16_t*)(ws + WS_Y);
    bf16_t* h = (bf16_t*)(ws + WS_H); bf16_t* q = (bf16_t*)(ws + WS_Q); bf16_t* k = (bf16_t*)(ws + WS_K); bf16_t* v = (bf16_t*)(ws + WS_V); bf16_t* xr = (bf16_t*)(ws + WS_XR); bf16_t* yg = (bf16_t*)(ws + WS_YG);
    bf16_t* ratio = (bf16_t*)(ws + WS_RATIO); bf16_t* gls = (bf16_t*)(ws + WS_GLS); bf16_t* ao = (bf16_t*)(ws + WS_AO); bf16_t* merged = (bf16_t*)(ws + WS_MERGED); float* xc = (float*)(ws + WS_XC);
    int* tok_e = (int*)(ws + WS_TOKE); float* tok_w = (float*)(ws + WS_TOKW); int* tok_p = (int*)(ws + WS_TOKP); int* slot_tok = (int*)(ws + WS_SLOT); float* logits = (float*)(ws + WS_LOGIT); float* rstd = (float*)(ws + WS_RSTD);

    (void)hipMemsetAsync(ws + WS_CTL, 0, CTL_BYTES, stream);
    const int G = 2048, B = 256;
    nv_transpose<<<G, B, 0, stream>>>(w_in, DM, INW, Win_t, DM, 0, INW, 1, 1);
    nv_transpose<<<G, B, 0, stream>>>(w_attn_o, 512, DM, Wcat_t, DM, 0, DM, 0, 1);
    nv_transpose<<<G, B, 0, stream>>>(w_lru_o, 512, DM, Wcat_t, DM, 512, DM, 0, 1);
    nv_transpose<<<G, B, 0, stream>>>(w_out, DM, DM, Wout_t, DM, 0, DM, 0, 1);
    nv_transpose<<<G, B, 0, stream>>>(w_gu, DM, 2048, Wgu_t, DM, 0, 2048, 2, NE);
    nv_transpose<<<G, B, 0, stream>>>(w_down, DE, DM, Wd_t, DE, 0, DM, 0, NE);
    nv_rmsnorm_bf16<<<G, B, 0, stream>>>(x, norm_mix_g, h, nullptr);
    nv_gemm1<<<G * 4, B, 0, stream>>>(h, Win_t, positions, q, k, v, xr, yg, ratio, gls);
    nv_attn<<<G, B, 0, stream>>>(q, k, v, sinks, ao);
    nv_conv<<<G, B, 0, stream>>>(xr, conv_w, conv_b, xc);
    nv_scan<<<NB * LW / 64, 64, 0, stream>>>(xc, w_rg, b_rg, w_ig, b_ig, lam, yg, ao);
    nv_merged<<<G * 4, B, 0, stream>>>(ao, Wcat_t, ratio, gls, merged);
    nv_wout<<<G * 4, B, 0, stream>>>(merged, Wout_t, x, x1);
    nv_rmsnorm_bf16<<<G, B, 0, stream>>>(x1, norm_ffn_g, h2, rstd);
    nv_logits<<<G, B, 0, stream>>>(x1, rstd, norm_ffn_g, w_router, b_router, logits);
    nv_topk<<<NTOK / 256, 256, 0, stream>>>(logits, ctl, tok_e, tok_w, tok_p, slot_tok);
    nv_moe1<<<G * 4, B, 0, stream>>>(ctl, slot_tok, h2, Wgu_t, b_gu, act);
    nv_moe2<<<G * 4, B, 0, stream>>>(ctl, act, Wd_t, b_down, y);
    nv_final<<<G, B, 0, stream>>>(ctl, x1, tok_e, tok_w, tok_p, y, norm_final_g, out);
}
```

```cpp
#include <hip/hip_runtime.h>
#include <stdint.h>
#include <stdio.h>

typedef unsigned short bf16_t;
typedef unsigned u32x4 __attribute__((ext_vector_type(4)));

constexpr int NB = 16, SEQ = 2048, NTOK = NB * SEQ, DM = 1024;
constexpr int NQH = 8, NKVH = 2, HD = 64, AW = 512, KVW = 128, LW = 512, LH = 8, LB = 64;
constexpr int INW = 3840, NE = 32, TOPK = 4, DE = 1024;
constexpr int CAP = NTOK;
constexpr int MAXTILES = NTOK * TOPK / 256 + NE;
constexpr int MAXROWS = MAXTILES * 256;

constexpr size_t MiB = 1u << 20;
constexpr size_t WS_CTL = 0, CTL_BYTES = 1 * MiB;
constexpr size_t WS_WRG = 1 * MiB;
constexpr size_t WS_WIG = WS_WRG + 65536;
constexpr size_t WS_TOKE = 2 * MiB;
constexpr size_t WS_TOKW = 2 * MiB + 512 * 1024;
constexpr size_t WS_TOKP = 3 * MiB;
constexpr size_t WS_SLOT = 4 * MiB;
constexpr size_t WS_LOGIT = 8 * MiB;
constexpr size_t WS_RSTD = 12 * MiB;
constexpr size_t WS_WIN = 16 * MiB;
constexpr size_t WS_WCAT = 24 * MiB;
constexpr size_t WS_WOUT = 26 * MiB;
constexpr size_t WS_WGU = 28 * MiB;
constexpr size_t WS_WD = 156 * MiB;
constexpr size_t WS_X1 = 220 * MiB;
constexpr size_t WS_H2 = 348 * MiB;
constexpr size_t WS_ACT = 412 * MiB;
constexpr size_t WS_Y = 684 * MiB;
constexpr size_t WS_H = 412 * MiB;
constexpr size_t WS_Q = 476 * MiB;
constexpr size_t WS_K = 508 * MiB;
constexpr size_t WS_V = 516 * MiB;
constexpr size_t WS_XR = 524 * MiB;
constexpr size_t WS_YG = 556 * MiB;
constexpr size_t WS_RATIO = 588 * MiB;
constexpr size_t WS_GLS = 652 * MiB;
constexpr size_t WS_AO = 716 * MiB;
constexpr size_t WS_MERGED = 780 * MiB;
constexpr size_t WS_XC = 844 * MiB;
constexpr size_t WS_END = 956 * MiB;
constexpr int CW_GCOUNT = 8192;

__device__ __forceinline__ float bf2f(bf16_t b) { return __uint_as_float(((unsigned)b) << 16); }
__device__ __forceinline__ bf16_t f2bf(float f) { return __builtin_bit_cast(unsigned short, (__bf16)f); }
__device__ __forceinline__ float sigmoidf_(float x) { return 1.0f / (1.0f + __expf(-x)); }
__device__ __forceinline__ float gelu_tanh(float x) { const float u = 0.7978845608028654f * (x + 0.044715f * x * x * x); return 0.5f * x * (1.0f + tanhf(u)); }

__host__ __device__ __forceinline__ int g1_orig(int g) {
    const int tile = g >> 8, w = g & 255, bj = w >> 7, wc = (w >> 5) & 3, j = w & 31;
    if (tile < 2) return tile * 256 + wc * 64 + bj * 32 + j;
    if (tile == 2) return wc < 2 ? 512 + wc * 64 + bj * 32 + j : 640 + (wc - 2) * 64 + bj * 32 + j;
    if (tile < 5) return 768 + (tile - 3) * 256 + w;
    if (tile < 7) return 1280 + (tile - 5) * 256 + w;
    const int t = tile - 7; return (bj ? 2816 : 1792) + 128 * t + (w & 127);
}
__host__ __device__ __forceinline__ int gu_orig(int g) { const int tile = g >> 8, w = g & 255, bj = w >> 7; return bj * 1024 + tile * 128 + (w & 127); }

__device__ __forceinline__ float dot_bf16(const bf16_t* a, const bf16_t* b, int K) {
    float s = 0.f;
    for (int k = 0; k < K; k += 8) {
        const u32x4 av = *(const u32x4*)(a + k), bv = *(const u32x4*)(b + k);
#pragma unroll
        for (int j = 0; j < 4; ++j) {
            s += __uint_as_float(av[j] << 16) * __uint_as_float(bv[j] << 16);
            s += __uint_as_float(av[j] & 0xffff0000u) * __uint_as_float(bv[j] & 0xffff0000u);
        }
    }
    return s;
}
__device__ __forceinline__ float wave_sum(float v) {
#pragma unroll
    for (int o = 1; o < 64; o <<= 1) v += __shfl_xor(v, o);
    return v;
}

#define GSTRIDE(i, n) for (size_t i = (size_t)blockIdx.x * blockDim.x + threadIdx.x; i < (size_t)(n); i += (size_t)gridDim.x * blockDim.x)

__global__ void __launch_bounds__(256) nv_transpose(const float* W, int K, int N, bf16_t* dst, int ldd, int koff, int Ng, int mode, int batch) {
    GSTRIDE(idx, (size_t)batch * Ng * K) {
        const int k = (int)(idx % K); const int g = (int)((idx / K) % Ng); const int b = (int)(idx / ((size_t)K * Ng));
        const int o = mode == 1 ? g1_orig(g) : mode == 2 ? gu_orig(g) : g;
        dst[(size_t)b * Ng * ldd + (size_t)g * ldd + koff + k] = f2bf(W[(size_t)b * K * N + (size_t)k * N + o]);
    }
}
__global__ void __launch_bounds__(256) nv_rmsnorm_bf16(const float* x, const float* g, bf16_t* out, float* rstd_out) {
    const int lane = threadIdx.x & 63; const int w = (blockIdx.x * blockDim.x + threadIdx.x) >> 6, nw = (gridDim.x * blockDim.x) >> 6;
    for (int m = w; m < NTOK; m += nw) {
        const float* xr = x + (size_t)m * DM; float v[16]; float s = 0.f;
#pragma unroll
        for (int j = 0; j < 16; ++j) { v[j] = xr[lane + 64 * j]; s += v[j] * v[j]; }
        const float r = rsqrtf(wave_sum(s) * (1.0f / DM) + 1e-6f);
#pragma unroll
        for (int j = 0; j < 16; ++j) out[(size_t)m * DM + lane + 64 * j] = f2bf(v[j] * r * g[lane + 64 * j]);
        if (rstd_out && lane == 0) rstd_out[m] = r;
    }
}
__device__ __forceinline__ void rope_cs(int pos, int j, float& c, float& s) {
    const float inv = exp2f(-(float)j * (13.287712379549449f / 32.0f));
    const double rev = (double)pos * (double)inv * 0.15915494309189535;
    const float fr = (float)(rev - floor(rev));
    s = __builtin_amdgcn_sinf(fr); c = __builtin_amdgcn_cosf(fr);
}
__global__ void __launch_bounds__(256) nv_gemm1(const bf16_t* h, const bf16_t* Wt, const int* positions, bf16_t* q, bf16_t* k, bf16_t* v, bf16_t* xr, bf16_t* yg, bf16_t* ratio, bf16_t* gls) {
    GSTRIDE(idx, (size_t)NTOK * 15 * 128) {
        const int r = (int)(idx % 128), tile = (int)((idx / 128) % 15), m = (int)(idx / (128 * 15));
        const int g0 = tile * 256 + r, g1 = g0 + 128;
        const float v0 = dot_bf16(h + (size_t)m * DM, Wt + (size_t)g0 * DM, DM), v1 = dot_bf16(h + (size_t)m * DM, Wt + (size_t)g1 * DM, DM);
        const int wc = r >> 5, j = r & 31;
        if (tile < 2 || (tile == 2 && wc < 2)) {
            float c, s; rope_cs(positions[m], j, c, s);
            const float o0 = v0 * c - v1 * s, o1 = v1 * c + v0 * s;
            if (tile < 2) { const int hq = tile * 4 + wc; q[(size_t)m * AW + hq * 64 + j] = f2bf(o0); q[(size_t)m * AW + hq * 64 + 32 + j] = f2bf(o1); }
            else { k[(size_t)m * KVW + wc * 64 + j] = f2bf(o0); k[(size_t)m * KVW + wc * 64 + 32 + j] = f2bf(o1); }
        } else if (tile == 2) { const int hv = wc - 2; v[(size_t)m * KVW + hv * 64 + j] = f2bf(v0); v[(size_t)m * KVW + hv * 64 + 32 + j] = f2bf(v1); }
        else if (tile < 5) { const int c0 = (tile - 3) * 256 + r; xr[(size_t)m * LW + c0] = f2bf(v0); xr[(size_t)m * LW + c0 + 128] = f2bf(v1); }
        else if (tile < 7) { const int c0 = (tile - 5) * 256 + r; yg[(size_t)m * LW + c0] = f2bf(gelu_tanh(v0)); yg[(size_t)m * LW + c0 + 128] = f2bf(gelu_tanh(v1)); }
        else { const int c0 = (tile - 7) * 128 + r; const float ea = __expf(-v0), eb = __expf(-v1);
            ratio[(size_t)m * DM + c0] = f2bf((1.0f + eb) / (1.0f + ea)); gls[(size_t)m * DM + c0] = f2bf(1.0f / (1.0f + eb)); }
    }
}
__global__ void __launch_bounds__(256) nv_attn(const bf16_t* q, const bf16_t* k, const bf16_t* v, const float* sinks, bf16_t* ao) {
    GSTRIDE(idx, (size_t)NTOK * NQH) {
        const int hq = (int)(idx % NQH), n = (int)(idx / NQH), s = n % SEQ, kvh = hq / 4;
        float qv[64], o[64];
#pragma unroll
        for (int d = 0; d < 64; ++d) { qv[d] = bf2f(q[(size_t)n * AW + hq * 64 + d]) * 0.125f; o[d] = 0.f; }
        const int lo = s - 127 > 0 ? s - 127 : 0; const float sink = sinks[hq];
        float mx = sink;
        for (int kp = lo; kp <= s; ++kp) { const bf16_t* kr = k + (size_t)(n - s + kp) * KVW + kvh * 64; float sc = 0.f;
#pragma unroll
            for (int d = 0; d < 64; ++d) sc += qv[d] * bf2f(kr[d]);
            mx = fmaxf(mx, sc); }
        float l = __expf(sink - mx);
        for (int kp = lo; kp <= s; ++kp) { const bf16_t* kr = k + (size_t)(n - s + kp) * KVW + kvh * 64; const bf16_t* vr = v + (size_t)(n - s + kp) * KVW + kvh * 64; float sc = 0.f;
#pragma unroll
            for (int d = 0; d < 64; ++d) sc += qv[d] * bf2f(kr[d]);
            const float p = __expf(sc - mx); l += p;
#pragma unroll
            for (int d = 0; d < 64; ++d) o[d] += p * bf2f(vr[d]); }
        const float il = 1.0f / l;
#pragma unroll
        for (int d = 0; d < 64; ++d) ao[(size_t)n * DM + hq * 64 + d] = f2bf(o[d] * il);
    }
}
__global__ void __launch_bounds__(256) nv_conv(const bf16_t* xr, const float* cw, const float* cb, float* xc) {
    GSTRIDE(idx, (size_t)NTOK * LW) {
        const int C = (int)(idx % LW), n = (int)(idx / LW), s = n % SEQ; float a = cb[C];
#pragma unroll
        for (int j = 0; j < 4; ++j) { const int ss = s - 3 + j; if (ss >= 0) a += bf2f(xr[(size_t)(n - 3 + j) * LW + C]) * cw[j * LW + C]; }
        xc[idx] = a;
    }
}
__global__ void __launch_bounds__(256) nv_scan(const float* xc, const float* w_rg, const float* b_rg, const float* w_ig, const float* b_ig, const float* lam, const bf16_t* yg, bf16_t* ao) {
    GSTRIDE(idx, (size_t)NB * LW) {
        const int C = (int)(idx % LW), b = (int)(idx / LW), hh = C / 64, cc = C % 64;
        const float sp = log1pf(__expf(-lam[C])); float hs = 0.f;
        for (int t = 0; t < SEQ; ++t) {
            const size_t n = (size_t)b * SEQ + t; const float* xrow = xc + n * LW + hh * 64; float rg = b_rg[C], ig = b_ig[C];
            for (int c = 0; c < 64; ++c) { const float x = xrow[c]; rg += x * w_rg[(hh * 64 + c) * 64 + cc]; ig += x * w_ig[(hh * 64 + c) * 64 + cc]; }
            const float r = sigmoidf_(rg), i = sigmoidf_(ig), la = -8.0f * r * sp, a = __expf(la), u = sqrtf(-expm1f(2.0f * la)) * (i * xrow[cc]);
            hs = a * hs + u;
            ao[n * DM + 512 + C] = f2bf(hs * bf2f(yg[n * LW + C]));
        }
    }
}
__global__ void __launch_bounds__(256) nv_merged(const bf16_t* ao, const bf16_t* Wcat, const bf16_t* ratio, const bf16_t* gls, bf16_t* merged) {
    GSTRIDE(idx, (size_t)NTOK * DM) {
        const int n = (int)(idx % DM), m = (int)(idx / DM);
        const float ya = dot_bf16(ao + (size_t)m * DM, Wcat + (size_t)n * DM, 512), yl = dot_bf16(ao + (size_t)m * DM + 512, Wcat + (size_t)n * DM + 512, 512);
        merged[idx] = f2bf((ya * bf2f(ratio[idx]) + yl) * bf2f(gls[idx]));
    }
}
__global__ void __launch_bounds__(256) nv_wout(const bf16_t* merged, const bf16_t* Wout, const float* x, float* x1) {
    GSTRIDE(idx, (size_t)NTOK * DM) {
        const int n = (int)(idx % DM), m = (int)(idx / DM);
        x1[idx] = x[idx] + dot_bf16(merged + (size_t)m * DM, Wout + (size_t)n * DM, DM);
    }
}
__global__ void __launch_bounds__(256) nv_logits(const float* x1, const float* rstd, const float* g, const float* Wr, const float* br, float* logits) {
    GSTRIDE(idx, (size_t)NTOK * NE) {
        const int e = (int)(idx % NE), m = (int)(idx / NE); const float r = rstd[m]; float s = 0.f;
        for (int k = 0; k < DM; ++k) s += (x1[(size_t)m * DM + k] * r * g[k]) * Wr[k * NE + e];
        logits[idx] = s + br[e];
    }
}
__global__ void __launch_bounds__(256) nv_topk(const float* logits, unsigned* ctl, int* tok_e, float* tok_w, int* tok_p, int* slot_tok) {
    GSTRIDE(idx, (size_t)NTOK) {
        const float* lg = logits + idx * NE; unsigned used = 0; float tv[4]; int te[4];
#pragma unroll
        for (int kk = 0; kk < 4; ++kk) { float best = -3.0e38f; int bi = 0;
            for (int e = 0; e < NE; ++e) { const float vv = lg[e]; if (!((used >> e) & 1u) && vv > best) { best = vv; bi = e; } }
            used |= 1u << bi; tv[kk] = best; te[kk] = bi; }
        float ex[4], sum = 0.f;
#pragma unroll
        for (int kk = 0; kk < 4; ++kk) { ex[kk] = __expf(tv[kk] - tv[0]); sum += ex[kk]; }
#pragma unroll
        for (int kk = 0; kk < 4; ++kk) { const int e = te[kk]; const unsigned p = atomicAdd(&ctl[CW_GCOUNT + 64 * e], 1u);
            tok_e[idx * 4 + kk] = e; tok_w[idx * 4 + kk] = ex[kk] / sum; tok_p[idx * 4 + kk] = (int)p; slot_tok[(size_t)e * CAP + p] = (int)idx; }
    }
}
__device__ __forceinline__ bool row_lookup(const unsigned* ctl, int row, int& e, int& pos, int& cnt) {
    int base = 0;
    for (int ee = 0; ee < NE; ++ee) { const int c = (int)ctl[CW_GCOUNT + 64 * ee]; const int pr = ((c + 255) >> 8) << 8; if (row < base + pr) { e = ee; pos = row - base; cnt = c; return true; } base += pr; }
    return false;
}
__global__ void __launch_bounds__(256) nv_moe1(const unsigned* ctl, const int* slot_tok, const bf16_t* h2, const bf16_t* Wgu, const float* bgu, bf16_t* act) {
    GSTRIDE(idx, (size_t)MAXROWS * DE) {
        const int j = (int)(idx % DE), row = (int)(idx / DE); int e, pos, cnt;
        if (!row_lookup(ctl, row, e, pos, cnt)) continue;
        const int tok = pos < cnt ? slot_tok[(size_t)e * CAP + pos] : 0;
        const int tile = j >> 7, r = j & 127, gg = tile * 256 + r, gu = gg + 128;
        float g = dot_bf16(h2 + (size_t)tok * DM, Wgu + ((size_t)e * 2048 + gg) * DM, DM) + bgu[e * 2048 + j];
        float u = dot_bf16(h2 + (size_t)tok * DM, Wgu + ((size_t)e * 2048 + gu) * DM, DM) + bgu[e * 2048 + 1024 + j];
        g = fminf(g, 7.0f); u = fminf(fmaxf(u, -7.0f), 7.0f);
        act[idx] = f2bf((u + 1.0f) * (g * sigmoidf_(1.702f * g)));
    }
}
__global__ void __launch_bounds__(256) nv_moe2(const unsigned* ctl, const bf16_t* act, const bf16_t* Wd, const float* bd, bf16_t* y) {
    GSTRIDE(idx, (size_t)MAXROWS * DM) {
        const int n = (int)(idx % DM), row = (int)(idx / DM); int e, pos, cnt;
        if (!row_lookup(ctl, row, e, pos, cnt)) continue;
        y[idx] = f2bf(dot_bf16(act + (size_t)row * DE, Wd + ((size_t)e * DM + n) * DE, DE) + bd[e * DM + n]);
    }
}
__global__ void __launch_bounds__(256) nv_final(const unsigned* ctl, const float* x1, const int* tok_e, const float* tok_w, const int* tok_p, const bf16_t* y, const float* g, float* out) {
    const int lane = threadIdx.x & 63; const int w = (blockIdx.x * blockDim.x + threadIdx.x) >> 6, nw = (gridDim.x * blockDim.x) >> 6;
    for (int m = w; m < NTOK; m += nw) {
        int yrow[4]; float ww[4];
#pragma unroll
        for (int kk = 0; kk < 4; ++kk) { const int e = tok_e[m * 4 + kk]; int base = 0; for (int ee = 0; ee < e; ++ee) base += (((int)ctl[CW_GCOUNT + 64 * ee] + 255) >> 8) << 8; yrow[kk] = base + tok_p[m * 4 + kk]; ww[kk] = tok_w[m * 4 + kk]; }
        float v[16]; float s = 0.f;
#pragma unroll
        for (int j = 0; j < 16; ++j) { const int c = lane + 64 * j; float a = x1[(size_t)m * DM + c];
#pragma unroll
            for (int kk = 0; kk < 4; ++kk) a += ww[kk] * bf2f(y[(size_t)yrow[kk] * DM + c]);
            v[j] = a; s += a * a; }
        const float r = rsqrtf(wave_sum(s) * (1.0f / DM) + 1e-6f);
#pragma unroll
        for (int j = 0; j < 16; ++j) out[(size_t)m * DM + lane + 64 * j] = v[j] * r * g[lane + 64 * j];
    }
}

#define LAS __attribute__((address_space(3)))
typedef short bf16x8 __attribute__((ext_vector_type(8)));
typedef short s16x4 __attribute__((ext_vector_type(4)));
typedef float f32x4 __attribute__((ext_vector_type(4)));
typedef float f32x16 __attribute__((ext_vector_type(16)));
constexpr int NWAVES = 8;
constexpr int RING_BYTES = 131072, MISC_OFF = RING_BYTES, LDS_BYTES = 147456;
constexpr int MW_Q = 16, MW_TS = 32, MW_CNT = 72, MW_P5 = 128;
constexpr int CW_BAR = 4096, CW_QUEUE = 12288;

__device__ __forceinline__ unsigned cvt_pk_bf16(float lo, float hi) { unsigned r; asm volatile("v_cvt_pk_bf16_f32 %0, %1, %2" : "=v"(r) : "v"(lo), "v"(hi)); return r; }
__device__ __forceinline__ float fsig(float x) { return __builtin_amdgcn_rcpf(1.0f + __builtin_amdgcn_exp2f(-1.4426950408889634f * x)); }
__device__ __forceinline__ int crow(int r, int hi) { return (r & 3) + 8 * (r >> 2) + 4 * hi; }
__device__ __forceinline__ void unpack8(const u32x4 w, float (&f)[8]) {
#pragma unroll
    for (int j = 0; j < 4; ++j) { f[2 * j] = __uint_as_float(w[j] << 16); f[2 * j + 1] = __uint_as_float(w[j] & 0xffff0000u); }
}
__host__ __device__ __forceinline__ int g1_inv(int o) {
    if (o < 512) { const int head = o >> 6, d = o & 63; return (head >> 2) * 256 + (d >> 5) * 128 + (head & 3) * 32 + (d & 31); }
    if (o < 640) { const int hk = (o - 512) >> 6, d = o & 63; return 512 + (d >> 5) * 128 + hk * 32 + (d & 31); }
    if (o < 768) { const int hv = (o - 640) >> 6, d = o & 63; return 512 + (d >> 5) * 128 + (2 + hv) * 32 + (d & 31); }
    if (o < 1792) return o;
    if (o < 2816) { const int c = o - 1792; return (7 + (c >> 7)) * 256 + (c & 127); }
    const int c = o - 2816; return (7 + (c >> 7)) * 256 + 128 + (c & 127);
}
__host__ __device__ __forceinline__ int gu_inv(int o) { const int bj = o >> 10, c = o & 1023; return (c >> 7) * 256 + bj * 128 + (c & 127); }

#define XB_TMO      128
#define XB_XCNT(j)  (256  + 64 * (j))
#define XB_XSUB(j)  (1280 + 64 * (j))
#define XB_XGEN(j)  (2304 + 64 * (j))
#define XB_TOP      3328
#define XB_TOPGEN   3392
#define XCD_BAR_WORDS 3456
#define XB_SPIN_CAP (1u << 18)
__device__ __forceinline__ unsigned xb_ld(unsigned* p)              { return __hip_atomic_load(p, __ATOMIC_RELAXED, __HIP_MEMORY_SCOPE_AGENT); }
__device__ __forceinline__ unsigned xb_add(unsigned* p, unsigned v) { return __hip_atomic_fetch_add(p, v, __ATOMIC_RELAXED, __HIP_MEMORY_SCOPE_AGENT); }
__device__ __forceinline__ unsigned xb_xcc_id() { return (unsigned)__builtin_amdgcn_s_getreg((3 << 11) | 20) & 0xFu; }
#define XB_SPIN(cond, bar) do { unsigned _sp = 0; while (cond) { __builtin_amdgcn_s_sleep(1); \
    if ((++_sp & 255u) == 0u) { if (xb_ld(&(bar)[XB_TMO])) break; if (_sp > XB_SPIN_CAP) { atomicAdd(&(bar)[XB_TMO], 1u); break; } } } } while (0)
struct XcdBarrier { unsigned* bar; unsigned x; volatile LAS unsigned* st; };
__device__ __forceinline__ XcdBarrier xcd_barrier_post(unsigned* bar, volatile LAS unsigned* st) {
    XcdBarrier b; b.bar = bar; b.x = xb_xcc_id(); b.st = st;
    if (threadIdx.x == 0) (void)xb_add(&bar[XB_XCNT(b.x)], 1u);
    return b;
}
__device__ __forceinline__ void xcd_barrier_complete(unsigned* bar, unsigned x, unsigned& nloc, unsigned& nx) {
    const unsigned G = gridDim.x * gridDim.y * gridDim.z;
    unsigned sum, cnt, mine, sp = 0u;
    for (;;) {
        sum = 0u; cnt = 0u; mine = 0u;
#pragma unroll
        for (unsigned j = 0; j < 16; ++j) { const unsigned c = xb_ld(&bar[XB_XCNT(j)]); sum += c; cnt += (c > 0u) ? 1u : 0u; mine = (j == x) ? c : mine; }
        if (sum == G) break;
        __builtin_amdgcn_s_sleep(1);
        if ((++sp & 255u) == 0u) { if (xb_ld(&bar[XB_TMO])) break; if (sp > XB_SPIN_CAP) { atomicAdd(&bar[XB_TMO], 1u); break; } }
    }
    nloc = mine > 0u ? mine : 1u; nx = cnt > 0u ? cnt : 1u;
}
__device__ __forceinline__ void xcd_barrier(const XcdBarrier& b) {
    asm volatile("s_waitcnt vmcnt(0)" ::: "memory");
    __syncthreads();
    if (threadIdx.x == 0) {
        unsigned* bar = b.bar;
        __builtin_amdgcn_s_waitcnt(0);
        unsigned nloc = b.st[0], nx = b.st[1];
        if (nloc == 0u) { xcd_barrier_complete(bar, b.x, nloc, nx); b.st[0] = nloc; b.st[1] = nx; }
        const unsigned old = xb_add(&bar[XB_XSUB(b.x)], 1u);
        const unsigned gen = old / nloc;
        if (old + 1u == (gen + 1u) * nloc) {
            __builtin_amdgcn_fence(__ATOMIC_RELEASE, "agent");
            asm volatile("s_waitcnt vmcnt(0)" ::: "memory");
            const unsigned og = xb_add(&bar[XB_TOP], 1u);
            const unsigned tg = og / nx;
            if (og + 1u == (tg + 1u) * nx) xb_add(&bar[XB_TOPGEN], 1u);
            else XB_SPIN(xb_ld(&bar[XB_TOPGEN]) == tg, bar);
            __builtin_amdgcn_fence(__ATOMIC_ACQUIRE, "agent");
            xb_add(&bar[XB_XGEN(b.x)], 1u);
            asm volatile("s_waitcnt vmcnt(0)" ::: "memory");
        } else {
            XB_SPIN(xb_ld(&bar[XB_XGEN(b.x)]) == gen, bar);
            __builtin_amdgcn_fence(__ATOMIC_ACQUIRE, "agent");
            asm volatile("s_waitcnt vmcnt(0)" ::: "memory");
        }
    }
    __syncthreads();
}

namespace pg8 {
constexpr int BM = 256, BK = 64, HALF = 128, HTB = HALF * BK * 2, STAGE_BYTES = 8 * HTB, NXCD = 8, WGM = 8, KK = 1024, NT = KK / BK;
__host__ __device__ __forceinline__ int lds_byte(int r, int c) { const int st = (r >> 4) * 2 + (c >> 5), rr = r & 15, cc = c & 31, ob = rr * 64 + cc * 2; return st * 1024 + (ob ^ (((ob >> 9) & 1) << 5)); }
__host__ __device__ __forceinline__ void stage_rc(int b, int& R, int& C) { const int st = b / 1024, sb = b % 1024, swz = sb ^ (((sb >> 9) & 1) << 5); R = (st >> 1) * 16 + swz / 64; C = (st & 1) * 32 + (swz % 64) / 2; }
__host__ __device__ __forceinline__ int perm32(int rho) { const int n = rho >> 4, i = rho & 15; return 8 * (i >> 2) + 4 * n + (i & 3); }
struct Unit { int pm, pn, e, nvalid; };
constexpr size_t TSTEP = (size_t)BM * KK * 2, HSTEP = (size_t)HALF * KK * 2, KSTEP = BK * 2;

struct DenseSched {
    const bf16_t* A; const bf16_t* Bt; int nM, nN, nwg, G, c, it;
    __device__ void init(const bf16_t* A_, const bf16_t* Bt_, int M, int N, int G_, int c_) { A = A_; Bt = Bt_; nM = M / BM; nN = N / BM; nwg = nM * nN; G = G_; c = c_; it = 0; }
    __device__ __forceinline__ bool next(Unit& u) {
        const long L = (long)it * G + c; ++it; if (L >= nwg) return false;
        int wgid = (int)L; { const int q = nwg / NXCD, r = nwg % NXCD, xcd = wgid % NXCD, off = wgid / NXCD; wgid = (xcd < r ? xcd * (q + 1) : r * (q + 1) + (xcd - r) * q) + off; }
        const int nig = WGM * nN, gid = wgid / nig, fm = gid * WGM, gsz = (nM - fm) < WGM ? (nM - fm) : WGM;
        u.pm = fm + ((wgid % nig) % gsz); u.pn = (wgid % nig) / gsz; u.e = 0; u.nvalid = 256; return true;
    }
    __device__ __forceinline__ const char* a_base(const Unit& u) const { return (const char*)A + (size_t)u.pm * TSTEP; }
    __device__ __forceinline__ const char* b_base(const Unit& u) const { return (const char*)Bt + (size_t)u.pn * TSTEP; }
    __device__ __forceinline__ void a_off(const Unit&, const int (&R)[2], const int (&C)[2], unsigned (&v)[2][2]) const {
#pragma unroll
        for (int h = 0; h < 2; ++h)
#pragma unroll
            for (int i = 0; i < 2; ++i) v[h][i] = (unsigned)((R[i] + HALF * h) * KK + C[i]) * 2u;
    }
};
template <bool GATHER> struct MoeSched {
    const bf16_t* A; const bf16_t* Bt; const int* slot_tok; const volatile LAS int* ts; const volatile LAS int* cnt; int NPN, ntiles, Lmax, G, c, it;
    __device__ void init(const bf16_t* A_, const bf16_t* Bt_, const int* slot_tok_, const volatile LAS int* ts_, const volatile LAS int* cnt_, int NPN_, int G_, int c_) {
        A = A_; Bt = Bt_; slot_tok = slot_tok_; ts = ts_; cnt = cnt_; NPN = NPN_; G = G_; c = c_; it = 0; ntiles = ts[NE]; Lmax = ((ntiles + 7) / 8) * 8 * NPN; }
    __device__ __forceinline__ bool next(Unit& u) {
        for (;;) {
            const int L = it * G + c; ++it; if (L >= Lmax) return false;
            const int xcd = L & 7, j = L >> 3, m = (j / NPN) * 8 + xcd; if (m >= ntiles) continue;
            int e = 0;
            for (int ee = 1; ee < NE; ++ee) e = (m >= ts[ee]) ? ee : e;
            u.pm = m; u.pn = j % NPN; u.e = e; u.nvalid = cnt[e] - 256 * (m - ts[e]); return true;
        }
    }
    __device__ __forceinline__ const char* a_base(const Unit& u) const { return GATHER ? (const char*)A : (const char*)A + (size_t)u.pm * TSTEP; }
    __device__ __forceinline__ const char* b_base(const Unit& u) const { return (const char*)Bt + ((size_t)u.e * NPN + u.pn) * TSTEP; }
    __device__ __forceinline__ void a_off(const Unit& u, const int (&R)[2], const int (&C)[2], unsigned (&v)[2][2]) const {
#pragma unroll
        for (int h = 0; h < 2; ++h)
#pragma unroll
            for (int i = 0; i < 2; ++i) {
                const int r = R[i] + HALF * h;
                if (GATHER) { const int tok = r < u.nvalid ? slot_tok[(size_t)u.e * CAP + 256 * (u.pm - ts[u.e]) + r] : 0; v[h][i] = (unsigned)(tok * KK + C[i]) * 2u; }
                else v[h][i] = (unsigned)(r * KK + C[i]) * 2u;
            }
    }
};

template <class Epi, class Sched, bool ALIGN_EPI>
__device__ __forceinline__ void gemm_phase(LAS unsigned char* lds, Sched& S, const Epi& E) {
    const int tid = threadIdx.x, wid = __builtin_amdgcn_readfirstlane(tid >> 6), lane = tid & 63, wr = wid >> 2, wc = wid & 3, fr = lane & 15, fq = lane >> 4;
    unsigned voffB[2]; int Rr[2], Cc[2];
#pragma unroll
    for (int i = 0; i < 2; ++i) { int R, C; stage_rc(tid * 16 + i * 8192, R, C); const int Rb = Epi::PERM ? ((R & ~31) + perm32(R & 31)) : R; Rr[i] = R; Cc[i] = C; voffB[i] = (unsigned)(Rb * KK + C) * 2u; }
    const unsigned ldsw = (unsigned)wid * 1024u;
    const int aoff = lds_byte(wr * 64 + fr, fq * 8), boff = lds_byte(wc * 32 + fr, fq * 8);
#define PG8_SA(b, h) (((b) * 2 + (h)) * HTB)
#define PG8_SB(b, h) ((4 + (b) * 2 + (h)) * HTB)
#define PG8_STAGE(bufoff, gbase, voff) do { _Pragma("unroll") for (int _i = 0; _i < 2; ++_i) \
        __builtin_amdgcn_global_load_lds((const unsigned*)((const char*)(gbase) + (voff)[_i]), (LAS unsigned*)(lds + (bufoff) + ldsw + _i * 8192), 16, 0, 0); } while (0)
#define PG8_LDA(dst, b, h) do { _Pragma("unroll") for (int m = 0; m < 4; ++m) _Pragma("unroll") for (int k = 0; k < 2; ++k) dst[m][k] = *(const LAS bf16x8*)(lds + PG8_SA(b, h) + aoff + m * 2048 + k * 1024); } while (0)
#define PG8_LDB(dst, b, h) do { _Pragma("unroll") for (int n = 0; n < 2; ++n) _Pragma("unroll") for (int k = 0; k < 2; ++k) dst[n][k] = *(const LAS bf16x8*)(lds + PG8_SB(b, h) + boff + n * 2048 + k * 1024); } while (0)
#define PG8_MMA(ai, bj, At, Bt) do { __builtin_amdgcn_s_setprio(1); _Pragma("unroll") for (int m = 0; m < 4; ++m) _Pragma("unroll") for (int n = 0; n < 2; ++n) _Pragma("unroll") for (int k = 0; k < 2; ++k) \
        acc[ai][bj][m][n] = __builtin_amdgcn_mfma_f32_16x16x32_bf16(Bt[n][k], At[m][k], acc[ai][bj][m][n], 0, 0, 0); __builtin_amdgcn_s_setprio(0); } while (0)
#define PG8_WAIT_V(n) asm volatile("s_waitcnt vmcnt(" #n ")" ::: "memory")
#define PG8_WAIT_L(n) asm volatile("s_waitcnt lgkmcnt(" #n ")" ::: "memory")
#define PG8_BAR __builtin_amdgcn_s_barrier()
#define PG8_SCHED __builtin_amdgcn_sched_barrier(0)
    Unit cur, nxt;
    if (!S.next(cur)) return;
    f32x4 acc[2][2][4][2];
#pragma unroll
    for (int a = 0; a < 2; ++a)
#pragma unroll
        for (int b = 0; b < 2; ++b)
#pragma unroll
            for (int m = 0; m < 4; ++m)
#pragma unroll
                for (int n = 0; n < 2; ++n) acc[a][b][m][n] = (f32x4){0.f, 0.f, 0.f, 0.f};
    bf16x8 At[4][2], B0[2][2], B1[2][2];
    unsigned vA[2][2], vN[2][2];
    S.a_off(cur, Rr, Cc, vA);
    const char* cA = S.a_base(cur); const char* cB = S.b_base(cur);
    PG8_STAGE(PG8_SB(0, 0), cB, voffB); PG8_STAGE(PG8_SB(0, 1), cB + HSTEP, voffB); PG8_STAGE(PG8_SA(0, 0), cA, vA[0]); PG8_STAGE(PG8_SA(0, 1), cA, vA[1]);
    if (wr == 1) PG8_BAR;
    PG8_WAIT_V(2); PG8_BAR;
    PG8_STAGE(PG8_SB(1, 0), cB + KSTEP, voffB); PG8_STAGE(PG8_SA(1, 0), cA + KSTEP, vA[0]); PG8_STAGE(PG8_SB(1, 1), cB + HSTEP + KSTEP, voffB);
    PG8_WAIT_V(6); PG8_BAR;
    for (;;) {
        const bool has_next = S.next(nxt);
        const char* nA = has_next ? S.a_base(nxt) : cA; const char* nB = has_next ? S.b_base(nxt) : cB;
        if (has_next) S.a_off(nxt, Rr, Cc, vN);
        else {
#pragma unroll
            for (int h = 0; h < 2; ++h)
#pragma unroll
                for (int i = 0; i < 2; ++i) vN[h][i] = vA[h][i];
        }
        for (int t = 0; t < NT; t += 2) {
            const bool last = (t == NT - 2);
            const char* a1 = cA + (size_t)(t + 1) * KSTEP;
            const char* a2 = last ? nA : cA + (size_t)(t + 2) * KSTEP; const char* b2 = last ? nB : cB + (size_t)(t + 2) * KSTEP;
            const char* a3 = a2 + KSTEP; const char* b3 = b2 + KSTEP;
            unsigned v2[2][2];
#pragma unroll
            for (int h = 0; h < 2; ++h)
#pragma unroll
                for (int i = 0; i < 2; ++i) v2[h][i] = last ? vN[h][i] : vA[h][i];
            if constexpr (Epi::HAS_MID) { if (t == NT / 2) E.mid(acc, cur, wr, wc, fr, fq); }
            PG8_LDB(B0, 0, 0); PG8_LDB(B1, 0, 1); PG8_SCHED; PG8_LDA(At, 0, 0); PG8_STAGE(PG8_SA(1, 1), a1, vA[1]);
            PG8_WAIT_V(8); PG8_WAIT_L(0); PG8_BAR; PG8_MMA(0, 0, At, B0); PG8_MMA(0, 1, At, B1); PG8_BAR; PG8_SCHED;
            PG8_LDA(At, 0, 1); PG8_STAGE(PG8_SB(0, 0), b2, voffB); PG8_STAGE(PG8_SB(0, 1), b2 + HSTEP, voffB); PG8_STAGE(PG8_SA(0, 0), a2, v2[0]);
            PG8_WAIT_V(8); PG8_WAIT_L(0); PG8_BAR; PG8_MMA(1, 0, At, B0); PG8_MMA(1, 1, At, B1); PG8_BAR; PG8_SCHED;
            PG8_LDB(B0, 1, 0); PG8_LDB(B1, 1, 1); PG8_SCHED; PG8_LDA(At, 1, 0); PG8_STAGE(PG8_SA(0, 1), a2, v2[1]);
            PG8_WAIT_V(8); PG8_WAIT_L(0); PG8_BAR; PG8_MMA(0, 0, At, B0); PG8_MMA(0, 1, At, B1); PG8_BAR; PG8_SCHED;
            PG8_LDA(At, 1, 1); PG8_STAGE(PG8_SB(1, 0), b3, voffB); PG8_STAGE(PG8_SB(1, 1), b3 + HSTEP, voffB); PG8_STAGE(PG8_SA(1, 0), a3, v2[0]);
            PG8_WAIT_V(8); PG8_WAIT_L(0); PG8_BAR; PG8_MMA(1, 0, At, B0); PG8_MMA(1, 1, At, B1); PG8_BAR; PG8_SCHED;
        }
        if constexpr (ALIGN_EPI) { if (wr == 0) PG8_BAR; }
        E(acc, cur, wr, wc, fr, fq);
        if (!has_next) break;
#pragma unroll
        for (int a = 0; a < 2; ++a)
#pragma unroll
            for (int b = 0; b < 2; ++b)
#pragma unroll
                for (int m = 0; m < 4; ++m)
#pragma unroll
                    for (int n = 0; n < 2; ++n) acc[a][b][m][n] = (f32x4){0.f, 0.f, 0.f, 0.f};
        cur = nxt; cA = nA; cB = nB;
#pragma unroll
        for (int h = 0; h < 2; ++h)
#pragma unroll
            for (int i = 0; i < 2; ++i) vA[h][i] = vN[h][i];
        if constexpr (ALIGN_EPI) { if (wr == 1) PG8_BAR; }
    }
    PG8_WAIT_V(0);
    if constexpr (!ALIGN_EPI) { if (wr == 0) PG8_BAR; }
    PG8_BAR;
#undef PG8_SA
#undef PG8_SB
#undef PG8_STAGE
#undef PG8_LDA
#undef PG8_LDB
#undef PG8_MMA
#undef PG8_WAIT_V
#undef PG8_WAIT_L
#undef PG8_BAR
#undef PG8_SCHED
}

struct EpiG1 {
    static constexpr bool PERM = true, HAS_MID = false;
    const int* pos; bf16_t *q, *k, *v, *xr, *yg, *ratio, *gls;
    __device__ __forceinline__ void mid(f32x4 (&)[2][2][4][2], const Unit&, int, int, int, int) const {}
    __device__ __forceinline__ void operator()(const f32x4 (&acc)[2][2][4][2], const Unit& u, int wr, int wc, int fr, int fq) const {
        const int row0 = u.pm * BM + wr * 64 + fr, j0 = 8 * fq, pn = u.pn;
        const bool rope = (pn < 2) || (pn == 2 && wc < 2);
        float invf[8];
#pragma unroll
        for (int e = 0; e < 8; ++e) invf[e] = exp2f(-(float)(j0 + e) * (13.287712379549449f / 32.0f)) * 0.15915494309189535f;
#pragma unroll
        for (int ai = 0; ai < 2; ++ai)
#pragma unroll
            for (int m = 0; m < 4; ++m) {
                const int row = row0 + ai * HALF + m * 16;
                float lo[8], hi[8];
#pragma unroll
                for (int e = 0; e < 4; ++e) { lo[e] = acc[ai][0][m][0][e]; lo[4 + e] = acc[ai][0][m][1][e]; hi[e] = acc[ai][1][m][0][e]; hi[4 + e] = acc[ai][1][m][1][e]; }
                bf16_t* d0; bf16_t* d1;
                if (rope) {
                    const float p = (float)pos[row];
#pragma unroll
                    for (int e = 0; e < 8; ++e) { float rev = p * invf[e]; rev -= floorf(rev); const float s = __builtin_amdgcn_sinf(rev), c = __builtin_amdgcn_cosf(rev);
                        const float a = lo[e], b = hi[e]; lo[e] = a * c - b * s; hi[e] = b * c + a * s; }
                    if (pn < 2) { d0 = q + (size_t)row * AW + (pn * 4 + wc) * 64 + j0; } else { d0 = k + (size_t)row * KVW + wc * 64 + j0; }
                    d1 = d0 + 32;
                } else if (pn == 2) { d0 = v + (size_t)row * KVW + (wc - 2) * 64 + j0; d1 = d0 + 32; }
                else if (pn < 5) { d0 = xr + (size_t)row * LW + (pn - 3) * 256 + wc * 32 + j0; d1 = d0 + 128; }
                else if (pn < 7) {
#pragma unroll
                    for (int e = 0; e < 8; ++e) { const float a = lo[e], b = hi[e];
                        lo[e] = a * fsig(1.5957691216057308f * (a + 0.044715f * a * a * a)); hi[e] = b * fsig(1.5957691216057308f * (b + 0.044715f * b * b * b)); }
                    d0 = yg + (size_t)row * LW + (pn - 5) * 256 + wc * 32 + j0; d1 = d0 + 128;
                } else {
#pragma unroll
                    for (int e = 0; e < 8; ++e) { const float a = fminf(fmaxf(lo[e], -30.f), 30.f), b = fminf(fmaxf(hi[e], -30.f), 30.f);
                        const float ea = __builtin_amdgcn_exp2f(-1.4426950408889634f * a), eb = __builtin_amdgcn_exp2f(-1.4426950408889634f * b);
                        const float ib = __builtin_amdgcn_rcpf(1.0f + eb); lo[e] = (1.0f + eb) * __builtin_amdgcn_rcpf(1.0f + ea); hi[e] = ib; }
                    d0 = ratio + (size_t)row * DM + (pn - 7) * 128 + wc * 32 + j0; d1 = gls + (size_t)row * DM + (pn - 7) * 128 + wc * 32 + j0;
                }
                u32x4 w0, w1;
#pragma unroll
                for (int e = 0; e < 4; ++e) { w0[e] = cvt_pk_bf16(lo[2 * e], lo[2 * e + 1]); w1[e] = cvt_pk_bf16(hi[2 * e], hi[2 * e + 1]); }
                *(u32x4*)d0 = w0; *(u32x4*)d1 = w1;
            }
    }
};
struct EpiMerged {
    static constexpr bool PERM = true, HAS_MID = true;
    const bf16_t* ratio; const bf16_t* gls; bf16_t* merged;
    __device__ __forceinline__ void mid(f32x4 (&acc)[2][2][4][2], const Unit& u, int wr, int wc, int fr, int fq) const {
        int off0 = (u.pm * BM + wr * 64 + fr) * DM + u.pn * BM + wc * 32 + 8 * fq;
        asm volatile("" : "+v"(off0));
#pragma unroll
        for (int ai = 0; ai < 2; ++ai)
#pragma unroll
            for (int m = 0; m < 4; ++m)
            {
#pragma unroll
                for (int bj = 0; bj < 2; ++bj) { const u32x4 w = *(const u32x4*)(ratio + (size_t)(unsigned)(off0 + (ai * HALF + m * 16) * DM + bj * HALF)); float f[8]; unpack8(w, f);
#pragma unroll
                    for (int e = 0; e < 4; ++e) { acc[ai][bj][m][0][e] *= f[e]; acc[ai][bj][m][1][e] *= f[4 + e]; } }
                if (m & 1) asm volatile("" ::: "memory"); }
    }
    __device__ __forceinline__ void operator()(const f32x4 (&acc)[2][2][4][2], const Unit& u, int wr, int wc, int fr, int fq) const {
        const int row0 = u.pm * BM + wr * 64 + fr, col0 = u.pn * BM + wc * 32 + 8 * fq;
#pragma unroll
        for (int ai = 0; ai < 2; ++ai)
#pragma unroll
            for (int m = 0; m < 4; ++m)
#pragma unroll
                for (int bj = 0; bj < 2; ++bj) { const size_t off = (size_t)(row0 + ai * HALF + m * 16) * DM + col0 + bj * HALF; const u32x4 w = *(const u32x4*)(gls + off); float f[8]; unpack8(w, f);
                    u32x4 o;
#pragma unroll
                    for (int e = 0; e < 2; ++e) { o[e] = cvt_pk_bf16(acc[ai][bj][m][0][2 * e] * f[2 * e], acc[ai][bj][m][0][2 * e + 1] * f[2 * e + 1]);
                        o[2 + e] = cvt_pk_bf16(acc[ai][bj][m][1][2 * e] * f[4 + 2 * e], acc[ai][bj][m][1][2 * e + 1] * f[4 + 2 * e + 1]); }
                    *(u32x4*)(merged + off) = o; }
    }
};
struct EpiX1 {
    static constexpr bool PERM = false, HAS_MID = false;
    const float* x; float* x1;
    __device__ __forceinline__ void mid(f32x4 (&)[2][2][4][2], const Unit&, int, int, int, int) const {}
    __device__ __forceinline__ void operator()(const f32x4 (&acc)[2][2][4][2], const Unit& u, int wr, int wc, int fr, int fq) const {
        const int row0 = u.pm * BM + wr * 64 + fr, col0 = u.pn * BM + wc * 32 + 4 * fq;
#pragma unroll
        for (int ai = 0; ai < 2; ++ai)
#pragma unroll
            for (int m = 0; m < 4; ++m)
#pragma unroll
                for (int bj = 0; bj < 2; ++bj)
#pragma unroll
                    for (int n = 0; n < 2; ++n) { const size_t off = (size_t)(row0 + ai * HALF + m * 16) * DM + col0 + bj * HALF + n * 16; *(f32x4*)(x1 + off) = *(const f32x4*)(x + off) + acc[ai][bj][m][n]; }
    }
};
struct EpiAct {
    static constexpr bool PERM = true, HAS_MID = false;
    const float* bgu; bf16_t* act;
    __device__ __forceinline__ void mid(f32x4 (&)[2][2][4][2], const Unit&, int, int, int, int) const {}
    __device__ __forceinline__ void operator()(const f32x4 (&acc)[2][2][4][2], const Unit& u, int wr, int wc, int fr, int fq) const {
        const int row0 = u.pm * BM + wr * 64 + fr, j0 = u.pn * 128 + wc * 32 + 8 * fq;
        const float* bp = bgu + (size_t)u.e * 2048 + j0;
        const f32x4 bg0 = *(const f32x4*)bp, bg1 = *(const f32x4*)(bp + 4), bu0 = *(const f32x4*)(bp + 1024), bu1 = *(const f32x4*)(bp + 1028);
#pragma unroll
        for (int ai = 0; ai < 2; ++ai)
#pragma unroll
            for (int m = 0; m < 4; ++m) {
                float o[8];
#pragma unroll
                for (int e = 0; e < 4; ++e) {
                    float g = fminf(acc[ai][0][m][0][e] + bg0[e], 7.0f), uu = fminf(fmaxf(acc[ai][1][m][0][e] + bu0[e], -7.0f), 7.0f); o[e] = (uu + 1.0f) * (g * fsig(1.702f * g));
                    g = fminf(acc[ai][0][m][1][e] + bg1[e], 7.0f); uu = fminf(fmaxf(acc[ai][1][m][1][e] + bu1[e], -7.0f), 7.0f); o[4 + e] = (uu + 1.0f) * (g * fsig(1.702f * g)); }
                u32x4 w;
#pragma unroll
                for (int e = 0; e < 4; ++e) w[e] = cvt_pk_bf16(o[2 * e], o[2 * e + 1]);
                *(u32x4*)(act + (size_t)(row0 + ai * HALF + m * 16) * DE + j0) = w;
            }
    }
};
struct EpiY {
    static constexpr bool PERM = true, HAS_MID = false;
    const float* bd; bf16_t* y;
    __device__ __forceinline__ void mid(f32x4 (&)[2][2][4][2], const Unit&, int, int, int, int) const {}
    __device__ __forceinline__ void operator()(const f32x4 (&acc)[2][2][4][2], const Unit& u, int wr, int wc, int fr, int fq) const {
        const int row0 = u.pm * BM + wr * 64 + fr, col0 = u.pn * BM + wc * 32 + 8 * fq;
#pragma unroll
        for (int bj = 0; bj < 2; ++bj) {
            const float* bp = bd + (size_t)u.e * DM + col0 + bj * HALF; const f32x4 b0 = *(const f32x4*)bp, b1 = *(const f32x4*)(bp + 4);
#pragma unroll
            for (int ai = 0; ai < 2; ++ai)
#pragma unroll
                for (int m = 0; m < 4; ++m) { const f32x4 v0 = acc[ai][bj][m][0] + b0, v1 = acc[ai][bj][m][1] + b1; u32x4 w;
                    w[0] = cvt_pk_bf16(v0[0], v0[1]); w[1] = cvt_pk_bf16(v0[2], v0[3]); w[2] = cvt_pk_bf16(v1[0], v1[1]); w[3] = cvt_pk_bf16(v1[2], v1[3]);
                    *(u32x4*)(y + (size_t)(row0 + ai * HALF + m * 16) * DM + col0 + bj * HALF) = w; }
        }
    }
};
}

struct Frame {
    LAS unsigned char* lds; volatile LAS unsigned* MISC; unsigned* ctl;
    int tid, lane, wave, vcu, G;
    const float *x, *norm_mix_g, *w_in, *conv_w, *conv_b, *w_rg, *b_rg, *w_ig, *b_ig, *lam, *sinks, *w_attn_o, *w_lru_o, *w_out, *norm_ffn_g, *w_router, *b_router, *w_gu, *b_gu, *w_down, *b_down, *norm_final_g;
    const int* positions; float* out;
    unsigned char* ws;
    __device__ __forceinline__ bf16_t* Win_t() const { return (bf16_t*)(ws + WS_WIN); }
    __device__ __forceinline__ bf16_t* Wcat_t() const { return (bf16_t*)(ws + WS_WCAT); }
    __device__ __forceinline__ bf16_t* Wout_t() const { return (bf16_t*)(ws + WS_WOUT); }
    __device__ __forceinline__ bf16_t* Wgu_t() const { return (bf16_t*)(ws + WS_WGU); }
    __device__ __forceinline__ bf16_t* Wd_t() const { return (bf16_t*)(ws + WS_WD); }
    __device__ __forceinline__ bf16_t* Wrg_t() const { return (bf16_t*)(ws + WS_WRG); }
    __device__ __forceinline__ bf16_t* Wig_t() const { return (bf16_t*)(ws + WS_WIG); }
    __device__ __forceinline__ bf16_t* h() const { return (bf16_t*)(ws + WS_H); }
    __device__ __forceinline__ bf16_t* q() const { return (bf16_t*)(ws + WS_Q); }
    __device__ __forceinline__ bf16_t* k() const { return (bf16_t*)(ws + WS_K); }
    __device__ __forceinline__ bf16_t* v() const { return (bf16_t*)(ws + WS_V); }
    __device__ __forceinline__ bf16_t* xr() const { return (bf16_t*)(ws + WS_XR); }
    __device__ __forceinline__ bf16_t* yg() const { return (bf16_t*)(ws + WS_YG); }
    __device__ __forceinline__ bf16_t* ratio() const { return (bf16_t*)(ws + WS_RATIO); }
    __device__ __forceinline__ bf16_t* gls() const { return (bf16_t*)(ws + WS_GLS); }
    __device__ __forceinline__ bf16_t* ao() const { return (bf16_t*)(ws + WS_AO); }
    __device__ __forceinline__ bf16_t* merged() const { return (bf16_t*)(ws + WS_MERGED); }
    __device__ __forceinline__ bf16_t* h2() const { return (bf16_t*)(ws + WS_H2); }
    __device__ __forceinline__ bf16_t* act() const { return (bf16_t*)(ws + WS_ACT); }
    __device__ __forceinline__ bf16_t* y() const { return (bf16_t*)(ws + WS_Y); }
    __device__ __forceinline__ float* x1() const { return (float*)(ws + WS_X1); }
    __device__ __forceinline__ float* tok_w() const { return (float*)(ws + WS_TOKW); }
    __device__ __forceinline__ int* tok_e() const { return (int*)(ws + WS_TOKE); }
    __device__ __forceinline__ int* tok_p() const { return (int*)(ws + WS_TOKP); }
    __device__ __forceinline__ int* slot_tok() const { return (int*)(ws + WS_SLOT); }
};

__device__ __forceinline__ void p0_transpose_item(const float* W, int N, bf16_t* dst, int ldd, LAS float* scr, int k0, int n0, int lane) {
#pragma unroll 8
    for (int i = 0; i < 32; ++i) { const int kk = 2 * i + (lane >> 5); scr[kk * 33 + (lane & 31)] = W[(size_t)(k0 + kk) * N + n0 + (lane & 31)]; }
    asm volatile("s_waitcnt lgkmcnt(0)" ::: "memory");
    const int c = lane & 7;
#pragma unroll
    for (int j = 0; j < 4; ++j) { const int n = (lane >> 3) + 8 * j; const LAS float* s = scr + (8 * c) * 33 + n;
        u32x4 o; o.x = cvt_pk_bf16(s[0 * 33], s[1 * 33]); o.y = cvt_pk_bf16(s[2 * 33], s[3 * 33]); o.z = cvt_pk_bf16(s[4 * 33], s[5 * 33]); o.w = cvt_pk_bf16(s[6 * 33], s[7 * 33]);
        *(u32x4*)(dst + (size_t)n * ldd + k0 + 8 * c) = o; }
    asm volatile("s_waitcnt lgkmcnt(0)" ::: "memory");
}
__device__ __forceinline__ void p0_prologue(Frame& F) {
    LAS float* scr = (LAS float*)(F.lds + F.wave * 16384);
    const int gw = F.vcu * NWAVES + F.wave, NGW = F.G * NWAVES;
    constexpr int I_IN = 16 * 120, I_AO = 8 * 32, I_OUT = 16 * 32, I_GU = 16 * 64 * NE, I_D = 16 * 32 * NE, I_G = 2 * LH;
    constexpr int NITEMS = I_IN + 2 * I_AO + I_OUT + I_GU + I_D + 2 * I_G;
    for (int it = gw; it < NITEMS; it += NGW) {
        int r = it;
        if (r < I_GU) { const int e = r / 1024, rr = r % 1024, kb = rr / 64, nb = rr % 64; p0_transpose_item(F.w_gu + (size_t)e * DM * 2048, 2048, F.Wgu_t() + ((size_t)e * 2048 + gu_inv(32 * nb)) * DM, DM, scr, 64 * kb, 32 * nb, F.lane); continue; } r -= I_GU;
        if (r < I_D) { const int e = r / 512, rr = r % 512, kb = rr / 32, nb = rr % 32; p0_transpose_item(F.w_down + (size_t)e * DE * DM, DM, F.Wd_t() + ((size_t)e * DM + 32 * nb) * DE, DE, scr, 64 * kb, 32 * nb, F.lane); continue; } r -= I_D;
        if (r < I_IN) { const int kb = r / 120, nb = r % 120; p0_transpose_item(F.w_in, INW, F.Win_t() + (size_t)g1_inv(32 * nb) * DM, DM, scr, 64 * kb, 32 * nb, F.lane); continue; } r -= I_IN;
        if (r < I_AO) { const int kb = r / 32, nb = r % 32; p0_transpose_item(F.w_attn_o, DM, F.Wcat_t() + (size_t)(32 * nb) * DM, DM, scr, 64 * kb, 32 * nb, F.lane); continue; } r -= I_AO;
        if (r < I_AO) { const int kb = r / 32, nb = r % 32; p0_transpose_item(F.w_lru_o, DM, F.Wcat_t() + (size_t)(32 * nb) * DM + 512, DM, scr, 64 * kb, 32 * nb, F.lane); continue; } r -= I_AO;
        if (r < I_OUT) { const int kb = r / 32, nb = r % 32; p0_transpose_item(F.w_out, DM, F.Wout_t() + (size_t)(32 * nb) * DM, DM, scr, 64 * kb, 32 * nb, F.lane); continue; } r -= I_OUT;
        if (r < I_G) { const int hh = r / 2, nb = r % 2; p0_transpose_item(F.w_rg + hh * 4096, 64, F.Wrg_t() + hh * 4096 + (32 * nb) * 64, 64, scr, 0, 32 * nb, F.lane); continue; } r -= I_G;
        { const int hh = r / 2, nb = r % 2; p0_transpose_item(F.w_ig + hh * 4096, 64, F.Wig_t() + hh * 4096 + (32 * nb) * 64, 64, scr, 0, 32 * nb, F.lane); }
    }
    f32x4 gv[4];
#pragma unroll
    for (int j = 0; j < 4; ++j) gv[j] = *(const f32x4*)(F.norm_mix_g + 4 * F.lane + 256 * j);
    for (int m = gw; m < NTOK; m += NGW) {
        const f32x4* xr = (const f32x4*)(F.x + (size_t)m * DM) + F.lane; f32x4 v[4]; float s = 0.f;
#pragma unroll
        for (int j = 0; j < 4; ++j) { v[j] = xr[64 * j]; s += (v[j].x * v[j].x + v[j].y * v[j].y) + (v[j].z * v[j].z + v[j].w * v[j].w); }
        const float rs = rsqrtf(wave_sum(s) * (1.0f / DM) + 1e-6f);
        unsigned long long* o8 = (unsigned long long*)(F.h() + (size_t)m * DM) + F.lane;
#pragma unroll
        for (int j = 0; j < 4; ++j) o8[64 * j] = (unsigned long long)cvt_pk_bf16(v[j].x * rs * gv[j].x, v[j].y * rs * gv[j].y) | ((unsigned long long)cvt_pk_bf16(v[j].z * rs * gv[j].z, v[j].w * rs * gv[j].w) << 32);
    }
}

__device__ __forceinline__ s16x4 vtr(const LAS unsigned char* p) { typedef short v4i16_t __attribute__((ext_vector_type(4))); return __builtin_bit_cast(s16x4, __builtin_amdgcn_ds_read_tr16_b64_v4i16((LAS v4i16_t*)p)); }
constexpr int AT_KS = 0, AT_VS = 36864, AT_LS = 36864 + 32768;
__device__ __forceinline__ void attn_unit(Frame& F, int unit) {
    const int b = unit >> 5, kvh = (unit >> 4) & 1, qb = unit & 15;
    const int tid = F.tid, lane = F.lane, wid = F.wave, hi = lane >> 5, iq = lane & 31;
    const size_t n0 = (size_t)b * SEQ + 128 * qb;
    LAS unsigned char* Ks = F.lds + AT_KS; LAS unsigned char* Vs = F.lds + AT_VS; LAS float* Ls = (LAS float*)(F.lds + AT_LS) + wid * 32;
#pragma unroll
    for (int i = 0; i < 4; ++i) {
        const int ch = tid + 512 * i, key = ch >> 3, c = ch & 7; const bool valid = (qb > 0) || (key >= 128);
        u32x4 kv = (u32x4){0u, 0u, 0u, 0u}, vv = (u32x4){0u, 0u, 0u, 0u};
        if (valid) { const size_t tok = n0 - 128 + key; kv = *(const u32x4*)(F.k() + tok * KVW + kvh * 64 + c * 8); vv = *(const u32x4*)(F.v() + tok * KVW + kvh * 64 + c * 8); }
        *(LAS u32x4*)(Ks + key * 144 + c * 16) = kv;
        *(LAS u32x4*)(Vs + ((key >> 3) * 2 + (c >> 2)) * 512 + (key & 7) * 64 + (c & 3) * 16) = vv;
    }
    __syncthreads();
    const int g = wid >> 1, qh = wid & 1, hq = kvh * 4 + g;
    const float sink2 = F.sinks[hq] * 1.4426950408889634f; const float c2 = 0.125f * 1.4426950408889634f;
    const int voff = (4 * hi + ((lane & 15) >> 2)) * 64 + ((lane >> 4) & 1) * 32 + (lane & 3) * 8;
#pragma unroll 1
    for (int sb = 0; sb < 2; ++sb) {
        const int s1 = 2 * qh + sb; const size_t nq = n0 + 32 * s1 + iq;
        bf16x8 qf[4];
#pragma unroll
        for (int s = 0; s < 4; ++s) qf[s] = *(const bf16x8*)(F.q() + nq * AW + hq * 64 + 16 * s + 8 * hi);
        f32x16 p[5];
#pragma unroll
        for (int tt = 0; tt < 5; ++tt) {
            p[tt] = (f32x16){0.f, 0.f, 0.f, 0.f, 0.f, 0.f, 0.f, 0.f, 0.f, 0.f, 0.f, 0.f, 0.f, 0.f, 0.f, 0.f};
#pragma unroll
            for (int s = 0; s < 4; ++s) { const bf16x8 kf = *(const LAS bf16x8*)(Ks + (32 * (s1 + tt) + iq) * 144 + (16 * s + 8 * hi) * 2); p[tt] = __builtin_amdgcn_mfma_f32_32x32x16_bf16(kf, qf[s], p[tt], 0, 0, 0); }
        }
        float mx = sink2;
#pragma unroll
        for (int tt = 0; tt < 5; ++tt) {
            const bool tile_ok = (qb > 0) || (s1 + tt >= 4);
#pragma unroll
            for (int r = 0; r < 16; ++r) { const int kk = crow(r, hi); bool ok = tile_ok; if (tt == 0) ok = ok && (kk >= iq + 1); if (tt == 4) ok = ok && (kk <= iq);
                const float sc = ok ? p[tt][r] * c2 : -INFINITY; p[tt][r] = sc; mx = fmaxf(mx, sc); }
        }
        mx = fmaxf(mx, __shfl_xor(mx, 32));
        float l = 0.f;
#pragma unroll
        for (int tt = 0; tt < 5; ++tt)
#pragma unroll
            for (int r = 0; r < 16; ++r) { const float e = __builtin_amdgcn_exp2f(p[tt][r] - mx); p[tt][r] = e; l += e; }
        l += __shfl_xor(l, 32); l += __builtin_amdgcn_exp2f(sink2 - mx);
        f32x16 o[2];
        o[0] = (f32x16){0.f, 0.f, 0.f, 0.f, 0.f, 0.f, 0.f, 0.f, 0.f, 0.f, 0.f, 0.f, 0.f, 0.f, 0.f, 0.f}; o[1] = o[0];
#pragma unroll
        for (int tt = 0; tt < 5; ++tt)
#pragma unroll
            for (int s2 = 0; s2 < 2; ++s2) {
                u32x4 pw;
#pragma unroll
                for (int e = 0; e < 4; ++e) pw[e] = cvt_pk_bf16(p[tt][8 * s2 + 2 * e], p[tt][8 * s2 + 2 * e + 1]);
                const bf16x8 pa = __builtin_bit_cast(bf16x8, pw);
                const int sub = 4 * (s1 + tt) + 2 * s2;
#pragma unroll
                for (int db = 0; db < 2; ++db) {
                    const s16x4 lo = vtr(Vs + (sub * 2 + db) * 512 + voff), hi4 = vtr(Vs + ((sub + 1) * 2 + db) * 512 + voff);
                    const bf16x8 vb = (bf16x8){lo[0], lo[1], lo[2], lo[3], hi4[0], hi4[1], hi4[2], hi4[3]};
                    o[db] = __builtin_amdgcn_mfma_f32_32x32x16_bf16(pa, vb, o[db], 0, 0, 0);
                }
            }
        if (hi == 0) Ls[iq] = __builtin_amdgcn_rcpf(l);
        asm volatile("s_waitcnt lgkmcnt(0)" ::: "memory");
#pragma unroll
        for (int r = 0; r < 16; ++r) { const int qr = crow(r, hi); const float il = Ls[qr]; bf16_t* op = F.ao() + (n0 + 32 * s1 + qr) * DM + hq * 64 + iq;
            op[0] = f2bf(o[0][r] * il); op[32] = f2bf(o[1][r] * il); }
        asm volatile("s_waitcnt lgkmcnt(0)" ::: "memory");
    }
    __syncthreads();
}
constexpr int LR_XA = 0, LR_AS = 18432, LR_US = LR_AS + 32768, LR_CH = LR_US + 32768, LR_HC = LR_CH + 4096;
__device__ __forceinline__ void lru_unit(Frame& F, int unit) {
    const int b = unit >> 3, hh = unit & 7, C0 = 64 * hh;
    const int tid = F.tid, lane = F.lane, wid = F.wave, hi = lane >> 5;
    LAS unsigned char* XA = F.lds + LR_XA; LAS float* AS = (LAS float*)(F.lds + LR_AS); LAS float* US = (LAS float*)(F.lds + LR_US); LAS float* CH = (LAS float*)(F.lds + LR_CH); LAS float* HC = (LAS float*)(F.lds + LR_HC);
    const int tb = wid >> 1, cb = wid & 1, cm = 32 * cb + (lane & 31), Cm = C0 + cm;
    bf16x8 brg[4], big[4];
#pragma unroll
    for (int s = 0; s < 4; ++s) { brg[s] = *(const bf16x8*)(F.Wrg_t() + hh * 4096 + cm * 64 + 16 * s + 8 * hi); big[s] = *(const bf16x8*)(F.Wig_t() + hh * 4096 + cm * 64 + 16 * s + 8 * hi); }
    const float brg_b = F.b_rg[Cm], big_b = F.b_ig[Cm], sp8 = 8.0f * log1pf(__expf(-F.lam[Cm])) * 1.4426950408889634f;
    const int cs = tid & 63, js = wid, Cs = C0 + cs;
    const int tokc = tid >> 2, cq = tid & 3, Cq = C0 + 16 * cq;
    if (tid < 64) HC[tid] = 0.f;
    u32x4 xn[4][2];
    {
#pragma unroll
        for (int j = 0; j < 4; ++j) { const int tt = tokc - 3 + j;
#pragma unroll
            for (int hf = 0; hf < 2; ++hf) xn[j][hf] = tt >= 0 ? *(const u32x4*)(F.xr() + ((size_t)b * SEQ + tt) * LW + Cq + 8 * hf) : (u32x4){0u, 0u, 0u, 0u}; }
    }
#pragma unroll 1
    for (int tile = 0; tile < SEQ / 128; ++tile) {
        const int t0 = 128 * tile;
        {
            float xc[16];
#pragma unroll
            for (int e4 = 0; e4 < 4; ++e4) { const f32x4 cbv = *(const f32x4*)(F.conv_b + Cq + 4 * e4); xc[4 * e4] = cbv.x; xc[4 * e4 + 1] = cbv.y; xc[4 * e4 + 2] = cbv.z; xc[4 * e4 + 3] = cbv.w; }
#pragma unroll
            for (int j = 0; j < 4; ++j) { float xf[16]; { float t8[8]; unpack8(xn[j][0], t8);
#pragma unroll
                    for (int e = 0; e < 8; ++e) xf[e] = t8[e]; unpack8(xn[j][1], t8);
#pragma unroll
                    for (int e = 0; e < 8; ++e) xf[8 + e] = t8[e]; }
#pragma unroll
                for (int e4 = 0; e4 < 4; ++e4) { const f32x4 w = *(const f32x4*)(F.conv_w + j * LW + Cq + 4 * e4); xc[4 * e4] += xf[4 * e4] * w.x; xc[4 * e4 + 1] += xf[4 * e4 + 1] * w.y; xc[4 * e4 + 2] += xf[4 * e4 + 2] * w.z; xc[4 * e4 + 3] += xf[4 * e4 + 3] * w.w; } }
            u32x4 w0, w1;
#pragma unroll
            for (int e = 0; e < 4; ++e) { w0[e] = cvt_pk_bf16(xc[2 * e], xc[2 * e + 1]); w1[e] = cvt_pk_bf16(xc[8 + 2 * e], xc[8 + 2 * e + 1]); }
            *(LAS u32x4*)(XA + tokc * 144 + cq * 32) = w0; *(LAS u32x4*)(XA + tokc * 144 + cq * 32 + 16) = w1;
        }
        if (tile + 1 < SEQ / 128) {
#pragma unroll
            for (int j = 0; j < 4; ++j) { const size_t tt = (size_t)b * SEQ + t0 + 128 + tokc - 3 + j;
                xn[j][0] = *(const u32x4*)(F.xr() + tt * LW + Cq); xn[j][1] = *(const u32x4*)(F.xr() + tt * LW + Cq + 8); }
        }
        bf16_t ygv[16];
#pragma unroll
        for (int tt = 0; tt < 16; ++tt) ygv[tt] = F.yg()[((size_t)b * SEQ + t0 + 16 * js + tt) * LW + Cs];
        __syncthreads();
        {
            f32x16 drg = (f32x16){0.f, 0.f, 0.f, 0.f, 0.f, 0.f, 0.f, 0.f, 0.f, 0.f, 0.f, 0.f, 0.f, 0.f, 0.f, 0.f}, dig = drg;
#pragma unroll
            for (int s = 0; s < 4; ++s) { const bf16x8 af = *(const LAS bf16x8*)(XA + (32 * tb + (lane & 31)) * 144 + (16 * s + 8 * hi) * 2);
                drg = __builtin_amdgcn_mfma_f32_32x32x16_bf16(af, brg[s], drg, 0, 0, 0); dig = __builtin_amdgcn_mfma_f32_32x32x16_bf16(af, big[s], dig, 0, 0, 0); }
#pragma unroll
            for (int r = 0; r < 16; ++r) { const int t = 32 * tb + crow(r, hi);
                const float xcv = bf2f(*(const LAS bf16_t*)(XA + t * 144 + cm * 2));
                const float rg = fsig(drg[r] + brg_b), ig = fsig(dig[r] + big_b);
                const float la2 = -rg * sp8;
                const float a = __builtin_amdgcn_exp2f(la2);
                const float x2 = 2.0f * 0.6931471805599453f * la2;
                const float om = x2 > -0.3f ? -x2 * (1.0f + x2 * (0.5f + x2 * (0.16666667f + x2 * (0.041666668f + x2 * 0.008333334f)))) : 1.0f - a * a;
                AS[t * 64 + cm] = a; US[t * 64 + cm] = sqrtf(om) * (ig * xcv); }
        }
        __syncthreads();
        float av[16], uv[16]; float Ap = 1.f, Hp = 0.f;
#pragma unroll
        for (int tt = 0; tt < 16; ++tt) { av[tt] = AS[(16 * js + tt) * 64 + cs]; uv[tt] = US[(16 * js + tt) * 64 + cs]; }
#pragma unroll
        for (int tt = 0; tt < 16; ++tt) { Hp = av[tt] * Hp + uv[tt]; Ap *= av[tt]; }
        CH[js * 64 + cs] = Ap; CH[512 + js * 64 + cs] = Hp;
        __syncthreads();
        float hcur = HC[cs];
        for (int jj = 0; jj < js; ++jj) hcur = CH[jj * 64 + cs] * hcur + CH[512 + jj * 64 + cs];
#pragma unroll
        for (int tt = 0; tt < 16; ++tt) { hcur = av[tt] * hcur + uv[tt]; F.ao()[((size_t)b * SEQ + t0 + 16 * js + tt) * DM + 512 + Cs] = f2bf(hcur * bf2f(ygv[tt])); }
        __syncthreads();
        if (js == 7) HC[cs] = hcur;
    }
    __syncthreads();
}
__device__ __forceinline__ void p2_mixers(Frame& F) {
    constexpr int NLRU = NB * LH, NATT = NB * NKVH * (SEQ / 128);
    for (;;) {
        if (F.tid == 0) F.MISC[MW_Q] = atomicAdd(&F.ctl[CW_QUEUE], 1u);
        __syncthreads();
        const int item = (int)F.MISC[MW_Q];
        __syncthreads();
        if (item >= NLRU + NATT) break;
        if (item < NLRU) lru_unit(F, item); else attn_unit(F, item - NLRU);
    }
}

__device__ __forceinline__ void moe_tables(Frame& F) {
    if (F.tid == 0) { int acc = 0; for (int e = 0; e < NE; ++e) { const int c = (int)__hip_atomic_load(&F.ctl[CW_GCOUNT + 64 * e], __ATOMIC_RELAXED, __HIP_MEMORY_SCOPE_AGENT); F.MISC[MW_TS + e] = (unsigned)acc; F.MISC[MW_CNT + e] = (unsigned)c; acc += (c + 255) >> 8; } F.MISC[MW_TS + NE] = (unsigned)acc; }
    __syncthreads();
}

__device__ __forceinline__ void p5_router(Frame& F) {
    LAS float* WT = (LAS float*)F.lds;
    LAS float* LG = (LAS float*)(F.lds + MISC_OFF) + MW_P5 + F.wave * 128;
    volatile LAS int* LCNT = (volatile LAS int*)(F.lds + MISC_OFF) + MW_P5 + 1024;
    volatile LAS int* LBASE = LCNT + 32;
    LAS int* PE = (LAS int*)(F.lds + MISC_OFF) + MW_P5 + 1024 + 64;
    LAS float* PW = (LAS float*)(PE + 512);
    const int tid = F.tid, lane = F.lane, wid = F.wave;
    for (int i = 0; i < 64; ++i) { const int idx = tid + 512 * i, e = idx >> 10, kx = idx & 1023; WT[idx] = F.w_router[kx * NE + e]; }
    if (tid < 32) LCNT[tid] = 0;
    __syncthreads();
    const int rows_per = NTOK / F.G, row_base = F.vcu * rows_per;
    f32x4 gv[4];
#pragma unroll
    for (int j = 0; j < 4; ++j) gv[j] = *(const f32x4*)(F.norm_ffn_g + 4 * lane + 256 * j);
    for (int it = 0; it * 32 < rows_per; ++it) {
        const int r0 = row_base + it * 32 + wid * 4;
        f32x4 xv[4][4]; float rs[4];
#pragma unroll
        for (int rr = 0; rr < 4; ++rr) { float s = 0.f;
#pragma unroll
            for (int j = 0; j < 4; ++j) { xv[rr][j] = *((const f32x4*)(F.x1() + (size_t)(r0 + rr) * DM) + lane + 64 * j); s += (xv[rr][j].x * xv[rr][j].x + xv[rr][j].y * xv[rr][j].y) + (xv[rr][j].z * xv[rr][j].z + xv[rr][j].w * xv[rr][j].w); }
            rs[rr] = rsqrtf(wave_sum(s) * (1.0f / DM) + 1e-6f);
            unsigned long long* o8 = (unsigned long long*)(F.h2() + (size_t)(r0 + rr) * DM) + lane;
#pragma unroll
            for (int j = 0; j < 4; ++j) { xv[rr][j] = xv[rr][j] * gv[j] * rs[rr];
                o8[64 * j] = (unsigned long long)cvt_pk_bf16(xv[rr][j].x, xv[rr][j].y) | ((unsigned long long)cvt_pk_bf16(xv[rr][j].z, xv[rr][j].w) << 32); } }
#define RSTEP(SRC, DST, NH, MASK) _Pragma("unroll") for (int i = 0; i < NH; ++i) { const bool up = (lane & MASK) != 0; const float send = up ? SRC[i] : SRC[i + NH]; const float keep = up ? SRC[i + NH] : SRC[i]; DST[i] = keep + __shfl_xor(send, MASK); }
#pragma unroll 1
        for (int eh = 0; eh < 2; ++eh) {
            float acc[64];
#pragma unroll
            for (int i = 0; i < 64; ++i) acc[i] = 0.f;
#pragma unroll
            for (int j = 0; j < 4; ++j)
#pragma unroll
                for (int e = 0; e < 16; ++e) { const f32x4 w = *(const LAS f32x4*)(WT + (eh * 16 + e) * 1024 + 4 * lane + 256 * j);
#pragma unroll
                    for (int rr = 0; rr < 4; ++rr) acc[rr * 16 + e] += (xv[rr][j].x * w.x + xv[rr][j].y * w.y) + (xv[rr][j].z * w.z + xv[rr][j].w * w.w); }
            float t1[32], t2[16], t3[8], t4[4], t5[2], t6[1];
            RSTEP(acc, t1, 32, 32) RSTEP(t1, t2, 16, 16) RSTEP(t2, t3, 8, 8) RSTEP(t3, t4, 4, 4) RSTEP(t4, t5, 2, 2) RSTEP(t5, t6, 1, 1)
            { const int rr = lane >> 4, e = eh * 16 + (lane & 15); LG[rr * 32 + e] = t6[0] + F.b_router[e]; }
        }
#undef RSTEP
        asm volatile("s_waitcnt lgkmcnt(0)" ::: "memory");
        if (lane < 4) {
            const LAS float* lg = LG + lane * 32; unsigned used = 0; float tv[4]; int te[4];
#pragma unroll
            for (int kk = 0; kk < 4; ++kk) { float best = -3.0e38f; int bi = 0;
                for (int e = 0; e < NE; ++e) { const float vv = lg[e]; if (!((used >> e) & 1u) && vv > best) { best = vv; bi = e; } }
                used |= 1u << bi; tv[kk] = best; te[kk] = bi; }
            float ex[4], sum = 0.f;
#pragma unroll
            for (int kk = 0; kk < 4; ++kk) { ex[kk] = __expf(tv[kk] - tv[0]); sum += ex[kk]; }
            const float inv = 1.0f / sum; const int lr = it * 32 + wid * 4 + lane;
#pragma unroll
            for (int kk = 0; kk < 4; ++kk) { const int lp = __hip_atomic_fetch_add((LAS int*)&LCNT[te[kk]], 1, __ATOMIC_RELAXED, __HIP_MEMORY_SCOPE_WORKGROUP); PE[(lr & 127) * 4 + kk] = te[kk] | (lp << 8); PW[(lr & 127) * 4 + kk] = ex[kk] * inv; }
        }
        asm volatile("s_waitcnt lgkmcnt(0)" ::: "memory");
        if ((it & 3) == 3 || (it + 1) * 32 >= rows_per) {
            __syncthreads();
            if (tid < 32) { const int c = LCNT[tid]; LBASE[tid] = c ? (int)atomicAdd(&F.ctl[CW_GCOUNT + 64 * tid], (unsigned)c) : 0; }
            __syncthreads();
            const int nrows = ((it & 3) + 1) * 32, rowf = row_base + (it & ~3) * 32;
            if (tid < nrows * 4) { const int pe = PE[tid], e = pe & 255, lp = pe >> 8, pos = LBASE[e] + lp, row = rowf + (tid >> 2);
                F.tok_e()[row * 4 + (tid & 3)] = e; F.tok_w()[row * 4 + (tid & 3)] = PW[tid]; F.tok_p()[row * 4 + (tid & 3)] = pos; F.slot_tok()[(size_t)e * CAP + pos] = row; }
            __syncthreads();
            if (tid < 32) LCNT[tid] = 0;
            __syncthreads();
        }
    }
}

__device__ __forceinline__ void p8_final(Frame& F) {
    const int gw = F.vcu * NWAVES + F.wave, NGW = F.G * NWAVES, lane = F.lane;
    f32x4 gv[4];
#pragma unroll
    for (int j = 0; j < 4; ++j) gv[j] = *(const f32x4*)(F.norm_final_g + 4 * lane + 256 * j);
    for (int m = gw; m < NTOK; m += NGW) {
        f32x4 v[4];
#pragma unroll
        for (int j = 0; j < 4; ++j) v[j] = *((const f32x4*)(F.x1() + (size_t)m * DM) + lane + 64 * j);
#pragma unroll
        for (int kk = 0; kk < 4; ++kk) {
            const int e = F.tok_e()[m * 4 + kk]; const float w = F.tok_w()[m * 4 + kk]; const size_t yrow = (size_t)256 * F.MISC[MW_TS + e] + F.tok_p()[m * 4 + kk];
            const unsigned long long* yp = (const unsigned long long*)(F.y() + yrow * DM) + lane;
#pragma unroll
            for (int j = 0; j < 4; ++j) { const unsigned long long t = yp[64 * j]; const unsigned lo = (unsigned)t, hi = (unsigned)(t >> 32);
                v[j].x += w * __uint_as_float(lo << 16); v[j].y += w * __uint_as_float(lo & 0xffff0000u); v[j].z += w * __uint_as_float(hi << 16); v[j].w += w * __uint_as_float(hi & 0xffff0000u); }
        }
        float s = 0.f;
#pragma unroll
        for (int j = 0; j < 4; ++j) s += (v[j].x * v[j].x + v[j].y * v[j].y) + (v[j].z * v[j].z + v[j].w * v[j].w);
        const float rs = rsqrtf(wave_sum(s) * (1.0f / DM) + 1e-6f);
#pragma unroll
        for (int j = 0; j < 4; ++j) *((f32x4*)(F.out + (size_t)m * DM) + lane + 64 * j) = v[j] * rs * gv[j];
    }
}

constexpr int NPHASE = 9;
struct Args { const void* in[23]; float* out; unsigned char* ws; int ph_lo, ph_hi; };
__global__ void __launch_bounds__(NWAVES * 64, 2) mega_fwd(Args args) {
    extern __shared__ __attribute__((aligned(16))) unsigned char lds_raw[];
    Frame F;
    F.lds = (LAS unsigned char*)lds_raw; F.MISC = (volatile LAS unsigned*)(F.lds + MISC_OFF);
    F.tid = threadIdx.x; F.lane = F.tid & 63; F.wave = __builtin_amdgcn_readfirstlane(F.tid >> 6);
    F.G = gridDim.x; { const int bx = blockIdx.x; F.vcu = (F.G % 8 == 0) ? (bx % 8) * (F.G / 8) + bx / 8 : bx; }
    unsigned char* ws = args.ws; F.ctl = (unsigned*)(ws + WS_CTL);
    F.x = (const float*)args.in[0]; F.positions = (const int*)args.in[1]; F.norm_mix_g = (const float*)args.in[2]; F.w_in = (const float*)args.in[3];
    F.conv_w = (const float*)args.in[4]; F.conv_b = (const float*)args.in[5]; F.w_rg = (const float*)args.in[6]; F.b_rg = (const float*)args.in[7];
    F.w_ig = (const float*)args.in[8]; F.b_ig = (const float*)args.in[9]; F.lam = (const float*)args.in[10]; F.sinks = (const float*)args.in[11];
    F.w_attn_o = (const float*)args.in[12]; F.w_lru_o = (const float*)args.in[13]; F.w_out = (const float*)args.in[14]; F.norm_ffn_g = (const float*)args.in[15];
    F.w_router = (const float*)args.in[16]; F.b_router = (const float*)args.in[17]; F.w_gu = (const float*)args.in[18]; F.b_gu = (const float*)args.in[19];
    F.w_down = (const float*)args.in[20]; F.b_down = (const float*)args.in[21]; F.norm_final_g = (const float*)args.in[22]; F.out = args.out;
    F.ws = ws;
    for (int u = F.tid; u < (LDS_BYTES - MISC_OFF) / 4; u += NWAVES * 64) ((LAS unsigned*)(F.lds + MISC_OFF))[u] = 0u;
    __syncthreads();
    const int lo = args.ph_lo, hi = args.ph_hi;
    const bool multi = (hi - lo) > 1;
    XcdBarrier bar; bar.bar = F.ctl + CW_BAR; bar.x = 0; bar.st = nullptr;
    if (multi) bar = xcd_barrier_post(F.ctl + CW_BAR, F.MISC + 8);
#ifndef PH_ONLY
#define PH_ONLY -1
#endif
#define IN(k) ((PH_ONLY < 0 || PH_ONLY == (k)) && lo <= (k) && (k) < hi)
#define SEAM(k) do { if (IN(k) && IN((k) + 1)) xcd_barrier(bar); } while (0)
    if (IN(0)) { p0_prologue(F); SEAM(0); }
    if (IN(1)) { pg8::DenseSched S; S.init(F.h(), F.Win_t(), NTOK, INW, F.G, (int)blockIdx.x);
        pg8::EpiG1 E{F.positions, F.q(), F.k(), F.v(), F.xr(), F.yg(), F.ratio(), F.gls()};
        pg8::gemm_phase<pg8::EpiG1, pg8::DenseSched, true>(F.lds, S, E); SEAM(1); }
    if (IN(2)) { p2_mixers(F); SEAM(2); }
    if (IN(3)) { pg8::DenseSched S; S.init(F.ao(), F.Wcat_t(), NTOK, DM, F.G, (int)blockIdx.x);
        pg8::EpiMerged E{F.ratio(), F.gls(), F.merged()};
        pg8::gemm_phase<pg8::EpiMerged, pg8::DenseSched, true>(F.lds, S, E); SEAM(3); }
    if (IN(4)) { pg8::DenseSched S; S.init(F.merged(), F.Wout_t(), NTOK, DM, F.G, (int)blockIdx.x);
        pg8::EpiX1 E{F.x, F.x1()};
        pg8::gemm_phase<pg8::EpiX1, pg8::DenseSched, true>(F.lds, S, E); SEAM(4); }
    if (IN(5)) { p5_router(F); SEAM(5); }
    if (IN(6)) { moe_tables(F);
        pg8::MoeSched<true> S; S.init(F.h2(), F.Wgu_t(), F.slot_tok(), (const volatile LAS int*)(F.MISC + MW_TS), (const volatile LAS int*)(F.MISC + MW_CNT), 8, F.G, (int)blockIdx.x);
        pg8::EpiAct E{F.b_gu, F.act()};
        pg8::gemm_phase<pg8::EpiAct, pg8::MoeSched<true>, true>(F.lds, S, E); SEAM(6); }
    if (IN(7)) { moe_tables(F);
        pg8::MoeSched<false> S; S.init(F.act(), F.Wd_t(), F.slot_tok(), (const volatile LAS int*)(F.MISC + MW_TS), (const volatile LAS int*)(F.MISC + MW_CNT), 4, F.G, (int)blockIdx.x);
        pg8::EpiY E{F.b_down, F.y()};
        pg8::gemm_phase<pg8::EpiY, pg8::MoeSched<false>, true>(F.lds, S, E); SEAM(7); }
    if (IN(8)) { moe_tables(F); p8_final(F); }
#undef IN
#undef SEAM
}

#ifndef OPT_MASK
#define OPT_MASK 0x1FF
#define FORCE_MULTI 0
#endif
extern "C" void kernel_launch(void* const* d_in, const int* in_sizes, int n_in, void* d_out, int out_size, void* d_ws, size_t ws_size, hipStream_t stream) {
    if (n_in != 23 || ws_size < WS_END) { fprintf(stderr, "kernel_launch: unexpected inputs (%d) or workspace (%zu)\n", n_in, ws_size); return; }
    static int grid = 0;
    if (grid == 0) {
        int dev = 0, cus = 0;
        if (hipGetDevice(&dev) != hipSuccess || hipDeviceGetAttribute(&cus, hipDeviceAttributeMultiprocessorCount, dev) != hipSuccess) { grid = -1; return; }
        if (hipFuncSetAttribute((const void*)mega_fwd, hipFuncAttributeMaxDynamicSharedMemorySize, LDS_BYTES) != hipSuccess) { fprintf(stderr, "kernel_launch: hipFuncSetAttribute failed\n"); grid = -1; return; }
        int per_cu = 0; (void)hipOccupancyMaxActiveBlocksPerMultiprocessor(&per_cu, (const void*)mega_fwd, NWAVES * 64, LDS_BYTES); (void)hipGetLastError();
        grid = 256; if (cus != 256 || per_cu < 1) fprintf(stderr, "kernel_launch: note: %d CUs, occupancy %d\n", cus, per_cu);
    }
    if (grid < 0) return;
    const float* x = (const float*)d_in[0]; const int* positions = (const int*)d_in[1]; const float* norm_mix_g = (const float*)d_in[2]; const float* w_in = (const float*)d_in[3];
    const float* conv_w = (const float*)d_in[4]; const float* conv_b = (const float*)d_in[5]; const float* w_rg = (const float*)d_in[6]; const float* b_rg = (const float*)d_in[7];
    const float* w_ig = (const float*)d_in[8]; const float* b_ig = (const float*)d_in[9]; const float* lam = (const float*)d_in[10]; const float* sinks = (const float*)d_in[11];
    const float* w_attn_o = (const float*)d_in[12]; const float* w_lru_o = (const float*)d_in[13]; const float* w_out = (const float*)d_in[14]; const float* norm_ffn_g = (const float*)d_in[15];
    const float* w_router = (const float*)d_in[16]; const float* b_router = (const float*)d_in[17]; const float* w_gu = (const float*)d_in[18]; const float* b_gu = (const float*)d_in[19];
    const float* w_down = (const float*)d_in[20]; const float* b_down = (const float*)d_in[21]; const float* norm_final_g = (const float*)d_in[22];
    unsigned char* ws = (unsigned char*)d_ws; float* out = (float*)d_out;
    unsigned* ctl = (unsigned*)(ws + WS_CTL);
    bf16_t* Win_t = (bf16_t*)(ws + WS_WIN); bf16_t* Wcat_t = (bf16_t*)(ws + WS_WCAT); bf16_t* Wout_t = (bf16_t*)(ws + WS_WOUT); bf16_t* Wgu_t = (bf16_t*)(ws + WS_WGU); bf16_t* Wd_t = (bf16_t*)(ws + WS_WD);
    bf16_t* Wrg_t = (bf16_t*)(ws + WS_WRG); bf16_t* Wig_t = (bf16_t*)(ws + WS_WIG);
    float* x1 = (float*)(ws + WS_X1); bf16_t* h2 = (bf16_t*)(ws + WS_H2); bf16_t* act = (bf16_t*)(ws + WS_ACT); bf16_t* y = (bf16_t*)(ws + WS_Y);
    bf16_t* h = (bf16_t*)(ws + WS_H); bf16_t* q = (bf16_t*)(ws + WS_Q); bf16_t* k = (bf16_t*)(ws + WS_K); bf16_t* v = (bf16_t*)(ws + WS_V); bf16_t* xr = (bf16_t*)(ws + WS_XR); bf16_t* yg = (bf16_t*)(ws + WS_YG);
    bf16_t* ratio = (bf16_t*)(ws + WS_RATIO); bf16_t* gls = (bf16_t*)(ws + WS_GLS); bf16_t* ao = (bf16_t*)(ws + WS_AO); bf16_t* merged = (bf16_t*)(ws + WS_MERGED); float* xc = (float*)(ws + WS_XC);
    int* tok_e = (int*)(ws + WS_TOKE); float* tok_w = (float*)(ws + WS_TOKW); int* tok_p = (int*)(ws + WS_TOKP); int* slot_tok = (int*)(ws + WS_SLOT); float* logits = (float*)(ws + WS_LOGIT); float* rstd = (float*)(ws + WS_RSTD);

    (void)hipMemsetAsync(ws + WS_CTL, 0, CTL_BYTES, stream);
    Args a{};
    for (int i = 0; i < 23; ++i) a.in[i] = d_in[i];
    a.out = out; a.ws = ws;
#ifndef FORCE_MULTI
#define FORCE_MULTI 0
#endif
    if (OPT_MASK == 0x1FF && !FORCE_MULTI) { a.ph_lo = 0; a.ph_hi = NPHASE; hipLaunchKernelGGL(mega_fwd, dim3(grid), dim3(NWAVES * 64), LDS_BYTES, stream, a); return; }
    const int G = 2048, B = 256;
    for (int ph = 0; ph < NPHASE; ++ph) {
        if ((OPT_MASK >> ph) & 1) { a.ph_lo = ph; a.ph_hi = ph + 1; hipLaunchKernelGGL(mega_fwd, dim3(grid), dim3(NWAVES * 64), LDS_BYTES, stream, a); continue; }
        switch (ph) {
        case 0:
            nv_transpose<<<G, B, 0, stream>>>(w_in, DM, INW, Win_t, DM, 0, INW, 1, 1);
            nv_transpose<<<G, B, 0, stream>>>(w_attn_o, 512, DM, Wcat_t, DM, 0, DM, 0, 1);
            nv_transpose<<<G, B, 0, stream>>>(w_lru_o, 512, DM, Wcat_t, DM, 512, DM, 0, 1);
            nv_transpose<<<G, B, 0, stream>>>(w_out, DM, DM, Wout_t, DM, 0, DM, 0, 1);
            nv_transpose<<<G, B, 0, stream>>>(w_gu, DM, 2048, Wgu_t, DM, 0, 2048, 2, NE);
            nv_transpose<<<G, B, 0, stream>>>(w_down, DE, DM, Wd_t, DE, 0, DM, 0, NE);
            nv_transpose<<<G, B, 0, stream>>>(w_rg, 64, 64, Wrg_t, 64, 0, 64, 0, LH);
            nv_transpose<<<G, B, 0, stream>>>(w_ig, 64, 64, Wig_t, 64, 0, 64, 0, LH);
            nv_rmsnorm_bf16<<<G, B, 0, stream>>>(x, norm_mix_g, h, nullptr); break;
        case 1: nv_gemm1<<<G * 4, B, 0, stream>>>(h, Win_t, positions, q, k, v, xr, yg, ratio, gls); break;
        case 2:
            nv_attn<<<G, B, 0, stream>>>(q, k, v, sinks, ao);
            nv_conv<<<G, B, 0, stream>>>(xr, conv_w, conv_b, xc);
            nv_scan<<<NB * LW / 64, 64, 0, stream>>>(xc, w_rg, b_rg, w_ig, b_ig, lam, yg, ao); break;
        case 3: nv_merged<<<G * 4, B, 0, stream>>>(ao, Wcat_t, ratio, gls, merged); break;
        case 4: nv_wout<<<G * 4, B, 0, stream>>>(merged, Wout_t, x, x1); break;
        case 5:
            nv_rmsnorm_bf16<<<G, B, 0, stream>>>(x1, norm_ffn_g, h2, rstd);
            nv_logits<<<G, B, 0, stream>>>(x1, rstd, norm_ffn_g, w_router, b_router, logits);
            nv_topk<<<NTOK / 256, 256, 0, stream>>>(logits, ctl, tok_e, tok_w, tok_p, slot_tok); break;
        case 6: nv_moe1<<<G * 4, B, 0, stream>>>(ctl, slot_tok, h2, Wgu_t, b_gu, act); break;
        case 7: nv_moe2<<<G * 4, B, 0, stream>>>(ctl, act, Wd_t, b_down, y); break;
        case 8: nv_final<<<G, B, 0, stream>>>(ctl, x1, tok_e, tok_w, tok_p, y, norm_final_g, out); break;
        }
    }
}
```

```cpp
#include <hip/hip_runtime.h>
#include <stdint.h>
#include <stdio.h>

#ifndef Y_FP8
#define Y_FP8 1
#endif
#ifndef MOE_ORDER
#define MOE_ORDER 0
#endif
#ifndef MOE_FP8
#define MOE_FP8 1
#endif
constexpr float W8_SCALE = 32.0f, W8_INV = 1.0f / 32.0f;
typedef unsigned short bf16_t;
typedef unsigned u32x4 __attribute__((ext_vector_type(4)));

constexpr int NB = 16, SEQ = 2048, NTOK = NB * SEQ, DM = 1024;
constexpr int NQH = 8, NKVH = 2, HD = 64, AW = 512, KVW = 128, LW = 512, LH = 8, LB = 64;
constexpr int INW = 3840, NE = 32, TOPK = 4, DE = 1024;
constexpr int CAP = NTOK;
constexpr int MAXTILES = NTOK * TOPK / 256 + NE;
constexpr int MAXROWS = MAXTILES * 256;

constexpr size_t MiB = 1u << 20;
constexpr size_t WS_CTL = 0, CTL_BYTES = 65536;
constexpr size_t WS_WRG = 1 * MiB;
constexpr size_t WS_WIG = WS_WRG + 65536;
constexpr size_t WS_WRT = WS_WRG + 131072;
constexpr size_t WS_TOKE = 2 * MiB;
constexpr size_t WS_TOKW = 2 * MiB + 512 * 1024;
constexpr size_t WS_TOKP = 3 * MiB;
constexpr size_t WS_SLOT = 4 * MiB;
constexpr size_t WS_LOGIT = 8 * MiB;
constexpr size_t WS_RSTD = 12 * MiB;
constexpr size_t WS_WIN = 16 * MiB;
constexpr size_t WS_WCAT = 24 * MiB;
constexpr size_t WS_WOUT = 26 * MiB;
constexpr size_t WS_WGU = 28 * MiB;
constexpr size_t WS_WD = 156 * MiB;
constexpr size_t WS_X1 = 220 * MiB;
constexpr size_t WS_H2 = 348 * MiB;
constexpr size_t WS_ACT = 412 * MiB;
constexpr size_t WS_Y = 684 * MiB;
constexpr size_t WS_H = 412 * MiB;
constexpr size_t WS_Q = 476 * MiB;
constexpr size_t WS_K = 508 * MiB;
constexpr size_t WS_V = 516 * MiB;
constexpr size_t WS_XR = 524 * MiB;
constexpr size_t WS_YG = 556 * MiB;
constexpr size_t WS_RATIO = 588 * MiB;
constexpr size_t WS_GLS = 652 * MiB;
constexpr size_t WS_AO = 716 * MiB;
constexpr size_t WS_MERGED = 780 * MiB;
constexpr size_t WS_XC = 844 * MiB;
constexpr size_t WS_END = 956 * MiB;
constexpr int CW_GCOUNT = 8192;

__device__ __forceinline__ float bf2f(bf16_t b) { return __uint_as_float(((unsigned)b) << 16); }
__device__ __forceinline__ bf16_t f2bf(float f) { return __builtin_bit_cast(unsigned short, (__bf16)f); }
__device__ __forceinline__ float sigmoidf_(float x) { return 1.0f / (1.0f + __expf(-x)); }
__device__ __forceinline__ float gelu_tanh(float x) { const float u = 0.7978845608028654f * (x + 0.044715f * x * x * x); return 0.5f * x * (1.0f + tanhf(u)); }

__host__ __device__ __forceinline__ int g1_orig(int g) {
    const int tile = g >> 8, w = g & 255, bj = w >> 7, wc = (w >> 5) & 3, j = w & 31;
    if (tile < 2) return tile * 256 + wc * 64 + bj * 32 + j;
    if (tile == 2) return wc < 2 ? 512 + wc * 64 + bj * 32 + j : 640 + (wc - 2) * 64 + bj * 32 + j;
    if (tile < 5) return 768 + (tile - 3) * 256 + w;
    if (tile < 7) return 1280 + (tile - 5) * 256 + w;
    const int t = tile - 7; return (bj ? 2816 : 1792) + 128 * t + (w & 127);
}
__host__ __device__ __forceinline__ int gu_orig(int g) { const int tile = g >> 8, w = g & 255, bj = w >> 7; return bj * 1024 + tile * 128 + (w & 127); }

__device__ __forceinline__ float dot_bf16(const bf16_t* a, const bf16_t* b, int K) {
    float s = 0.f;
    for (int k = 0; k < K; k += 8) {
        const u32x4 av = *(const u32x4*)(a + k), bv = *(const u32x4*)(b + k);
#pragma unroll
        for (int j = 0; j < 4; ++j) {
            s += __uint_as_float(av[j] << 16) * __uint_as_float(bv[j] << 16);
            s += __uint_as_float(av[j] & 0xffff0000u) * __uint_as_float(bv[j] & 0xffff0000u);
        }
    }
    return s;
}
__device__ __forceinline__ float wave_sum(float v) {
#pragma unroll
    for (int o = 1; o < 64; o <<= 1) v += __shfl_xor(v, o);
    return v;
}

#define GSTRIDE(i, n) for (size_t i = (size_t)blockIdx.x * blockDim.x + threadIdx.x; i < (size_t)(n); i += (size_t)gridDim.x * blockDim.x)

__global__ void __launch_bounds__(256) nv_transpose(const float* W, int K, int N, bf16_t* dst, int ldd, int koff, int Ng, int mode, int batch) {
    GSTRIDE(idx, (size_t)batch * Ng * K) {
        const int k = (int)(idx % K); const int g = (int)((idx / K) % Ng); const int b = (int)(idx / ((size_t)K * Ng));
        const int o = mode == 1 ? g1_orig(g) : mode == 2 ? gu_orig(g) : g;
        dst[(size_t)b * Ng * ldd + (size_t)g * ldd + koff + k] = f2bf(W[(size_t)b * K * N + (size_t)k * N + o]);
    }
}
__global__ void __launch_bounds__(256) nv_rmsnorm_bf16(const float* x, const float* g, bf16_t* out, float* rstd_out) {
    const int lane = threadIdx.x & 63; const int w = (blockIdx.x * blockDim.x + threadIdx.x) >> 6, nw = (gridDim.x * blockDim.x) >> 6;
    for (int m = w; m < NTOK; m += nw) {
        const float* xr = x + (size_t)m * DM; float v[16]; float s = 0.f;
#pragma unroll
        for (int j = 0; j < 16; ++j) { v[j] = xr[lane + 64 * j]; s += v[j] * v[j]; }
        const float r = rsqrtf(wave_sum(s) * (1.0f / DM) + 1e-6f);
#pragma unroll
        for (int j = 0; j < 16; ++j) out[(size_t)m * DM + lane + 64 * j] = f2bf(v[j] * r * g[lane + 64 * j]);
        if (rstd_out && lane == 0) rstd_out[m] = r;
    }
}
__device__ __forceinline__ void rope_cs(int pos, int j, float& c, float& s) {
    const float inv = exp2f(-(float)j * (13.287712379549449f / 32.0f));
    const double rev = (double)pos * (double)inv * 0.15915494309189535;
    const float fr = (float)(rev - floor(rev));
    s = __builtin_amdgcn_sinf(fr); c = __builtin_amdgcn_cosf(fr);
}
__global__ void __launch_bounds__(256) nv_gemm1(const bf16_t* h, const bf16_t* Wt, const int* positions, bf16_t* q, bf16_t* k, bf16_t* v, bf16_t* xr, bf16_t* yg, bf16_t* ratio, bf16_t* gls) {
    GSTRIDE(idx, (size_t)NTOK * 15 * 128) {
        const int r = (int)(idx % 128), tile = (int)((idx / 128) % 15), m = (int)(idx / (128 * 15));
        const int g0 = tile * 256 + r, g1 = g0 + 128;
        const float v0 = dot_bf16(h + (size_t)m * DM, Wt + (size_t)g0 * DM, DM), v1 = dot_bf16(h + (size_t)m * DM, Wt + (size_t)g1 * DM, DM);
        const int wc = r >> 5, j = r & 31;
        if (tile < 2 || (tile == 2 && wc < 2)) {
            float c, s; rope_cs(positions[m], j, c, s);
            const float o0 = v0 * c - v1 * s, o1 = v1 * c + v0 * s;
            if (tile < 2) { const int hq = tile * 4 + wc; q[(size_t)m * AW + hq * 64 + j] = f2bf(o0); q[(size_t)m * AW + hq * 64 + 32 + j] = f2bf(o1); }
            else { k[(size_t)m * KVW + wc * 64 + j] = f2bf(o0); k[(size_t)m * KVW + wc * 64 + 32 + j] = f2bf(o1); }
        } else if (tile == 2) { const int hv = wc - 2; v[(size_t)m * KVW + hv * 64 + j] = f2bf(v0); v[(size_t)m * KVW + hv * 64 + 32 + j] = f2bf(v1); }
        else if (tile < 5) { const int c0 = (tile - 3) * 256 + r; xr[(size_t)m * LW + c0] = f2bf(v0); xr[(size_t)m * LW + c0 + 128] = f2bf(v1); }
        else if (tile < 7) { const int c0 = (tile - 5) * 256 + r; yg[(size_t)m * LW + c0] = f2bf(gelu_tanh(v0)); yg[(size_t)m * LW + c0 + 128] = f2bf(gelu_tanh(v1)); }
        else { const int c0 = (tile - 7) * 128 + r; const float ea = __expf(-v0), eb = __expf(-v1);
            ratio[(size_t)m * DM + c0] = f2bf((1.0f + eb) / (1.0f + ea)); gls[(size_t)m * DM + c0] = f2bf(1.0f / (1.0f + eb)); }
    }
}
__global__ void __launch_bounds__(256) nv_attn(const bf16_t* q, const bf16_t* k, const bf16_t* v, const float* sinks, bf16_t* ao) {
    GSTRIDE(idx, (size_t)NTOK * NQH) {
        const int hq = (int)(idx % NQH), n = (int)(idx / NQH), s = n % SEQ, kvh = hq / 4;
        float qv[64], o[64];
#pragma unroll
        for (int d = 0; d < 64; ++d) { qv[d] = bf2f(q[(size_t)n * AW + hq * 64 + d]) * 0.125f; o[d] = 0.f; }
        const int lo = s - 127 > 0 ? s - 127 : 0; const float sink = sinks[hq];
        float mx = sink;
        for (int kp = lo; kp <= s; ++kp) { const bf16_t* kr = k + (size_t)(n - s + kp) * KVW + kvh * 64; float sc = 0.f;
#pragma unroll
            for (int d = 0; d < 64; ++d) sc += qv[d] * bf2f(kr[d]);
            mx = fmaxf(mx, sc); }
        float l = __expf(sink - mx);
        for (int kp = lo; kp <= s; ++kp) { const bf16_t* kr = k + (size_t)(n - s + kp) * KVW + kvh * 64; const bf16_t* vr = v + (size_t)(n - s + kp) * KVW + kvh * 64; float sc = 0.f;
#pragma unroll
            for (int d = 0; d < 64; ++d) sc += qv[d] * bf2f(kr[d]);
            const float p = __expf(sc - mx); l += p;
#pragma unroll
            for (int d = 0; d < 64; ++d) o[d] += p * bf2f(vr[d]); }
        const float il = 1.0f / l;
#pragma unroll
        for (int d = 0; d < 64; ++d) ao[(size_t)n * DM + hq * 64 + d] = f2bf(o[d] * il);
    }
}
__global__ void __launch_bounds__(256) nv_conv(const bf16_t* xr, const float* cw, const float* cb, float* xc) {
    GSTRIDE(idx, (size_t)NTOK * LW) {
        const int C = (int)(idx % LW), n = (int)(idx / LW), s = n % SEQ; float a = cb[C];
#pragma unroll
        for (int j = 0; j < 4; ++j) { const int ss = s - 3 + j; if (ss >= 0) a += bf2f(xr[(size_t)(n - 3 + j) * LW + C]) * cw[j * LW + C]; }
        xc[idx] = a;
    }
}
__global__ void __launch_bounds__(256) nv_scan(const float* xc, const float* w_rg, const float* b_rg, const float* w_ig, const float* b_ig, const float* lam, const bf16_t* yg, bf16_t* ao) {
    GSTRIDE(idx, (size_t)NB * LW) {
        const int C = (int)(idx % LW), b = (int)(idx / LW), hh = C / 64, cc = C % 64;
        const float sp = log1pf(__expf(-lam[C])); float hs = 0.f;
        for (int t = 0; t < SEQ; ++t) {
            const size_t n = (size_t)b * SEQ + t; const float* xrow = xc + n * LW + hh * 64; float rg = b_rg[C], ig = b_ig[C];
            for (int c = 0; c < 64; ++c) { const float x = xrow[c]; rg += x * w_rg[(hh * 64 + c) * 64 + cc]; ig += x * w_ig[(hh * 64 + c) * 64 + cc]; }
            const float r = sigmoidf_(rg), i = sigmoidf_(ig), la = -8.0f * r * sp, a = __expf(la), u = sqrtf(-expm1f(2.0f * la)) * (i * xrow[cc]);
            hs = a * hs + u;
            ao[n * DM + 512 + C] = f2bf(hs * bf2f(yg[n * LW + C]));
        }
    }
}
__global__ void __launch_bounds__(256) nv_merged(const bf16_t* ao, const bf16_t* Wcat, const bf16_t* ratio, const bf16_t* gls, bf16_t* merged) {
    GSTRIDE(idx, (size_t)NTOK * DM) {
        const int n = (int)(idx % DM), m = (int)(idx / DM);
        const float ya = dot_bf16(ao + (size_t)m * DM, Wcat + (size_t)n * DM, 512), yl = dot_bf16(ao + (size_t)m * DM + 512, Wcat + (size_t)n * DM + 512, 512);
        merged[idx] = f2bf((ya * bf2f(ratio[idx]) + yl) * bf2f(gls[idx]));
    }
}
__global__ void __launch_bounds__(256) nv_wout(const bf16_t* merged, const bf16_t* Wout, const float* x, float* x1) {
    GSTRIDE(idx, (size_t)NTOK * DM) {
        const int n = (int)(idx % DM), m = (int)(idx / DM);
        x1[idx] = x[idx] + dot_bf16(merged + (size_t)m * DM, Wout + (size_t)n * DM, DM);
    }
}
__global__ void __launch_bounds__(256) nv_logits(const float* x1, const float* rstd, const float* g, const float* Wr, const float* br, float* logits) {
    GSTRIDE(idx, (size_t)NTOK * NE) {
        const int e = (int)(idx % NE), m = (int)(idx / NE); const float r = rstd[m]; float s = 0.f;
        for (int k = 0; k < DM; ++k) s += (x1[(size_t)m * DM + k] * r * g[k]) * Wr[k * NE + e];
        logits[idx] = s + br[e];
    }
}
__global__ void __launch_bounds__(256) nv_topk(const float* logits, unsigned* ctl, int* tok_e, float* tok_w, int* tok_p, int* slot_tok) {
    GSTRIDE(idx, (size_t)NTOK) {
        const float* lg = logits + idx * NE; unsigned used = 0; float tv[4]; int te[4];
#pragma unroll
        for (int kk = 0; kk < 4; ++kk) { float best = -3.0e38f; int bi = 0;
            for (int e = 0; e < NE; ++e) { const float vv = lg[e]; if (!((used >> e) & 1u) && vv > best) { best = vv; bi = e; } }
            used |= 1u << bi; tv[kk] = best; te[kk] = bi; }
        float ex[4], sum = 0.f;
#pragma unroll
        for (int kk = 0; kk < 4; ++kk) { ex[kk] = __expf(tv[kk] - tv[0]); sum += ex[kk]; }
#pragma unroll
        for (int kk = 0; kk < 4; ++kk) { const int e = te[kk]; const unsigned p = atomicAdd(&ctl[CW_GCOUNT + 64 * e], 1u);
            tok_e[idx * 4 + kk] = e; tok_w[idx * 4 + kk] = ex[kk] / sum; tok_p[idx * 4 + kk] = (int)p; slot_tok[(size_t)e * CAP + p] = (int)idx; }
    }
}
__device__ __forceinline__ bool row_lookup(const unsigned* ctl, int row, int& e, int& pos, int& cnt) {
    int base = 0;
    for (int ee = 0; ee < NE; ++ee) { const int c = (int)ctl[CW_GCOUNT + 64 * ee]; const int pr = ((c + 255) >> 8) << 8; if (row < base + pr) { e = ee; pos = row - base; cnt = c; return true; } base += pr; }
    return false;
}
__global__ void __launch_bounds__(256) nv_moe1(const unsigned* ctl, const int* slot_tok, const bf16_t* h2, const bf16_t* Wgu, const float* bgu, bf16_t* act) {
    GSTRIDE(idx, (size_t)MAXROWS * DE) {
        const int j = (int)(idx % DE), row = (int)(idx / DE); int e, pos, cnt;
        if (!row_lookup(ctl, row, e, pos, cnt)) continue;
        const int tok = pos < cnt ? slot_tok[(size_t)e * CAP + pos] : 0;
        const int tile = j >> 7, r = j & 127, gg = tile * 256 + r, gu = gg + 128;
        float g = dot_bf16(h2 + (size_t)tok * DM, Wgu + ((size_t)e * 2048 + gg) * DM, DM) + bgu[e * 2048 + j];
        float u = dot_bf16(h2 + (size_t)tok * DM, Wgu + ((size_t)e * 2048 + gu) * DM, DM) + bgu[e * 2048 + 1024 + j];
        g = fminf(g, 7.0f); u = fminf(fmaxf(u, -7.0f), 7.0f);
        act[idx] = f2bf((u + 1.0f) * (g * sigmoidf_(1.702f * g)));
    }
}
__global__ void __launch_bounds__(256) nv_moe2(const unsigned* ctl, const bf16_t* act, const bf16_t* Wd, const float* bd, bf16_t* y) {
    GSTRIDE(idx, (size_t)MAXROWS * DM) {
        const int n = (int)(idx % DM), row = (int)(idx / DM); int e, pos, cnt;
        if (!row_lookup(ctl, row, e, pos, cnt)) continue;
        y[idx] = f2bf(dot_bf16(act + (size_t)row * DE, Wd + ((size_t)e * DM + n) * DE, DE) + bd[e * DM + n]);
    }
}
__global__ void __launch_bounds__(256) nv_final(const unsigned* ctl, const float* x1, const int* tok_e, const float* tok_w, const int* tok_p, const bf16_t* y, const float* g, float* out) {
    const int lane = threadIdx.x & 63; const int w = (blockIdx.x * blockDim.x + threadIdx.x) >> 6, nw = (gridDim.x * blockDim.x) >> 6;
    for (int m = w; m < NTOK; m += nw) {
        int yrow[4]; float ww[4];
#pragma unroll
        for (int kk = 0; kk < 4; ++kk) { const int e = tok_e[m * 4 + kk]; int base = 0; for (int ee = 0; ee < e; ++ee) base += (((int)ctl[CW_GCOUNT + 64 * ee] + 255) >> 8) << 8; yrow[kk] = base + tok_p[m * 4 + kk]; ww[kk] = tok_w[m * 4 + kk]; }
        float v[16]; float s = 0.f;
#pragma unroll
        for (int j = 0; j < 16; ++j) { const int c = lane + 64 * j; float a = x1[(size_t)m * DM + c];
#pragma unroll
            for (int kk = 0; kk < 4; ++kk) a += ww[kk] * bf2f(y[(size_t)yrow[kk] * DM + c]);
            v[j] = a; s += a * a; }
        const float r = rsqrtf(wave_sum(s) * (1.0f / DM) + 1e-6f);
#pragma unroll
        for (int j = 0; j < 16; ++j) out[(size_t)m * DM + lane + 64 * j] = v[j] * r * g[lane + 64 * j];
    }
}

#define LAS __attribute__((address_space(3)))
typedef short bf16x8 __attribute__((ext_vector_type(8)));
typedef short s16x4 __attribute__((ext_vector_type(4)));
typedef float f32x4 __attribute__((ext_vector_type(4)));
typedef float f32x16 __attribute__((ext_vector_type(16)));
typedef int i32x4 __attribute__((ext_vector_type(4)));
constexpr int NWAVES = 8;
constexpr int RING_BYTES = 131072, MISC_OFF = 147456, LDS_BYTES = 163840;
constexpr int MW_Q = 16, MW_TS = 32, MW_CNT = 72, MW_P5 = 128, MW_TE = 3072;
constexpr int CW_BAR = 4096, CW_QUEUE = 12288;

__device__ __forceinline__ unsigned cvt_pk_bf16(float lo, float hi) { unsigned r; asm volatile("v_cvt_pk_bf16_f32 %0, %1, %2" : "=v"(r) : "v"(lo), "v"(hi)); return r; }
__device__ __forceinline__ unsigned pk4_fp8(float a, float b, float c, float d) { int p = __builtin_amdgcn_cvt_pk_fp8_f32(a, b, 0, false); p = __builtin_amdgcn_cvt_pk_fp8_f32(c, d, p, true); return (unsigned)p; }
__device__ __forceinline__ float clamp448(float x) { return fminf(fmaxf(x, -448.0f), 448.0f); }
__device__ __forceinline__ float fsig(float x) { return __builtin_amdgcn_rcpf(1.0f + __builtin_amdgcn_exp2f(-1.4426950408889634f * x)); }
__device__ __forceinline__ int crow(int r, int hi) { return (r & 3) + 8 * (r >> 2) + 4 * hi; }
__device__ __forceinline__ void unpack8(const u32x4 w, float (&f)[8]) {
#pragma unroll
    for (int j = 0; j < 4; ++j) { f[2 * j] = __uint_as_float(w[j] << 16); f[2 * j + 1] = __uint_as_float(w[j] & 0xffff0000u); }
}
__host__ __device__ __forceinline__ int g1_inv(int o) {
    if (o < 512) { const int head = o >> 6, d = o & 63; return (head >> 2) * 256 + (d >> 5) * 128 + (head & 3) * 32 + (d & 31); }
    if (o < 640) { const int hk = (o - 512) >> 6, d = o & 63; return 512 + (d >> 5) * 128 + hk * 32 + (d & 31); }
    if (o < 768) { const int hv = (o - 640) >> 6, d = o & 63; return 512 + (d >> 5) * 128 + (2 + hv) * 32 + (d & 31); }
    if (o < 1792) return o;
    if (o < 2816) { const int c = o - 1792; return (7 + (c >> 7)) * 256 + (c & 127); }
    const int c = o - 2816; return (7 + (c >> 7)) * 256 + 128 + (c & 127);
}
__host__ __device__ __forceinline__ int gu_inv(int o) { const int bj = o >> 10, c = o & 1023; return (c >> 7) * 256 + bj * 128 + (c & 127); }

#define XB_TMO      128
#define XB_XCNT(j)  (256  + 64 * (j))
#define XB_XSUB(j)  (1280 + 64 * (j))
#define XB_XGEN(j)  (2304 + 64 * (j))
#define XB_TOP      3328
#define XB_TOPGEN   3392
#define XCD_BAR_WORDS 3456
#define XB_SPIN_CAP (1u << 18)
__device__ __forceinline__ unsigned xb_ld(unsigned* p)              { return __hip_atomic_load(p, __ATOMIC_RELAXED, __HIP_MEMORY_SCOPE_AGENT); }
__device__ __forceinline__ unsigned xb_add(unsigned* p, unsigned v) { return __hip_atomic_fetch_add(p, v, __ATOMIC_RELAXED, __HIP_MEMORY_SCOPE_AGENT); }
__device__ __forceinline__ unsigned xb_xcc_id() { return (unsigned)__builtin_amdgcn_s_getreg((3 << 11) | 20) & 0xFu; }
#define XB_SPIN(cond, bar) do { unsigned _sp = 0; while (cond) { __builtin_amdgcn_s_sleep(1); \
    if ((++_sp & 255u) == 0u) { if (xb_ld(&(bar)[XB_TMO])) break; if (_sp > XB_SPIN_CAP) { atomicAdd(&(bar)[XB_TMO], 1u); break; } } } } while (0)
struct XcdBarrier { unsigned* bar; unsigned x; volatile LAS unsigned* st; };
__device__ __forceinline__ XcdBarrier xcd_barrier_post(unsigned* bar, volatile LAS unsigned* st) {
    XcdBarrier b; b.bar = bar; b.x = xb_xcc_id(); b.st = st;
    if (threadIdx.x == 0) (void)xb_add(&bar[XB_XCNT(b.x)], 1u);
    return b;
}
__device__ __forceinline__ void xcd_barrier_complete(unsigned* bar, unsigned x, unsigned& nloc, unsigned& nx) {
    const unsigned G = gridDim.x * gridDim.y * gridDim.z;
    unsigned sum, cnt, mine, sp = 0u;
    for (;;) {
        sum = 0u; cnt = 0u; mine = 0u;
#pragma unroll
        for (unsigned j = 0; j < 16; ++j) { const unsigned c = xb_ld(&bar[XB_XCNT(j)]); sum += c; cnt += (c > 0u) ? 1u : 0u; mine = (j == x) ? c : mine; }
        if (sum == G) break;
        __builtin_amdgcn_s_sleep(1);
        if ((++sp & 255u) == 0u) { if (xb_ld(&bar[XB_TMO])) break; if (sp > XB_SPIN_CAP) { atomicAdd(&bar[XB_TMO], 1u); break; } }
    }
    nloc = mine > 0u ? mine : 1u; nx = cnt > 0u ? cnt : 1u;
}
__device__ __forceinline__ void xcd_barrier(const XcdBarrier& b) {
    asm volatile("s_waitcnt vmcnt(0)" ::: "memory");
    __syncthreads();
    if (threadIdx.x == 0) {
        unsigned* bar = b.bar;
        __builtin_amdgcn_s_waitcnt(0);
        unsigned nloc = b.st[0], nx = b.st[1];
        if (nloc == 0u) { xcd_barrier_complete(bar, b.x, nloc, nx); b.st[0] = nloc; b.st[1] = nx; }
        const unsigned old = xb_add(&bar[XB_XSUB(b.x)], 1u);
        const unsigned gen = old / nloc;
        if (old + 1u == (gen + 1u) * nloc) {
            __builtin_amdgcn_fence(__ATOMIC_RELEASE, "agent");
            asm volatile("s_waitcnt vmcnt(0)" ::: "memory");
            const unsigned og = xb_add(&bar[XB_TOP], 1u);
            const unsigned tg = og / nx;
            if (og + 1u == (tg + 1u) * nx) xb_add(&bar[XB_TOPGEN], 1u);
            else XB_SPIN(xb_ld(&bar[XB_TOPGEN]) == tg, bar);
            __builtin_amdgcn_fence(__ATOMIC_ACQUIRE, "agent");
            xb_add(&bar[XB_XGEN(b.x)], 1u);
            asm volatile("s_waitcnt vmcnt(0)" ::: "memory");
        } else {
            XB_SPIN(xb_ld(&bar[XB_XGEN(b.x)]) == gen, bar);
            __builtin_amdgcn_fence(__ATOMIC_ACQUIRE, "agent");
            asm volatile("s_waitcnt vmcnt(0)" ::: "memory");
        }
    }
    __syncthreads();
}

namespace pg8 {
constexpr int BM = 256, BK = 64, HALF = 128, HTB = HALF * BK * 2, STAGE_BYTES = 8 * HTB, NXCD = 8, WGM = 8, KK = 1024, NT = KK / BK;
__host__ __device__ __forceinline__ int lds_byte(int r, int c) { const int st = (r >> 4) * 2 + (c >> 5), rr = r & 15, cc = c & 31, ob = rr * 64 + cc * 2; return st * 1024 + (ob ^ (((ob >> 9) & 1) << 5)); }
__host__ __device__ __forceinline__ void stage_rc(int b, int& R, int& C) { const int st = b / 1024, sb = b % 1024, swz = sb ^ (((sb >> 9) & 1) << 5); R = (st >> 1) * 16 + swz / 64; C = (st & 1) * 32 + (swz % 64) / 2; }
__host__ __device__ __forceinline__ int perm32(int rho) { const int n = rho >> 4, i = rho & 15; return 8 * (i >> 2) + 4 * n + (i & 3); }
struct Unit { int pm, pn, e, nvalid; };
constexpr unsigned KSTEP = BK * 2;

struct DenseSched {
    const bf16_t* A; const bf16_t* Bt; int nM, nN, nwg, G, c, it;
    __device__ void init(const bf16_t* A_, const bf16_t* Bt_, int M, int N, int G_, int c_) { A = A_; Bt = Bt_; nM = M / BM; nN = N / BM; nwg = nM * nN; G = G_; c = c_; it = 0; }
    __device__ __forceinline__ bool next(Unit& u) {
        const long L = (long)it * G + c; ++it; if (L >= nwg) return false;
        int wgid = (int)L; { const int q = nwg / NXCD, r = nwg % NXCD, xcd = wgid % NXCD, off = wgid / NXCD; wgid = (xcd < r ? xcd * (q + 1) : r * (q + 1) + (xcd - r) * q) + off; }
        const int nig = WGM * nN, gid = wgid / nig, fm = gid * WGM, gsz = (nM - fm) < WGM ? (nM - fm) : WGM;
        u.pm = fm + ((wgid % nig) % gsz); u.pn = (wgid % nig) / gsz; u.e = 0; u.nvalid = 256; return true;
    }
    __device__ __forceinline__ unsigned a_base(const Unit& u) const { return (unsigned)u.pm * (unsigned)(BM * KK * 2); }
    __device__ __forceinline__ unsigned b_base(const Unit& u) const { return (unsigned)u.pn * (unsigned)(BM * KK * 2); }
    __device__ __forceinline__ void a_rows(const Unit&, const int (&R)[2], int (&rows)[2][2]) const {
#pragma unroll
        for (int h = 0; h < 2; ++h)
#pragma unroll
            for (int i = 0; i < 2; ++i) rows[h][i] = R[i] + HALF * h;
    }
};
template <bool GATHER, int EB> struct MoeSched {
    const void* A; const void* Bt; const int* slot_tok; const volatile LAS int* ts; const volatile LAS int* cnt; int NPN, ntiles, Lmax, G, c, it;
    __device__ void init(const void* A_, const void* Bt_, const int* slot_tok_, const volatile LAS int* ts_, const volatile LAS int* cnt_, int NPN_, int G_, int c_) {
        A = A_; Bt = Bt_; slot_tok = slot_tok_; ts = ts_; cnt = cnt_; NPN = NPN_; G = G_; c = c_; it = 0; ntiles = __builtin_amdgcn_readfirstlane(ts[NE]); Lmax = ((ntiles + 7) / 8) * 8 * NPN; }
    __device__ __forceinline__ bool next(Unit& u) {
        for (;;) {
#if MOE_ORDER == 1
            const int U = ntiles * NPN, per = (U + G - 1) / G, uu = c * per + it; ++it; if (it > per || uu >= U) return false;
            const int m = uu / NPN, j = uu;
#elif MOE_ORDER == 2
            const int x = c & 7, nper = G >> 3; int lin = it * nper + (c >> 3); ++it;
            int m = -1, j = 0;
            for (int k = 0; k < NE / 8; ++k) { const int e2 = x + 8 * k, t0 = __builtin_amdgcn_readfirstlane(ts[e2]), nt2 = __builtin_amdgcn_readfirstlane(ts[e2 + 1]) - t0, nu = nt2 * NPN;
                if (m < 0) { if (lin < nu) { m = t0 + lin / NPN; j = lin % NPN; } else lin -= nu; } }
            if (m < 0) return false;
#else
            const int L = it * G + c; ++it; if (L >= Lmax) return false;
            const int xcd = L & 7, j = L >> 3, m = (j / NPN) * 8 + xcd; if (m >= ntiles) continue;
#endif
            const int e = __builtin_amdgcn_readfirstlane(ts[MW_TE - MW_TS + m]);
            u.pm = m; u.pn = j % NPN; u.e = e; u.nvalid = __builtin_amdgcn_readfirstlane(cnt[e]) - 256 * (m - __builtin_amdgcn_readfirstlane(ts[e])); return true;
        }
    }
    __device__ __forceinline__ unsigned a_base(const Unit& u) const { return GATHER ? 0u : (unsigned)u.pm * (unsigned)(BM * KK * EB); }
    __device__ __forceinline__ unsigned b_base(const Unit& u) const { return (unsigned)(u.e * NPN + u.pn) * (unsigned)(BM * KK * EB); }
    __device__ __forceinline__ void a_rows(const Unit& u, const int (&R)[2], int (&rows)[2][2]) const {
#pragma unroll
        for (int h = 0; h < 2; ++h)
#pragma unroll
            for (int i = 0; i < 2; ++i) {
                const int r = R[i] + HALF * h;
                if (GATHER) { const int last = u.nvalid - 1; rows[h][i] = slot_tok[(size_t)u.e * CAP + 256 * (u.pm - __builtin_amdgcn_readfirstlane(ts[u.e])) + (r < last ? r : last)]; }
                else rows[h][i] = r;
            }
    }
};

template <class Epi, class Sched, bool ALIGN_EPI, int EB, int KREP = 1>
__device__ __forceinline__ void gemm_phase(LAS unsigned char* lds, Sched& S, const Epi& E) {
    constexpr int PITCH = KK * EB, NTL = PITCH / 128; constexpr unsigned HSTEP = (unsigned)HALF * PITCH;
    const __amdgpu_buffer_rsrc_t rsrcA = __builtin_amdgcn_make_buffer_rsrc((void*)S.A, 0, 0xFFFFFFFF, 0x00020000), rsrcB = __builtin_amdgcn_make_buffer_rsrc((void*)S.Bt, 0, 0xFFFFFFFF, 0x00020000);
    typedef int v8i_t __attribute__((ext_vector_type(8)));
    const int tid = threadIdx.x, wid = __builtin_amdgcn_readfirstlane(tid >> 6), lane = tid & 63, wr = wid >> 2, wc = wid & 3, fr = lane & 15, fq = lane >> 4;
    unsigned voffB[2];
#pragma unroll
    for (int i = 0; i < 2; ++i) { int R, C; stage_rc(tid * 16 + i * 8192, R, C); const int Rb = Epi::PERM ? ((R & ~31) + perm32(R & 31)) : R; voffB[i] = (unsigned)(Rb * PITCH + C * 2); }
    const unsigned ldsw = (unsigned)wid * 1024u;
    const int aoff = lds_byte(wr * 64 + fr, fq * 8), boff = lds_byte(wc * 32 + fr, fq * 8);
#define PG8_SA(b, h) (((b) * 2 + (h)) * HTB)
#define PG8_SB(b, h) ((4 + (b) * 2 + (h)) * HTB)
#define PG8_STAGEA(bufoff, soff, voff) do { _Pragma("unroll") for (int _i = 0; _i < 2; ++_i) \
        __builtin_amdgcn_raw_ptr_buffer_load_lds(rsrcA, (LAS void*)(lds + (bufoff) + ldsw + _i * 8192), 16, (voff)[_i], (soff), 0, 0); } while (0)
#define PG8_STAGEB(bufoff, soff, voff) do { _Pragma("unroll") for (int _i = 0; _i < 2; ++_i) \
        __builtin_amdgcn_raw_ptr_buffer_load_lds(rsrcB, (LAS void*)(lds + (bufoff) + ldsw + _i * 8192), 16, (voff)[_i], (soff), 0, 0); } while (0)
#define PG8_LDA(dst, b, h) do { _Pragma("unroll") for (int m = 0; m < 4; ++m) _Pragma("unroll") for (int k = 0; k < 2; ++k) dst[m][k] = *(const LAS bf16x8*)(lds + PG8_SA(b, h) + aoff + m * 2048 + k * 1024); } while (0)
#define PG8_LDB(dst, b, h) do { _Pragma("unroll") for (int n = 0; n < 2; ++n) _Pragma("unroll") for (int k = 0; k < 2; ++k) dst[n][k] = *(const LAS bf16x8*)(lds + PG8_SB(b, h) + boff + n * 2048 + k * 1024); } while (0)
#define PG8_MMA(ai, bj, At, Bt) do { __builtin_amdgcn_s_setprio(1); _Pragma("unroll") for (int m = 0; m < 4; ++m) _Pragma("unroll") for (int n = 0; n < 2; ++n) { \
        if constexpr (EB == 2) { _Pragma("unroll") for (int k = 0; k < 2; ++k) acc[ai][bj][m][n] = __builtin_amdgcn_mfma_f32_16x16x32_bf16(Bt[n][k], At[m][k], acc[ai][bj][m][n], 0, 0, 0); } \
        else { const v8i_t b8 = __builtin_shufflevector(__builtin_bit_cast(i32x4, Bt[n][0]), __builtin_bit_cast(i32x4, Bt[n][1]), 0, 1, 2, 3, 4, 5, 6, 7); \
               const v8i_t a8 = __builtin_shufflevector(__builtin_bit_cast(i32x4, At[m][0]), __builtin_bit_cast(i32x4, At[m][1]), 0, 1, 2, 3, 4, 5, 6, 7); \
               asm volatile("v_mfma_f32_16x16x128_f8f6f4 %0, %1, %2, %0" : "+v"(acc[ai][bj][m][n]) : "v"(b8), "v"(a8)); } } \
        __builtin_amdgcn_s_setprio(0); } while (0)
#define PG8_WAIT_V(n) asm volatile("s_waitcnt vmcnt(" #n ")" ::: "memory")
#define PG8_WAIT_L(n) asm volatile("s_waitcnt lgkmcnt(" #n ")" ::: "memory")
#define PG8_BAR __builtin_amdgcn_s_barrier()
#define PG8_SCHED __builtin_amdgcn_sched_barrier(0)
    Unit cur, nxt;
    if (!S.next(cur)) return;
    f32x4 acc[2][2][4][2];
#pragma unroll
    for (int a = 0; a < 2; ++a)
#pragma unroll
        for (int b = 0; b < 2; ++b)
#pragma unroll
            for (int m = 0; m < 4; ++m)
#pragma unroll
                for (int n = 0; n < 2; ++n) acc[a][b][m][n] = (f32x4){0.f, 0.f, 0.f, 0.f};
    bf16x8 At[4][2], B0[2][2], B1[2][2];
    unsigned vA[2][2], vN[2][2]; typename Epi::Pre pre;
#define PG8_AOFF(u, v) do { int _R[2], _C[2]; _Pragma("unroll") for (int _i = 0; _i < 2; ++_i) stage_rc(tid * 16 + _i * 8192, _R[_i], _C[_i]); int _rows[2][2]; S.a_rows(u, _R, _rows); \
        _Pragma("unroll") for (int _h = 0; _h < 2; ++_h) _Pragma("unroll") for (int _i = 0; _i < 2; ++_i) v[_h][_i] = (unsigned)(_rows[_h][_i] * PITCH + _C[_i] * 2); } while (0)
    PG8_AOFF(cur, vA);
    unsigned cA = S.a_base(cur), cB = S.b_base(cur);
    PG8_STAGEB(PG8_SB(0, 0), cB, voffB); PG8_STAGEB(PG8_SB(0, 1), cB + HSTEP, voffB); PG8_STAGEA(PG8_SA(0, 0), cA, vA[0]); PG8_STAGEA(PG8_SA(0, 1), cA, vA[1]);
    if (wr == 1) PG8_BAR;
    PG8_WAIT_V(2); PG8_BAR;
    PG8_STAGEB(PG8_SB(1, 0), cB + KSTEP, voffB); PG8_STAGEA(PG8_SA(1, 0), cA + KSTEP, vA[0]); PG8_STAGEB(PG8_SB(1, 1), cB + HSTEP + KSTEP, voffB);
    PG8_WAIT_V(6); PG8_BAR;
    int krep = 0;
    for (;;) {
        bool has_next;
        if (KREP > 1 && krep + 1 < KREP) { has_next = true; nxt = cur; } else has_next = S.next(nxt);
        const unsigned nA = has_next ? S.a_base(nxt) : cA, nB = has_next ? S.b_base(nxt) : cB;
        if (has_next) PG8_AOFF(nxt, vN);
        else {
#pragma unroll
            for (int h = 0; h < 2; ++h)
#pragma unroll
                for (int i = 0; i < 2; ++i) vN[h][i] = vA[h][i];
        }
#pragma unroll 1
        for (int t = 0; t < NTL; t += 2) {
            const bool last = (t == NTL - 2);
            const unsigned a1 = cA + (unsigned)(t + 1) * KSTEP;
            const unsigned a2 = last ? nA : cA + (unsigned)(t + 2) * KSTEP, b2 = last ? nB : cB + (unsigned)(t + 2) * KSTEP;
            const unsigned a3 = a2 + KSTEP, b3 = b2 + KSTEP;
            unsigned v2[2][2];
#pragma unroll
            for (int h = 0; h < 2; ++h)
#pragma unroll
                for (int i = 0; i < 2; ++i) v2[h][i] = last ? vN[h][i] : vA[h][i];
            if constexpr (Epi::HAS_MID) { if (t == NTL / 2) E.mid(acc, cur, wr, wc, fr, fq); }
            if (last) pre = E.load_pre(cur, wr, wc, fr, fq);
            PG8_LDB(B0, 0, 0); PG8_LDB(B1, 0, 1); PG8_SCHED; PG8_LDA(At, 0, 0); PG8_STAGEA(PG8_SA(1, 1), a1, vA[1]);
            PG8_WAIT_V(8); PG8_WAIT_L(0); PG8_BAR; PG8_MMA(0, 0, At, B0); PG8_MMA(0, 1, At, B1); PG8_BAR; PG8_SCHED;
            PG8_LDA(At, 0, 1); PG8_STAGEB(PG8_SB(0, 0), b2, voffB); PG8_STAGEB(PG8_SB(0, 1), b2 + HSTEP, voffB); PG8_STAGEA(PG8_SA(0, 0), a2, v2[0]);
            PG8_WAIT_V(8); PG8_WAIT_L(0); PG8_BAR; PG8_MMA(1, 0, At, B0); PG8_MMA(1, 1, At, B1); PG8_BAR; PG8_SCHED;
            PG8_LDB(B0, 1, 0); PG8_LDB(B1, 1, 1); PG8_SCHED; PG8_LDA(At, 1, 0); PG8_STAGEA(PG8_SA(0, 1), a2, v2[1]);
            PG8_WAIT_V(8); PG8_WAIT_L(0); PG8_BAR; PG8_MMA(0, 0, At, B0); PG8_MMA(0, 1, At, B1); PG8_BAR; PG8_SCHED;
            PG8_LDA(At, 1, 1); PG8_STAGEB(PG8_SB(1, 0), b3, voffB); PG8_STAGEB(PG8_SB(1, 1), b3 + HSTEP, voffB); PG8_STAGEA(PG8_SA(1, 0), a3, v2[0]);
            PG8_WAIT_V(8); PG8_WAIT_L(0); PG8_BAR; PG8_MMA(1, 0, At, B0); PG8_MMA(1, 1, At, B1); PG8_BAR; PG8_SCHED;
        }
        if (KREP > 1 && ++krep < KREP) { cur = nxt; cA = nA; cB = nB; continue; }
        krep = 0;
        if constexpr (ALIGN_EPI) { if (wr == 0) PG8_BAR; }
        if constexpr (EB == 1) asm volatile("s_nop 15\n\ts_nop 15" ::: "memory");
        E(acc, cur, wr, wc, fr, fq, pre);
        if (!has_next) break;
#pragma unroll
        for (int a = 0; a < 2; ++a)
#pragma unroll
            for (int b = 0; b < 2; ++b)
#pragma unroll
                for (int m = 0; m < 4; ++m)
#pragma unroll
                    for (int n = 0; n < 2; ++n) acc[a][b][m][n] = (f32x4){0.f, 0.f, 0.f, 0.f};
        cur = nxt; cA = nA; cB = nB;
#pragma unroll
        for (int h = 0; h < 2; ++h)
#pragma unroll
            for (int i = 0; i < 2; ++i) vA[h][i] = vN[h][i];
        if constexpr (ALIGN_EPI) { if (wr == 1) PG8_BAR; }
    }
    PG8_WAIT_V(0);
    if constexpr (!ALIGN_EPI) { if (wr == 0) PG8_BAR; }
    PG8_BAR;
#undef PG8_AOFF
#undef PG8_SA
#undef PG8_SB
#undef PG8_STAGEA
#undef PG8_STAGEB
#undef PG8_LDA
#undef PG8_LDB
#undef PG8_MMA
#undef PG8_WAIT_V
#undef PG8_WAIT_L
#undef PG8_BAR
#undef PG8_SCHED
}

struct EpiG1 {
    static constexpr bool PERM = true, HAS_MID = false;
    struct Pre {}; __device__ __forceinline__ Pre load_pre(const Unit&, int, int, int, int) const { return Pre{}; }
    const int* pos; bf16_t *q, *k, *v, *xr, *yg, *ratio, *gls;
    __device__ __forceinline__ void mid(f32x4 (&)[2][2][4][2], const Unit&, int, int, int, int) const {}
    __device__ __forceinline__ void operator()(const f32x4 (&acc)[2][2][4][2], const Unit& u, int wr, int wc, int fr, int fq, const Pre& pre) const {
        const int row0 = u.pm * BM + wr * 64 + fr, j0 = 8 * fq, pn = u.pn;
        const bool rope = (pn < 2) || (pn == 2 && wc < 2);
        typedef float f2 __attribute__((ext_vector_type(2)));
        f2 invf[4];
#pragma unroll
        for (int e = 0; e < 4; ++e) { invf[e].x = exp2f(-(float)(j0 + 2 * e) * (13.287712379549449f / 32.0f)) * 0.15915494309189535f; invf[e].y = exp2f(-(float)(j0 + 2 * e + 1) * (13.287712379549449f / 32.0f)) * 0.15915494309189535f; }
#pragma unroll
        for (int ai = 0; ai < 2; ++ai)
#pragma unroll
            for (int m = 0; m < 4; ++m) {
                const int row = row0 + ai * HALF + m * 16;
                f2 lo[4], hi[4];
#pragma unroll
                for (int e = 0; e < 2; ++e) { lo[e] = (f2){acc[ai][0][m][0][2 * e], acc[ai][0][m][0][2 * e + 1]}; lo[2 + e] = (f2){acc[ai][0][m][1][2 * e], acc[ai][0][m][1][2 * e + 1]};
                    hi[e] = (f2){acc[ai][1][m][0][2 * e], acc[ai][1][m][0][2 * e + 1]}; hi[2 + e] = (f2){acc[ai][1][m][1][2 * e], acc[ai][1][m][1][2 * e + 1]}; }
                bf16_t* d0; bf16_t* d1;
                if (rope) {
                    const float p = (float)pos[row];
#pragma unroll
                    for (int e = 0; e < 4; ++e) { const f2 rev = invf[e] * p; f2 sn, cs;
                        const float r0 = __builtin_amdgcn_fractf(rev.x), r1 = __builtin_amdgcn_fractf(rev.y);
                        sn.x = __builtin_amdgcn_sinf(r0); sn.y = __builtin_amdgcn_sinf(r1); cs.x = __builtin_amdgcn_cosf(r0); cs.y = __builtin_amdgcn_cosf(r1);
                        const f2 a = lo[e], bb = hi[e]; lo[e] = a * cs - bb * sn; hi[e] = bb * cs + a * sn; }
                    if (pn < 2) { d0 = q + (size_t)row * AW + (pn * 4 + wc) * 64 + j0; } else { d0 = k + (size_t)row * KVW + wc * 64 + j0; }
                    d1 = d0 + 32;
                } else if (pn == 2) { d0 = v + (size_t)row * KVW + (wc - 2) * 64 + j0; d1 = d0 + 32; }
                else if (pn < 5) { d0 = xr + (size_t)row * LW + (pn - 3) * 256 + wc * 32 + j0; d1 = d0 + 128; }
                else if (pn < 7) {
#pragma unroll
                    for (int e = 0; e < 4; ++e) {
#pragma unroll
                        for (int hf = 0; hf < 2; ++hf) { const f2 a = hf ? hi[e] : lo[e]; const f2 z = (a * ((a * a) * 0.044715f + 1.0f)) * (-1.5957691216057308f * 1.4426950408889634f);
                            f2 d; d.x = __builtin_amdgcn_exp2f(z.x); d.y = __builtin_amdgcn_exp2f(z.y); d = d + 1.0f; f2 r; r.x = __builtin_amdgcn_rcpf(d.x); r.y = __builtin_amdgcn_rcpf(d.y);
                            if (hf) hi[e] = a * r; else lo[e] = a * r; } }
                    d0 = yg + (size_t)row * LW + (pn - 5) * 256 + wc * 32 + j0; d1 = d0 + 128;
                } else {
#pragma unroll
                    for (int e = 0; e < 4; ++e) { f2 a = lo[e], bb = hi[e];
                        a.x = __builtin_amdgcn_fmed3f(a.x, -30.f, 30.f); a.y = __builtin_amdgcn_fmed3f(a.y, -30.f, 30.f); bb.x = __builtin_amdgcn_fmed3f(bb.x, -30.f, 30.f); bb.y = __builtin_amdgcn_fmed3f(bb.y, -30.f, 30.f);
                        const f2 za = a * (-1.4426950408889634f), zb = bb * (-1.4426950408889634f); f2 da, db;
                        da.x = __builtin_amdgcn_exp2f(za.x); da.y = __builtin_amdgcn_exp2f(za.y); db.x = __builtin_amdgcn_exp2f(zb.x); db.y = __builtin_amdgcn_exp2f(zb.y); da = da + 1.0f; db = db + 1.0f;
                        f2 ia, ib; ia.x = __builtin_amdgcn_rcpf(da.x); ia.y = __builtin_amdgcn_rcpf(da.y); ib.x = __builtin_amdgcn_rcpf(db.x); ib.y = __builtin_amdgcn_rcpf(db.y);
                        lo[e] = db * ia; hi[e] = ib; }
                    d0 = ratio + (size_t)row * DM + (pn - 7) * 128 + wc * 32 + j0; d1 = gls + (size_t)row * DM + (pn - 7) * 128 + wc * 32 + j0;
                }
                u32x4 w0, w1;
#pragma unroll
                for (int e = 0; e < 4; ++e) { w0[e] = cvt_pk_bf16(lo[e].x, lo[e].y); w1[e] = cvt_pk_bf16(hi[e].x, hi[e].y); }
                *(u32x4*)d0 = w0; *(u32x4*)d1 = w1;
            }
    }
};
struct EpiMerged {
    static constexpr bool PERM = true, HAS_MID = true;
    struct Pre {}; __device__ __forceinline__ Pre load_pre(const Unit&, int, int, int, int) const { return Pre{}; }
    const bf16_t* ratio; const bf16_t* gls; bf16_t* merged;
    __device__ __forceinline__ void mid(f32x4 (&acc)[2][2][4][2], const Unit& u, int wr, int wc, int fr, int fq) const {
        int off0 = (u.pm * BM + wr * 64 + fr) * DM + u.pn * BM + wc * 32 + 8 * fq;
        asm volatile("" : "+v"(off0));
#pragma unroll
        for (int ai = 0; ai < 2; ++ai)
#pragma unroll
            for (int m = 0; m < 4; ++m)
            {
#pragma unroll
                for (int bj = 0; bj < 2; ++bj) { const u32x4 w = *(const u32x4*)(ratio + (size_t)(unsigned)(off0 + (ai * HALF + m * 16) * DM + bj * HALF)); float f[8]; unpack8(w, f);
#pragma unroll
                    for (int e = 0; e < 4; ++e) { acc[ai][bj][m][0][e] *= f[e]; acc[ai][bj][m][1][e] *= f[4 + e]; } }
                if (m & 1) asm volatile("" ::: "memory"); }
    }
    __device__ __forceinline__ void operator()(const f32x4 (&acc)[2][2][4][2], const Unit& u, int wr, int wc, int fr, int fq, const Pre& pre) const {
        const int row0 = u.pm * BM + wr * 64 + fr, col0 = u.pn * BM + wc * 32 + 8 * fq;
#pragma unroll
        for (int ai = 0; ai < 2; ++ai)
#pragma unroll
            for (int m = 0; m < 4; ++m)
#pragma unroll
                for (int bj = 0; bj < 2; ++bj) { const size_t off = (size_t)(row0 + ai * HALF + m * 16) * DM + col0 + bj * HALF; const u32x4 w = *(const u32x4*)(gls + off); float f[8]; unpack8(w, f);
                    u32x4 o;
#pragma unroll
                    for (int e = 0; e < 2; ++e) { o[e] = cvt_pk_bf16(acc[ai][bj][m][0][2 * e] * f[2 * e], acc[ai][bj][m][0][2 * e + 1] * f[2 * e + 1]);
                        o[2 + e] = cvt_pk_bf16(acc[ai][bj][m][1][2 * e] * f[4 + 2 * e], acc[ai][bj][m][1][2 * e + 1] * f[4 + 2 * e + 1]); }
                    *(u32x4*)(merged + off) = o; }
    }
};
struct EpiX1 {
    static constexpr bool PERM = false, HAS_MID = false;
    struct Pre {}; __device__ __forceinline__ Pre load_pre(const Unit&, int, int, int, int) const { return Pre{}; }
    const float* x; float* x1;
    __device__ __forceinline__ void mid(f32x4 (&)[2][2][4][2], const Unit&, int, int, int, int) const {}
    __device__ __forceinline__ void operator()(const f32x4 (&acc)[2][2][4][2], const Unit& u, int wr, int wc, int fr, int fq, const Pre& pre) const {
        const int row0 = u.pm * BM + wr * 64 + fr, col0 = u.pn * BM + wc * 32 + 4 * fq;
#pragma unroll
        for (int ai = 0; ai < 2; ++ai)
#pragma unroll
            for (int m = 0; m < 4; ++m)
#pragma unroll
                for (int bj = 0; bj < 2; ++bj)
#pragma unroll
                    for (int n = 0; n < 2; ++n) { const size_t off = (size_t)(row0 + ai * HALF + m * 16) * DM + col0 + bj * HALF + n * 16; *(f32x4*)(x1 + off) = *(const f32x4*)(x + off) + acc[ai][bj][m][n]; }
    }
};
struct EpiD {
    static constexpr bool PERM = true, HAS_MID = false;
    struct Pre {}; __device__ __forceinline__ Pre load_pre(const Unit&, int, int, int, int) const { return Pre{}; }
    bf16_t* d;
    __device__ __forceinline__ void mid(f32x4 (&)[2][2][4][2], const Unit&, int, int, int, int) const {}
    __device__ __forceinline__ void operator()(const f32x4 (&acc)[2][2][4][2], const Unit& u, int wr, int wc, int fr, int fq, const Pre& pre) const {
        const int row0 = u.pm * BM + wr * 64 + fr, col0 = u.pn * BM + wc * 32 + 8 * fq;
#pragma unroll
        for (int ai = 0; ai < 2; ++ai)
#pragma unroll
            for (int m = 0; m < 4; ++m)
#pragma unroll
                for (int bj = 0; bj < 2; ++bj) { const f32x4 v0 = acc[ai][bj][m][0], v1 = acc[ai][bj][m][1]; u32x4 w;
                    w[0] = cvt_pk_bf16(v0[0], v0[1]); w[1] = cvt_pk_bf16(v0[2], v0[3]); w[2] = cvt_pk_bf16(v1[0], v1[1]); w[3] = cvt_pk_bf16(v1[2], v1[3]);
                    *(u32x4*)(d + (size_t)(row0 + ai * HALF + m * 16) * DM + col0 + bj * HALF) = w; }
    }
};
struct EpiAct {
    static constexpr bool PERM = true, HAS_MID = false;
    const float* bgu; void* act; float sc;
    struct Pre { f32x4 b[4]; };
    __device__ __forceinline__ Pre load_pre(const Unit& u, int wr, int wc, int fr, int fq) const { const float* bp = bgu + (size_t)u.e * 2048 + u.pn * 128 + wc * 32 + 8 * fq;
        Pre p; p.b[0] = *(const f32x4*)bp; p.b[1] = *(const f32x4*)(bp + 4); p.b[2] = *(const f32x4*)(bp + 1024); p.b[3] = *(const f32x4*)(bp + 1028); return p; }
    __device__ __forceinline__ void mid(f32x4 (&)[2][2][4][2], const Unit&, int, int, int, int) const {}
    __device__ __forceinline__ void operator()(const f32x4 (&acc)[2][2][4][2], const Unit& u, int wr, int wc, int fr, int fq, const Pre& pre) const {
        const int row0 = u.pm * BM + wr * 64 + fr, j0 = u.pn * 128 + wc * 32 + 8 * fq;
        typedef float f2 __attribute__((ext_vector_type(2)));
        f2 bg[4], bu[4];
#pragma unroll
        for (int q = 0; q < 2; ++q) { bg[q] = (f2){pre.b[0][2 * q], pre.b[0][2 * q + 1]}; bg[2 + q] = (f2){pre.b[1][2 * q], pre.b[1][2 * q + 1]}; bu[q] = (f2){pre.b[2][2 * q], pre.b[2][2 * q + 1]}; bu[2 + q] = (f2){pre.b[3][2 * q], pre.b[3][2 * q + 1]}; }
#pragma unroll
        for (int ai = 0; ai < 2; ++ai)
#pragma unroll
            for (int m = 0; m < 4; ++m) {
                float o[8];
#pragma unroll
                for (int q = 0; q < 4; ++q) {
                    const f32x4 ga = acc[ai][0][m][q >> 1], ua = acc[ai][1][m][q >> 1]; const int e0 = 2 * (q & 1);
                    f2 g = (f2){ga[e0], ga[e0 + 1]} * sc + bg[q], uu = (f2){ua[e0], ua[e0 + 1]} * sc + bu[q];
                    g.x = fminf(g.x, 7.0f); g.y = fminf(g.y, 7.0f); uu.x = __builtin_amdgcn_fmed3f(uu.x, -7.0f, 7.0f); uu.y = __builtin_amdgcn_fmed3f(uu.y, -7.0f, 7.0f);
                    const f2 z = g * (-1.702f * 1.4426950408889634f); f2 d; d.x = __builtin_amdgcn_exp2f(z.x); d.y = __builtin_amdgcn_exp2f(z.y); d = d + 1.0f;
                    f2 r; r.x = __builtin_amdgcn_rcpf(d.x); r.y = __builtin_amdgcn_rcpf(d.y);
                    const f2 res = (uu + 1.0f) * (g * r); o[2 * q] = res.x; o[2 * q + 1] = res.y; }
                const size_t off = (size_t)(row0 + ai * HALF + m * 16) * DE + j0;
                if (MOE_FP8) { *(unsigned long long*)((unsigned char*)act + off) = (unsigned long long)pk4_fp8(o[0], o[1], o[2], o[3]) | ((unsigned long long)pk4_fp8(o[4], o[5], o[6], o[7]) << 32); }
                else { u32x4 w;
#pragma unroll
                    for (int e = 0; e < 4; ++e) w[e] = cvt_pk_bf16(o[2 * e], o[2 * e + 1]);
                    *(u32x4*)((bf16_t*)act + off) = w; }
            }
    }
};
struct EpiY {
    static constexpr bool PERM = true, HAS_MID = false;
    const float* bd; bf16_t* y; float sc;
    struct Pre { f32x4 b[4]; };
    __device__ __forceinline__ Pre load_pre(const Unit& u, int wr, int wc, int fr, int fq) const { const float* bp = bd + (size_t)u.e * DM + u.pn * BM + wc * 32 + 8 * fq;
        Pre p; p.b[0] = *(const f32x4*)bp; p.b[1] = *(const f32x4*)(bp + 4); p.b[2] = *(const f32x4*)(bp + HALF); p.b[3] = *(const f32x4*)(bp + HALF + 4); return p; }
    __device__ __forceinline__ void mid(f32x4 (&)[2][2][4][2], const Unit&, int, int, int, int) const {}
    __device__ __forceinline__ void operator()(const f32x4 (&acc)[2][2][4][2], const Unit& u, int wr, int wc, int fr, int fq, const Pre& pre) const {
        const int row0 = u.pm * BM + wr * 64 + fr, col0 = u.pn * BM + wc * 32 + 8 * fq;
#pragma unroll
        for (int bj = 0; bj < 2; ++bj) {
            const f32x4 b0 = pre.b[2 * bj], b1 = pre.b[2 * bj + 1];
#pragma unroll
            for (int ai = 0; ai < 2; ++ai)
#pragma unroll
                for (int m = 0; m < 4; ++m) { const f32x4 v0 = acc[ai][bj][m][0] * sc + b0, v1 = acc[ai][bj][m][1] * sc + b1;
                    const size_t off = (size_t)(row0 + ai * HALF + m * 16) * DM + col0 + bj * HALF;
                    if (Y_FP8) *(unsigned long long*)((unsigned char*)y + off) = (unsigned long long)pk4_fp8(clamp448(v0[0]), clamp448(v0[1]), clamp448(v0[2]), clamp448(v0[3])) | ((unsigned long long)pk4_fp8(clamp448(v1[0]), clamp448(v1[1]), clamp448(v1[2]), clamp448(v1[3])) << 32);
                    else { u32x4 w; w[0] = cvt_pk_bf16(v0[0], v0[1]); w[1] = cvt_pk_bf16(v0[2], v0[3]); w[2] = cvt_pk_bf16(v1[0], v1[1]); w[3] = cvt_pk_bf16(v1[2], v1[3]);
                        *(u32x4*)(y + off) = w; } }
        }
    }
};
}

struct Frame {
    LAS unsigned char* lds; volatile LAS unsigned* MISC; unsigned* ctl;
    int tid, lane, wave, vcu, G;
    const float *x, *norm_mix_g, *w_in, *conv_w, *conv_b, *w_rg, *b_rg, *w_ig, *b_ig, *lam, *sinks, *w_attn_o, *w_lru_o, *w_out, *norm_ffn_g, *w_router, *b_router, *w_gu, *b_gu, *w_down, *b_down, *norm_final_g;
    const int* positions; float* out;
    unsigned char* ws;
    __device__ __forceinline__ bf16_t* Win_t() const { return (bf16_t*)(ws + WS_WIN); }
    __device__ __forceinline__ bf16_t* Wcat_t() const { return (bf16_t*)(ws + WS_WCAT); }
    __device__ __forceinline__ bf16_t* Wout_t() const { return (bf16_t*)(ws + WS_WOUT); }
    __device__ __forceinline__ bf16_t* Wgu_t() const { return (bf16_t*)(ws + WS_WGU); }
    __device__ __forceinline__ bf16_t* Wd_t() const { return (bf16_t*)(ws + WS_WD); }
    __device__ __forceinline__ bf16_t* Wrg_t() const { return (bf16_t*)(ws + WS_WRG); }
    __device__ __forceinline__ bf16_t* Wig_t() const { return (bf16_t*)(ws + WS_WIG); }
    __device__ __forceinline__ bf16_t* Wrt() const { return (bf16_t*)(ws + WS_WRT); }
    __device__ __forceinline__ bf16_t* h() const { return (bf16_t*)(ws + WS_H); }
    __device__ __forceinline__ bf16_t* q() const { return (bf16_t*)(ws + WS_Q); }
    __device__ __forceinline__ bf16_t* k() const { return (bf16_t*)(ws + WS_K); }
    __device__ __forceinline__ bf16_t* v() const { return (bf16_t*)(ws + WS_V); }
    __device__ __forceinline__ bf16_t* xr() const { return (bf16_t*)(ws + WS_XR); }
    __device__ __forceinline__ bf16_t* yg() const { return (bf16_t*)(ws + WS_YG); }
    __device__ __forceinline__ bf16_t* ratio() const { return (bf16_t*)(ws + WS_RATIO); }
    __device__ __forceinline__ bf16_t* gls() const { return (bf16_t*)(ws + WS_GLS); }
    __device__ __forceinline__ bf16_t* ao() const { return (bf16_t*)(ws + WS_AO); }
    __device__ __forceinline__ bf16_t* merged() const { return (bf16_t*)(ws + WS_MERGED); }
    __device__ __forceinline__ bf16_t* h2() const { return (bf16_t*)(ws + WS_H2); }
    __device__ __forceinline__ bf16_t* act() const { return (bf16_t*)(ws + WS_ACT); }
    __device__ __forceinline__ bf16_t* y() const { return (bf16_t*)(ws + WS_Y); }
    __device__ __forceinline__ float* x1() const { return (float*)(ws + WS_X1); }
    __device__ __forceinline__ bf16_t* dmix() const { return (bf16_t*)(ws + WS_X1); }
    __device__ __forceinline__ float* tok_w() const { return (float*)(ws + WS_TOKW); }
    __device__ __forceinline__ int* tok_e() const { return (int*)(ws + WS_TOKE); }
    __device__ __forceinline__ int* tok_p() const { return (int*)(ws + WS_TOKP); }
    __device__ __forceinline__ int* slot_tok() const { return (int*)(ws + WS_SLOT); }
};

struct XDesc { const float* src; unsigned char* dst; int N, ldd, kind, n0; };
constexpr int XA_IN = 16 * 60, XA_AO = 8 * 16, XA_OUT = 16 * 16, XA_G = LH, XA_N = XA_IN + 2 * XA_AO + XA_OUT + 2 * XA_G;
constexpr int XB_GU = NE * 16 * 32, XB_D = NE * 16 * 16, XB_N = XB_GU + XB_D;
__device__ __forceinline__ XDesc x_desc(const Frame& F, int list, int r) {
    XDesc d;
    if (list == 1) {
        if (r < XB_GU) { const int e = r >> 9, rr = r & 511, kb = rr >> 5, nb = rr & 31; d.src = F.w_gu + (size_t)e * DM * 2048 + (size_t)(64 * kb) * 2048 + 64 * nb; d.N = 2048; d.n0 = 64 * nb; d.ldd = DM;
            d.kind = MOE_FP8 ? 2 : 4; d.dst = (unsigned char*)F.Wgu_t() + ((size_t)e * 2048 * DM + 64 * kb) * (MOE_FP8 ? 1 : 2); return d; }
        r -= XB_GU; { const int e = r >> 8, rr = r & 255, kb = rr >> 4, nb = rr & 15; d.src = F.w_down + (size_t)e * DE * DM + (size_t)(64 * kb) * DM + 64 * nb; d.N = DM; d.n0 = 64 * nb; d.ldd = DE;
            d.kind = MOE_FP8 ? 3 : 0; d.dst = (unsigned char*)F.Wd_t() + ((size_t)e * DM * DE + 64 * kb) * (MOE_FP8 ? 1 : 2); return d; }
    }
    if (r < XA_IN) { const int kb = r / 60, nb = r % 60; d.src = F.w_in + (size_t)(64 * kb) * INW + 64 * nb; d.N = INW; d.n0 = 64 * nb; d.ldd = DM; d.kind = 1; d.dst = (unsigned char*)(F.Win_t() + 64 * kb); return d; } r -= XA_IN;
    if (r < XA_AO) { const int kb = r >> 4, nb = r & 15; d.src = F.w_attn_o + (size_t)(64 * kb) * DM + 64 * nb; d.N = DM; d.n0 = 64 * nb; d.ldd = DM; d.kind = 0; d.dst = (unsigned char*)(F.Wcat_t() + 64 * kb); return d; } r -= XA_AO;
    if (r < XA_AO) { const int kb = r >> 4, nb = r & 15; d.src = F.w_lru_o + (size_t)(64 * kb) * DM + 64 * nb; d.N = DM; d.n0 = 64 * nb; d.ldd = DM; d.kind = 0; d.dst = (unsigned char*)(F.Wcat_t() + 512 + 64 * kb); return d; } r -= XA_AO;
    if (r < XA_OUT) { const int kb = r >> 4, nb = r & 15; d.src = F.w_out + (size_t)(64 * kb) * DM + 64 * nb; d.N = DM; d.n0 = 64 * nb; d.ldd = DM; d.kind = 0; d.dst = (unsigned char*)(F.Wout_t() + 64 * kb); return d; } r -= XA_OUT;
    if (r < XA_G) { d.src = F.w_rg + r * 4096; d.N = 64; d.n0 = 0; d.ldd = 64; d.kind = 0; d.dst = (unsigned char*)(F.Wrg_t() + r * 4096); return d; } r -= XA_G;
    d.src = F.w_ig + r * 4096; d.N = 64; d.n0 = 0; d.ldd = 64; d.kind = 0; d.dst = (unsigned char*)(F.Wig_t() + r * 4096); return d;
}
__device__ __forceinline__ void xpose_write(LAS float* scr, const float (&v)[64], int lane) {
#pragma unroll
    for (int i = 0; i < 64; ++i) scr[i * 64 + (lane ^ (i & 31))] = v[i];
    asm volatile("" ::: "memory");
}
__device__ __forceinline__ void xpose_store(const XDesc& d, LAS float* scr, int lane) {
    const int c = lane & 7, nn = lane >> 3;
#pragma unroll
    for (int j = 0; j < 8; ++j) {
        const int n = nn + 8 * j, o = d.n0 + n;
        const int row = d.kind == 1 ? g1_inv(o) : (d.kind == 2 || d.kind == 4) ? gu_inv(o) : o;
        float f[8];
#pragma unroll
        for (int e = 0; e < 8; ++e) { const int kx = 8 * c + e; f[e] = scr[kx * 64 + (n ^ (kx & 31))]; }
        if (d.kind == 2 || d.kind == 3) {
#pragma unroll
            for (int e = 0; e < 8; ++e) f[e] = clamp448(f[e] * W8_SCALE);
            *(unsigned long long*)(d.dst + (size_t)row * d.ldd + 8 * c) = (unsigned long long)pk4_fp8(f[0], f[1], f[2], f[3]) | ((unsigned long long)pk4_fp8(f[4], f[5], f[6], f[7]) << 32);
        } else { u32x4 w; w.x = cvt_pk_bf16(f[0], f[1]); w.y = cvt_pk_bf16(f[2], f[3]); w.z = cvt_pk_bf16(f[4], f[5]); w.w = cvt_pk_bf16(f[6], f[7]);
            *(u32x4*)(d.dst + ((size_t)row * d.ldd + 8 * c) * 2) = w; }
    }
    asm volatile("s_waitcnt lgkmcnt(0)" ::: "memory");
}
__device__ __forceinline__ void xpose_run(const Frame& F, int list, int first, int count, int stride) {
    LAS float* scr = (LAS float*)(F.lds + F.wave * 16384);
    const int lane = F.lane;
    float va[64], vb[64];
    int ia = first, ib = first + stride;
    if (ia >= count) return;
    XDesc da = x_desc(F, list, ia), db = da;
#pragma unroll
    for (int i = 0; i < 64; ++i) va[i] = da.src[(size_t)i * da.N + lane];
    if (ib < count) { db = x_desc(F, list, ib);
#pragma unroll
        for (int i = 0; i < 64; ++i) vb[i] = db.src[(size_t)i * db.N + lane]; }
    for (;;) {
        {
            xpose_write(scr, va, lane);
            const XDesc dc = da; const int na = ia + 2 * stride;
            if (na < count) { da = x_desc(F, list, na);
#pragma unroll
                for (int i = 0; i < 64; ++i) va[i] = da.src[(size_t)i * da.N + lane]; }
            xpose_store(dc, scr, lane); ia = na;
        }
        if (ib >= count) break;
        {
            xpose_write(scr, vb, lane);
            const XDesc dc = db; const int nb = ib + 2 * stride;
            if (nb < count) { db = x_desc(F, list, nb);
#pragma unroll
                for (int i = 0; i < 64; ++i) vb[i] = db.src[(size_t)i * db.N + lane]; }
            xpose_store(dc, scr, lane); ib = nb;
        }
        if (ia >= count) break;
    }
}
__device__ __forceinline__ void xq8_load(const XDesc& d, f32x4 (&v)[16], int lane) {
    const float* p = d.src + (size_t)(lane & 3) * d.N + 4 * (lane >> 2);
#pragma unroll
    for (int i = 0; i < 16; ++i) v[i] = *(const f32x4*)(p + (size_t)(4 * i) * d.N);
}
__device__ __forceinline__ void xq8_store(const XDesc& d, const f32x4 (&v)[16], int lane) {
    const int kq = lane & 3; const unsigned selA = 0x0c0c0000u | ((4u + kq) << 8) | (unsigned)kq, selB = ((4u + kq) << 24) | ((unsigned)kq << 16) | 0x0c0cu;
    unsigned T[16];
#pragma unroll
    for (int i = 0; i < 16; ++i) {
        const int D = (int)pk4_fp8(clamp448(v[i].x * W8_SCALE), clamp448(v[i].y * W8_SCALE), clamp448(v[i].z * W8_SCALE), clamp448(v[i].w * W8_SCALE));
        const unsigned x0 = (unsigned)__builtin_amdgcn_mov_dpp(D, 0x00, 0xf, 0xf, true), x1 = (unsigned)__builtin_amdgcn_mov_dpp(D, 0x55, 0xf, 0xf, true),
                       x2 = (unsigned)__builtin_amdgcn_mov_dpp(D, 0xaa, 0xf, 0xf, true), x3 = (unsigned)__builtin_amdgcn_mov_dpp(D, 0xff, 0xf, 0xf, true);
        T[i] = __builtin_amdgcn_perm(x1, x0, selA) | __builtin_amdgcn_perm(x3, x2, selB);
    }
    const int o = d.n0 + 4 * (lane >> 2) + kq; const int row = d.kind == 2 ? gu_inv(o) : o;
    unsigned char* op = d.dst + (size_t)row * d.ldd;
#pragma unroll
    for (int q = 0; q < 4; ++q) *(u32x4*)(op + 16 * q) = (u32x4){T[4 * q], T[4 * q + 1], T[4 * q + 2], T[4 * q + 3]};
}
__device__ __forceinline__ void xq8_run(const Frame& F, int first, int count) {
    const int lane = F.lane; f32x4 va[16], vb[16];
    int ia = first, ib = first + 1; if (ia >= count) return;
    XDesc da = x_desc(F, 1, ia), db = da; xq8_load(da, va, lane);
    if (ib < count) { db = x_desc(F, 1, ib); xq8_load(db, vb, lane); }
    for (;;) {
        { const XDesc dc = da; f32x4 t[16];
#pragma unroll
          for (int i = 0; i < 16; ++i) t[i] = va[i];
          ia += 2; if (ia < count) { da = x_desc(F, 1, ia); xq8_load(da, va, lane); }
          xq8_store(dc, t, lane); }
        if (ib >= count) break;
        { const XDesc dc = db; f32x4 t[16];
#pragma unroll
          for (int i = 0; i < 16; ++i) t[i] = vb[i];
          ib += 2; if (ib < count) { db = x_desc(F, 1, ib); xq8_load(db, vb, lane); }
          xq8_store(dc, t, lane); }
        if (ia >= count) break;
    }
}
#ifndef XQ_DPP
#define XQ_DPP 0
#endif
#ifndef P1_XWG
#define P1_XWG 42
#endif
constexpr int XQ_TILES = 16, XQ_ITEMS = XB_N / XQ_TILES;
#ifndef XQ_P1
#define XQ_P1 576
#endif
constexpr int CW_XQ1 = 12288 + 64, CW_XQ2 = 12288 + 128;
__device__ __forceinline__ int wg_pull(Frame& F, int cw) {
    if (F.tid == 0) F.MISC[MW_Q] = atomicAdd(&F.ctl[cw], 1u);
    __syncthreads();
    const int item = (int)F.MISC[MW_Q];
    __syncthreads();
    return item;
}
__device__ __forceinline__ void xq_item(Frame& F, int idx) { const int t0 = idx * XQ_TILES + F.wave * 2; if (MOE_FP8 && XQ_DPP) xq8_run(F, t0, t0 + 2); else xpose_run(F, 1, t0, t0 + 2, 1); }
__device__ __forceinline__ void p0_prologue(Frame& F) {
    const int gw = F.vcu * NWAVES + F.wave, NGW = F.G * NWAVES;
    xpose_run(F, 0, gw, XA_N, NGW);
    for (int idx = gw * 64 + F.lane; idx < NE * DM; idx += NGW * 64) { const int e = idx >> 10, kx = idx & 1023; F.Wrt()[idx] = f2bf(F.w_router[kx * NE + e]); }
    f32x4 gv[4];
#pragma unroll
    for (int j = 0; j < 4; ++j) gv[j] = *(const f32x4*)(F.norm_mix_g + 4 * F.lane + 256 * j);
    for (int m0 = gw * 4; m0 < NTOK; m0 += NGW * 4) {
        f32x4 v[4][4];
#pragma unroll
        for (int r = 0; r < 4; ++r)
#pragma unroll
            for (int j = 0; j < 4; ++j) v[r][j] = *((const f32x4*)(F.x + (size_t)(m0 + r) * DM) + F.lane + 64 * j);
#pragma unroll
        for (int r = 0; r < 4; ++r) { float s = 0.f;
#pragma unroll
            for (int j = 0; j < 4; ++j) s += (v[r][j].x * v[r][j].x + v[r][j].y * v[r][j].y) + (v[r][j].z * v[r][j].z + v[r][j].w * v[r][j].w);
            const float rs = rsqrtf(wave_sum(s) * (1.0f / DM) + 1e-6f);
            unsigned long long* o8 = (unsigned long long*)(F.h() + (size_t)(m0 + r) * DM) + F.lane;
#pragma unroll
            for (int j = 0; j < 4; ++j) o8[64 * j] = (unsigned long long)cvt_pk_bf16(v[r][j].x * rs * gv[j].x, v[r][j].y * rs * gv[j].y) | ((unsigned long long)cvt_pk_bf16(v[r][j].z * rs * gv[j].z, v[r][j].w * rs * gv[j].w) << 32); }
    }
}

__device__ __forceinline__ s16x4 vtr(const LAS unsigned char* p) { typedef short v4i16_t __attribute__((ext_vector_type(4))); return __builtin_bit_cast(s16x4, __builtin_amdgcn_ds_read_tr16_b64_v4i16((LAS v4i16_t*)p)); }
constexpr int AT_KS = 0, AT_VS = 36864, AT_LS = 36864 + 32768;
__device__ __forceinline__ void attn_unit(Frame& F, int unit) {
    const int b = unit >> 5, kvh = (unit >> 4) & 1, qb = unit & 15;
    const int tid = F.tid, lane = F.lane, wid = F.wave, hi = lane >> 5, iq = lane & 31;
    const size_t n0 = (size_t)b * SEQ + 128 * qb;
    LAS unsigned char* Ks = F.lds + AT_KS; LAS unsigned char* Vs = F.lds + AT_VS; LAS float* Ls = (LAS float*)(F.lds + AT_LS) + wid * 32;
#pragma unroll
    for (int i = 0; i < 4; ++i) {
        const int ch = tid + 512 * i, key = ch >> 3, c = ch & 7; const bool valid = (qb > 0) || (key >= 128);
        u32x4 kv = (u32x4){0u, 0u, 0u, 0u}, vv = (u32x4){0u, 0u, 0u, 0u};
        if (valid) { const size_t tok = n0 - 128 + key; kv = *(const u32x4*)(F.k() + tok * KVW + kvh * 64 + c * 8); vv = *(const u32x4*)(F.v() + tok * KVW + kvh * 64 + c * 8); }
        *(LAS u32x4*)(Ks + key * 144 + c * 16) = kv;
        *(LAS u32x4*)(Vs + ((key >> 3) * 2 + (c >> 2)) * 512 + (key & 7) * 64 + (c & 3) * 16) = vv;
    }
    __syncthreads();
    const int g = wid >> 1, qh = wid & 1, hq = kvh * 4 + g;
    const float sink2 = F.sinks[hq] * 1.4426950408889634f; const float c2 = 0.125f * 1.4426950408889634f;
    const int voff = (4 * hi + ((lane & 15) >> 2)) * 64 + ((lane >> 4) & 1) * 32 + (lane & 3) * 8;
#pragma unroll 1
    for (int sb = 0; sb < 2; ++sb) {
        const int s1 = 2 * qh + sb; const size_t nq = n0 + 32 * s1 + iq;
        bf16x8 qf[4];
#pragma unroll
        for (int s = 0; s < 4; ++s) qf[s] = *(const bf16x8*)(F.q() + nq * AW + hq * 64 + 16 * s + 8 * hi);
        f32x16 p[5];
#pragma unroll
        for (int tt = 0; tt < 5; ++tt) {
            p[tt] = (f32x16){0.f, 0.f, 0.f, 0.f, 0.f, 0.f, 0.f, 0.f, 0.f, 0.f, 0.f, 0.f, 0.f, 0.f, 0.f, 0.f};
#pragma unroll
            for (int s = 0; s < 4; ++s) { const bf16x8 kf = *(const LAS bf16x8*)(Ks + (32 * (s1 + tt) + iq) * 144 + (16 * s + 8 * hi) * 2); p[tt] = __builtin_amdgcn_mfma_f32_32x32x16_bf16(kf, qf[s], p[tt], 0, 0, 0); }
        }
        float mx = sink2;
#pragma unroll
        for (int tt = 0; tt < 5; ++tt) {
            const bool tile_ok = (qb > 0) || (s1 + tt >= 4);
#pragma unroll
            for (int r = 0; r < 16; ++r) { const int kk = crow(r, hi); bool ok = tile_ok; if (tt == 0) ok = ok && (kk >= iq + 1); if (tt == 4) ok = ok && (kk <= iq);
                const float sc = ok ? p[tt][r] * c2 : -INFINITY; p[tt][r] = sc; mx = fmaxf(mx, sc); }
        }
        mx = fmaxf(mx, __shfl_xor(mx, 32));
        float l = 0.f;
#pragma unroll
        for (int tt = 0; tt < 5; ++tt)
#pragma unroll
            for (int r = 0; r < 16; ++r) { const float e = __builtin_amdgcn_exp2f(p[tt][r] - mx); p[tt][r] = e; l += e; }
        l += __shfl_xor(l, 32); l += __builtin_amdgcn_exp2f(sink2 - mx);
        f32x16 o[2];
        o[0] = (f32x16){0.f, 0.f, 0.f, 0.f, 0.f, 0.f, 0.f, 0.f, 0.f, 0.f, 0.f, 0.f, 0.f, 0.f, 0.f, 0.f}; o[1] = o[0];
#pragma unroll
        for (int tt = 0; tt < 5; ++tt)
#pragma unroll
            for (int s2 = 0; s2 < 2; ++s2) {
                u32x4 pw;
#pragma unroll
                for (int e = 0; e < 4; ++e) pw[e] = cvt_pk_bf16(p[tt][8 * s2 + 2 * e], p[tt][8 * s2 + 2 * e + 1]);
                const bf16x8 pa = __builtin_bit_cast(bf16x8, pw);
                const int sub = 4 * (s1 + tt) + 2 * s2;
#pragma unroll
                for (int db = 0; db < 2; ++db) {
                    const s16x4 lo = vtr(Vs + (sub * 2 + db) * 512 + voff), hi4 = vtr(Vs + ((sub + 1) * 2 + db) * 512 + voff);
                    const bf16x8 vb = (bf16x8){lo[0], lo[1], lo[2], lo[3], hi4[0], hi4[1], hi4[2], hi4[3]};
                    o[db] = __builtin_amdgcn_mfma_f32_32x32x16_bf16(pa, vb, o[db], 0, 0, 0);
                }
            }
        if (hi == 0) Ls[iq] = __builtin_amdgcn_rcpf(l);
        asm volatile("s_waitcnt lgkmcnt(0)" ::: "memory");
#pragma unroll
        for (int r = 0; r < 16; ++r) { const int qr = crow(r, hi); const float il = Ls[qr]; bf16_t* op = F.ao() + (n0 + 32 * s1 + qr) * DM + hq * 64 + iq;
            op[0] = f2bf(o[0][r] * il); op[32] = f2bf(o[1][r] * il); }
        asm volatile("s_waitcnt lgkmcnt(0)" ::: "memory");
    }
    __syncthreads();
}
constexpr int LR_XA = 0, LR_AS = 18432, LR_US = LR_AS + 32768, LR_CH = LR_US + 32768, LR_HC = LR_CH + 4096;
__device__ __forceinline__ void lru_unit(Frame& F, int unit) {
    const int b = unit >> 3, hh = unit & 7, C0 = 64 * hh;
    const int tid = F.tid, lane = F.lane, wid = F.wave, hi = lane >> 5;
    LAS unsigned char* XA = F.lds + LR_XA; LAS float* AS = (LAS float*)(F.lds + LR_AS); LAS float* US = (LAS float*)(F.lds + LR_US); LAS float* CH = (LAS float*)(F.lds + LR_CH); LAS float* HC = (LAS float*)(F.lds + LR_HC);
    const int tb = wid >> 1, cb = wid & 1, cm = 32 * cb + (lane & 31), Cm = C0 + cm;
    bf16x8 brg[4], big[4];
#pragma unroll
    for (int s = 0; s < 4; ++s) { brg[s] = *(const bf16x8*)(F.Wrg_t() + hh * 4096 + cm * 64 + 16 * s + 8 * hi); big[s] = *(const bf16x8*)(F.Wig_t() + hh * 4096 + cm * 64 + 16 * s + 8 * hi); }
    const float brg_b = F.b_rg[Cm], big_b = F.b_ig[Cm], sp8 = 8.0f * log1pf(__expf(-F.lam[Cm])) * 1.4426950408889634f;
    const int cs = tid & 63, js = wid, Cs = C0 + cs;
    const int tokc = tid >> 2, cq = tid & 3, Cq = C0 + 16 * cq;
    if (tid < 64) HC[tid] = 0.f;
    u32x4 xn[4][2];
    {
#pragma unroll
        for (int j = 0; j < 4; ++j) { const int tt = tokc - 3 + j;
#pragma unroll
            for (int hf = 0; hf < 2; ++hf) xn[j][hf] = tt >= 0 ? *(const u32x4*)(F.xr() + ((size_t)b * SEQ + tt) * LW + Cq + 8 * hf) : (u32x4){0u, 0u, 0u, 0u}; }
    }
#pragma unroll 1
    for (int tile = 0; tile < SEQ / 128; ++tile) {
        const int t0 = 128 * tile;
        {
            float xc[16];
#pragma unroll
            for (int e4 = 0; e4 < 4; ++e4) { const f32x4 cbv = *(const f32x4*)(F.conv_b + Cq + 4 * e4); xc[4 * e4] = cbv.x; xc[4 * e4 + 1] = cbv.y; xc[4 * e4 + 2] = cbv.z; xc[4 * e4 + 3] = cbv.w; }
#pragma unroll
            for (int j = 0; j < 4; ++j) { float xf[16]; { float t8[8]; unpack8(xn[j][0], t8);
#pragma unroll
                    for (int e = 0; e < 8; ++e) xf[e] = t8[e]; unpack8(xn[j][1], t8);
#pragma unroll
                    for (int e = 0; e < 8; ++e) xf[8 + e] = t8[e]; }
#pragma unroll
                for (int e4 = 0; e4 < 4; ++e4) { const f32x4 w = *(const f32x4*)(F.conv_w + j * LW + Cq + 4 * e4); xc[4 * e4] += xf[4 * e4] * w.x; xc[4 * e4 + 1] += xf[4 * e4 + 1] * w.y; xc[4 * e4 + 2] += xf[4 * e4 + 2] * w.z; xc[4 * e4 + 3] += xf[4 * e4 + 3] * w.w; } }
            u32x4 w0, w1;
#pragma unroll
            for (int e = 0; e < 4; ++e) { w0[e] = cvt_pk_bf16(xc[2 * e], xc[2 * e + 1]); w1[e] = cvt_pk_bf16(xc[8 + 2 * e], xc[8 + 2 * e + 1]); }
            *(LAS u32x4*)(XA + tokc * 144 + cq * 32) = w0; *(LAS u32x4*)(XA + tokc * 144 + cq * 32 + 16) = w1;
        }
        if (tile + 1 < SEQ / 128) {
#pragma unroll
            for (int j = 0; j < 4; ++j) { const size_t tt = (size_t)b * SEQ + t0 + 128 + tokc - 3 + j;
                xn[j][0] = *(const u32x4*)(F.xr() + tt * LW + Cq); xn[j][1] = *(const u32x4*)(F.xr() + tt * LW + Cq + 8); }
        }
        bf16_t ygv[16];
#pragma unroll
        for (int tt = 0; tt < 16; ++tt) ygv[tt] = F.yg()[((size_t)b * SEQ + t0 + 16 * js + tt) * LW + Cs];
        __syncthreads();
        {
            f32x16 drg = (f32x16){0.f, 0.f, 0.f, 0.f, 0.f, 0.f, 0.f, 0.f, 0.f, 0.f, 0.f, 0.f, 0.f, 0.f, 0.f, 0.f}, dig = drg;
#pragma unroll
            for (int s = 0; s < 4; ++s) { const bf16x8 af = *(const LAS bf16x8*)(XA + (32 * tb + (lane & 31)) * 144 + (16 * s + 8 * hi) * 2);
                drg = __builtin_amdgcn_mfma_f32_32x32x16_bf16(af, brg[s], drg, 0, 0, 0); dig = __builtin_amdgcn_mfma_f32_32x32x16_bf16(af, big[s], dig, 0, 0, 0); }
#pragma unroll
            for (int r = 0; r < 16; ++r) { const int t = 32 * tb + crow(r, hi);
                const float xcv = bf2f(*(const LAS bf16_t*)(XA + t * 144 + cm * 2));
                const float rg = fsig(drg[r] + brg_b), ig = fsig(dig[r] + big_b);
                const float la2 = -rg * sp8;
                const float a = __builtin_amdgcn_exp2f(la2);
                const float x2 = 2.0f * 0.6931471805599453f * la2;
                const float omp = -x2 * (1.0f + x2 * (0.5f + x2 * (0.16666667f + x2 * 0.041666668f))), omd = __builtin_fmaf(-a, a, 1.0f);
                const float om = x2 > -0.4f ? omp : omd;
                AS[t * 64 + cm] = a; US[t * 64 + cm] = __builtin_amdgcn_sqrtf(om) * (ig * xcv); }
        }
        __syncthreads();
        float av[16], uv[16]; float Ap = 1.f, Hp = 0.f;
#pragma unroll
        for (int tt = 0; tt < 16; ++tt) { av[tt] = AS[(16 * js + tt) * 64 + cs]; uv[tt] = US[(16 * js + tt) * 64 + cs]; }
#pragma unroll
        for (int tt = 0; tt < 16; ++tt) { Hp = av[tt] * Hp + uv[tt]; Ap *= av[tt]; }
        CH[js * 64 + cs] = Ap; CH[512 + js * 64 + cs] = Hp;
        __syncthreads();
        float hcur = HC[cs];
        for (int jj = 0; jj < js; ++jj) hcur = CH[jj * 64 + cs] * hcur + CH[512 + jj * 64 + cs];
#pragma unroll
        for (int tt = 0; tt < 16; ++tt) { hcur = av[tt] * hcur + uv[tt]; F.ao()[((size_t)b * SEQ + t0 + 16 * js + tt) * DM + 512 + Cs] = f2bf(hcur * bf2f(ygv[tt])); }
        __syncthreads();
        if (js == 7) HC[cs] = hcur;
    }
    __syncthreads();
}
__device__ __forceinline__ void p2_mixers(Frame& F) {
    constexpr int NLRU = NB * LH, NATT = NB * NKVH * (SEQ / 128);
    for (;;) {
        const int item = wg_pull(F, CW_QUEUE);
        if (item >= NLRU + NATT) break;
        if (item < NLRU) lru_unit(F, item); else attn_unit(F, item - NLRU);
    }
    for (;;) { const int idx = XQ_P1 + wg_pull(F, CW_XQ2); if (idx >= XQ_ITEMS) break; xq_item(F, idx); }
}

__device__ __forceinline__ void moe_tables(Frame& F) {
    if (F.tid < 64) {
        const int e = F.tid & 31; const int c = (int)__hip_atomic_load(&F.ctl[CW_GCOUNT + 64 * e], __ATOMIC_RELAXED, __HIP_MEMORY_SCOPE_AGENT);
        const int nt = (c + 255) >> 8; int inc = nt;
#pragma unroll
        for (int o = 1; o < 32; o <<= 1) { const int v = __shfl_up(inc, o, 32); if ((F.tid & 31) >= o) inc += v; }
        if (F.tid < 32) { F.MISC[MW_TS + e] = (unsigned)(inc - nt); F.MISC[MW_CNT + e] = (unsigned)c; if (e == 31) F.MISC[MW_TS + NE] = (unsigned)inc; }
    }
    __syncthreads();
    for (int m = F.tid; m < MAXTILES; m += NWAVES * 64) { int e = 0; for (int ee = 1; ee < NE; ++ee) e = (m >= (int)F.MISC[MW_TS + ee]) ? ee : e; F.MISC[MW_TE + m] = (unsigned)e; }
    __syncthreads();
}

__device__ __forceinline__ f32x4 x1_piece(const Frame& F, size_t row, int lane, int j) {
    const f32x4 xv = *((const f32x4*)(F.x + row * DM) + lane + 64 * j);
    const unsigned long long t = *((const unsigned long long*)(F.dmix() + row * DM) + lane + 64 * j); const unsigned lo = (unsigned)t, hi = (unsigned)(t >> 32);
    return xv + (f32x4){__uint_as_float(lo << 16), __uint_as_float(lo & 0xffff0000u), __uint_as_float(hi << 16), __uint_as_float(hi & 0xffff0000u)};
}
constexpr int P5_WT = 0, P5_AT = 66048, P5_ROW = 2064;
__device__ __forceinline__ void p5_router(Frame& F) {
    LAS unsigned char* WT = F.lds + P5_WT; LAS unsigned char* AT = F.lds + P5_AT;
    LAS float* PART = (LAS float*)AT;
    LAS float* LG = (LAS float*)(F.lds + MISC_OFF) + MW_P5;
    LAS float* RS = LG + 32 * 33;
    volatile LAS int* LCNT = (volatile LAS int*)(F.lds + MISC_OFF) + MW_P5 + 1280;
    volatile LAS int* LBASE = LCNT + 32;
    LAS int* PE = (LAS int*)(F.lds + MISC_OFF) + MW_P5 + 1280 + 64;
    LAS float* PW = (LAS float*)(PE + 512);
    const int tid = F.tid, lane = F.lane, wid = F.wave, hi = lane >> 5;
    for (int i = tid; i < NE * 128; i += NWAVES * 64) { const int e = i >> 7, c = i & 127; *(LAS u32x4*)(WT + e * P5_ROW + c * 16) = *(const u32x4*)(F.Wrt() + e * DM + c * 8); }
    if (tid < 32) LCNT[tid] = 0;
    const int row_base = F.vcu * 128;
    f32x4 gv[4];
#pragma unroll
    for (int j = 0; j < 4; ++j) gv[j] = *(const f32x4*)(F.norm_ffn_g + 4 * lane + 256 * j);
    f32x4 xn[4][4];
#pragma unroll
    for (int rr = 0; rr < 4; ++rr)
#pragma unroll
        for (int j = 0; j < 4; ++j) xn[rr][j] = x1_piece(F, (size_t)(row_base + wid * 4 + rr), lane, j);
#pragma unroll 1
    for (int it = 0; it < 4; ++it) {
        const int r0 = row_base + it * 32 + wid * 4;
#pragma unroll
        for (int rr = 0; rr < 4; ++rr) { float s = 0.f;
#pragma unroll
            for (int j = 0; j < 4; ++j) s += (xn[rr][j].x * xn[rr][j].x + xn[rr][j].y * xn[rr][j].y) + (xn[rr][j].z * xn[rr][j].z + xn[rr][j].w * xn[rr][j].w);
            const float rs = rsqrtf(wave_sum(s) * (1.0f / DM) + 1e-6f);
            unsigned long long* o8 = (unsigned long long*)(F.h2() + (size_t)(r0 + rr) * DM) + lane;
            unsigned* o4 = (unsigned*)((unsigned char*)F.h2() + (size_t)(r0 + rr) * DM) + lane;
#pragma unroll
            for (int j = 0; j < 4; ++j) { const f32x4 hv = xn[rr][j] * gv[j] * rs;
                if (MOE_FP8) o4[64 * j] = pk4_fp8(clamp448(hv.x), clamp448(hv.y), clamp448(hv.z), clamp448(hv.w));
                else o8[64 * j] = (unsigned long long)cvt_pk_bf16(hv.x, hv.y) | ((unsigned long long)cvt_pk_bf16(hv.z, hv.w) << 32);
                *(LAS unsigned long long*)(AT + (wid * 4 + rr) * P5_ROW + (4 * lane + 256 * j) * 2) = (unsigned long long)cvt_pk_bf16(hv.x, hv.y) | ((unsigned long long)cvt_pk_bf16(hv.z, hv.w) << 32); } }
        if (it + 1 < 4) {
#pragma unroll
            for (int rr = 0; rr < 4; ++rr)
#pragma unroll
                for (int j = 0; j < 4; ++j) xn[rr][j] = x1_piece(F, (size_t)(r0 + 32 + rr), lane, j);
        }
        __syncthreads();
        {
            f32x16 acc = (f32x16){0.f, 0.f, 0.f, 0.f, 0.f, 0.f, 0.f, 0.f, 0.f, 0.f, 0.f, 0.f, 0.f, 0.f, 0.f, 0.f};
#pragma unroll
            for (int s = 0; s < 8; ++s) { const int ko = (16 * (8 * wid + s) + 8 * hi) * 2;
                const bf16x8 af = *(const LAS bf16x8*)(AT + (lane & 31) * P5_ROW + ko), bfr = *(const LAS bf16x8*)(WT + (lane & 31) * P5_ROW + ko);
                acc = __builtin_amdgcn_mfma_f32_32x32x16_bf16(af, bfr, acc, 0, 0, 0); }
            __syncthreads();
#pragma unroll
            for (int r = 0; r < 16; ++r) PART[(wid * 16 + r) * 64 + lane] = acc[r];
        }
        __syncthreads();
#pragma unroll
        for (int q = 0; q < 2; ++q) { const int r = (tid >> 6) + 8 * q, ln = tid & 63; float sum = 0.f;
#pragma unroll
            for (int w = 0; w < 8; ++w) sum += PART[(w * 16 + r) * 64 + ln];
            LG[crow(r, ln >> 5) * 33 + (ln & 31)] = sum + F.b_router[ln & 31]; }
        __syncthreads();
        if (tid < 32) {
            const LAS float* lg = LG + tid * 33; unsigned used = 0; float tv[4]; int te[4];
#pragma unroll
            for (int kk = 0; kk < 4; ++kk) { float best = -3.0e38f; int bi = 0;
                for (int e = 0; e < NE; ++e) { const float vv = lg[e]; if (!((used >> e) & 1u) && vv > best) { best = vv; bi = e; } }
                used |= 1u << bi; tv[kk] = best; te[kk] = bi; }
            float ex[4], sum = 0.f;
#pragma unroll
            for (int kk = 0; kk < 4; ++kk) { ex[kk] = __expf(tv[kk] - tv[0]); sum += ex[kk]; }
            const float inv = 1.0f / sum; const int lr = it * 32 + tid;
#pragma unroll
            for (int kk = 0; kk < 4; ++kk) { const int lp = __hip_atomic_fetch_add((LAS int*)&LCNT[te[kk]], 1, __ATOMIC_RELAXED, __HIP_MEMORY_SCOPE_WORKGROUP); PE[lr * 4 + kk] = te[kk] | (lp << 8); PW[lr * 4 + kk] = ex[kk] * inv; }
        }
    }
    __syncthreads();
    if (tid < 32) { const int c = LCNT[tid]; LBASE[tid] = c ? (int)atomicAdd(&F.ctl[CW_GCOUNT + 64 * tid], (unsigned)c) : 0; }
    __syncthreads();
    { const int pe = PE[tid], e = pe & 255, lp = pe >> 8, pos = LBASE[e] + lp, row = row_base + (tid >> 2);
      F.tok_e()[row * 4 + (tid & 3)] = e; F.tok_w()[row * 4 + (tid & 3)] = PW[tid]; F.tok_p()[row * 4 + (tid & 3)] = pos; F.slot_tok()[(size_t)e * CAP + pos] = row; }
}

struct P8Row { f32x4 x[4]; unsigned yv[4][4]; float w[4]; };
__device__ __forceinline__ void p8_load(const Frame& F, int m, int lane, P8Row& r) {
    const int4 e4 = *(const int4*)(F.tok_e() + m * 4), p4 = *(const int4*)(F.tok_p() + m * 4); const f32x4 w4 = *(const f32x4*)(F.tok_w() + m * 4);
    const int ee[4] = {e4.x, e4.y, e4.z, e4.w}, pp[4] = {p4.x, p4.y, p4.z, p4.w}; r.w[0] = w4.x; r.w[1] = w4.y; r.w[2] = w4.z; r.w[3] = w4.w;
#pragma unroll
    for (int kk = 0; kk < 4; ++kk) { const size_t yrow = (size_t)256 * F.MISC[MW_TS + ee[kk]] + pp[kk];
        const unsigned* yp = (const unsigned*)((const unsigned char*)F.y() + yrow * DM) + lane;
#pragma unroll
        for (int j = 0; j < 4; ++j) r.yv[kk][j] = yp[64 * j]; }
#pragma unroll
    for (int j = 0; j < 4; ++j) r.x[j] = x1_piece(F, (size_t)m, lane, j);
}
__device__ __forceinline__ void p8_final(Frame& F) {
    static_assert(Y_FP8 && MOE_FP8, "p8_final reads fp8 y rows");
    const int gw = F.vcu * NWAVES + F.wave, NGW = F.G * NWAVES, lane = F.lane;
    f32x4 gv[4];
#pragma unroll
    for (int j = 0; j < 4; ++j) gv[j] = *(const f32x4*)(F.norm_final_g + 4 * lane + 256 * j);
    if (gw >= NTOK) return;
    P8Row cur, nxt; p8_load(F, gw, lane, cur);
    for (int m = gw; m < NTOK; m += NGW) {
        const int mn = m + NGW;
        if (mn < NTOK) p8_load(F, mn, lane, nxt);
        f32x4 v[4];
#pragma unroll
        for (int j = 0; j < 4; ++j) v[j] = cur.x[j];
#pragma unroll
        for (int kk = 0; kk < 4; ++kk)
#pragma unroll
            for (int j = 0; j < 4; ++j) { const int t = (int)cur.yv[kk][j]; const auto lo2 = __builtin_amdgcn_cvt_pk_f32_fp8(t, false), hi2 = __builtin_amdgcn_cvt_pk_f32_fp8(t, true); const float w = cur.w[kk];
                v[j].x += w * lo2[0]; v[j].y += w * lo2[1]; v[j].z += w * hi2[0]; v[j].w += w * hi2[1]; }
        float s = 0.f;
#pragma unroll
        for (int j = 0; j < 4; ++j) s += (v[j].x * v[j].x + v[j].y * v[j].y) + (v[j].z * v[j].z + v[j].w * v[j].w);
        const float rs = rsqrtf(wave_sum(s) * (1.0f / DM) + 1e-6f);
#pragma unroll
        for (int j = 0; j < 4; ++j) *((f32x4*)(F.out + (size_t)m * DM) + lane + 64 * j) = v[j] * rs * gv[j];
        cur = nxt;
    }
}

constexpr int NPHASE = 9;
struct Args { const void* in[23]; float* out; unsigned char* ws; int ph_lo, ph_hi; };
__global__ void __launch_bounds__(NWAVES * 64, 2) mega_fwd(Args args) {
    extern __shared__ __attribute__((aligned(16))) unsigned char lds_raw[];
    Frame F;
    F.lds = (LAS unsigned char*)lds_raw; F.MISC = (volatile LAS unsigned*)(F.lds + MISC_OFF);
    F.tid = threadIdx.x; F.lane = F.tid & 63; F.wave = __builtin_amdgcn_readfirstlane(F.tid >> 6);
    F.G = gridDim.x; { const int bx = blockIdx.x; F.vcu = (F.G % 8 == 0) ? (bx % 8) * (F.G / 8) + bx / 8 : bx; }
    unsigned char* ws = args.ws; F.ctl = (unsigned*)(ws + WS_CTL);
    F.x = (const float*)args.in[0]; F.positions = (const int*)args.in[1]; F.norm_mix_g = (const float*)args.in[2]; F.w_in = (const float*)args.in[3];
    F.conv_w = (const float*)args.in[4]; F.conv_b = (const float*)args.in[5]; F.w_rg = (const float*)args.in[6]; F.b_rg = (const float*)args.in[7];
    F.w_ig = (const float*)args.in[8]; F.b_ig = (const float*)args.in[9]; F.lam = (const float*)args.in[10]; F.sinks = (const float*)args.in[11];
    F.w_attn_o = (const float*)args.in[12]; F.w_lru_o = (const float*)args.in[13]; F.w_out = (const float*)args.in[14]; F.norm_ffn_g = (const float*)args.in[15];
    F.w_router = (const float*)args.in[16]; F.b_router = (const float*)args.in[17]; F.w_gu = (const float*)args.in[18]; F.b_gu = (const float*)args.in[19];
    F.w_down = (const float*)args.in[20]; F.b_down = (const float*)args.in[21]; F.norm_final_g = (const float*)args.in[22]; F.out = args.out;
    F.ws = ws;
    for (int u = F.tid; u < (LDS_BYTES - MISC_OFF) / 4; u += NWAVES * 64) ((LAS unsigned*)(F.lds + MISC_OFF))[u] = 0u;
    __syncthreads();
    const int lo = args.ph_lo, hi = args.ph_hi;
    const bool multi = (hi - lo) > 1;
    XcdBarrier bar; bar.bar = F.ctl + CW_BAR; bar.x = 0; bar.st = nullptr;
    if (multi) bar = xcd_barrier_post(F.ctl + CW_BAR, F.MISC + 8);
#ifndef PH_ONLY
#define PH_ONLY -1
#endif
#define IN(k) ((PH_ONLY < 0 || PH_ONLY == (k)) && lo <= (k) && (k) < hi)
#define SEAM(k) do { if (IN(k) && IN((k) + 1)) xcd_barrier(bar); } while (0)
#ifndef PROBE_K
#define PROBE_K -1
#endif
    unsigned long long pr_t0 = 0, pr_t1 = 0;
#define PSTAMP(k) do { if (PROBE_K >= 0) { if ((k) == PROBE_K) pr_t0 = __builtin_amdgcn_s_memrealtime(); if ((k) == PROBE_K + 1) pr_t1 = __builtin_amdgcn_s_memrealtime(); } } while (0)
    PSTAMP(0);
    if (IN(0)) { p0_prologue(F); SEAM(0); }
    PSTAMP(1);
    if (IN(1)) {
        const int ngemm = (P1_XWG > 0 && (int)F.G > P1_XWG) ? (int)F.G - P1_XWG : (int)F.G;
        if ((int)blockIdx.x < ngemm) { pg8::DenseSched S; S.init(F.h(), F.Win_t(), NTOK, INW, ngemm, (int)blockIdx.x);
            pg8::EpiG1 E{F.positions, F.q(), F.k(), F.v(), F.xr(), F.yg(), F.ratio(), F.gls()};
            pg8::gemm_phase<pg8::EpiG1, pg8::DenseSched, true, 2>(F.lds, S, E); }
        else { for (;;) { const int idx = wg_pull(F, CW_XQ1); if (idx >= XQ_P1) break; xq_item(F, idx); } }
        SEAM(1); }
    PSTAMP(2);
    if (IN(2)) { p2_mixers(F); SEAM(2); }
    PSTAMP(3);
    if (IN(3)) { pg8::DenseSched S; S.init(F.ao(), F.Wcat_t(), NTOK, DM, F.G, (int)blockIdx.x);
        pg8::EpiMerged E{F.ratio(), F.gls(), F.merged()};
        pg8::gemm_phase<pg8::EpiMerged, pg8::DenseSched, true, 2>(F.lds, S, E); SEAM(3); }
    PSTAMP(4);
    if (IN(4)) { pg8::DenseSched S; S.init(F.merged(), F.Wout_t(), NTOK, DM, F.G, (int)blockIdx.x);
        pg8::EpiD E{F.dmix()};
        pg8::gemm_phase<pg8::EpiD, pg8::DenseSched, true, 2>(F.lds, S, E); SEAM(4); }
    PSTAMP(5);
    if (IN(5)) { p5_router(F); SEAM(5); }
    PSTAMP(6);
    if (IN(6)) { moe_tables(F); constexpr int EB = MOE_FP8 ? 1 : 2;
        pg8::MoeSched<true, EB> S; S.init(F.h2(), F.Wgu_t(), F.slot_tok(), (const volatile LAS int*)(F.MISC + MW_TS), (const volatile LAS int*)(F.MISC + MW_CNT), 8, F.G, (int)blockIdx.x);
        pg8::EpiAct E{F.b_gu, F.act(), MOE_FP8 ? W8_INV : 1.0f};
        pg8::gemm_phase<pg8::EpiAct, pg8::MoeSched<true, EB>, true, EB>(F.lds, S, E); SEAM(6); }
    PSTAMP(7);
    if (IN(7)) { moe_tables(F); constexpr int EB = MOE_FP8 ? 1 : 2;
        pg8::MoeSched<false, EB> S; S.init(F.act(), F.Wd_t(), F.slot_tok(), (const volatile LAS int*)(F.MISC + MW_TS), (const volatile LAS int*)(F.MISC + MW_CNT), 4, F.G, (int)blockIdx.x);
#ifndef KREP7
#define KREP7 1
#endif
        pg8::EpiY E{F.b_down, F.y(), (MOE_FP8 ? W8_INV : 1.0f) / KREP7};
        pg8::gemm_phase<pg8::EpiY, pg8::MoeSched<false, EB>, true, EB, KREP7>(F.lds, S, E); SEAM(7); }
    PSTAMP(8);
    if (IN(8)) { moe_tables(F); p8_final(F); }
    PSTAMP(9);
    if (PROBE_K >= 0 && blockIdx.x == 0 && F.tid == 0) { const unsigned long long d = pr_t1 - pr_t0, te = __builtin_amdgcn_s_memrealtime(); while (__builtin_amdgcn_s_memrealtime() - te < d) __builtin_amdgcn_s_sleep(8); }
#undef IN
#undef SEAM
}

#ifndef OPT_MASK
#define OPT_MASK 0x1FF
#define FORCE_MULTI 0
#endif
extern "C" void kernel_launch(void* const* d_in, const int* in_sizes, int n_in, void* d_out, int out_size, void* d_ws, size_t ws_size, hipStream_t stream) {
    if (n_in != 23 || ws_size < WS_END) { fprintf(stderr, "kernel_launch: unexpected inputs (%d) or workspace (%zu)\n", n_in, ws_size); return; }
    static int grid = 0;
    if (grid == 0) {
        int dev = 0, cus = 0;
        if (hipGetDevice(&dev) != hipSuccess || hipDeviceGetAttribute(&cus, hipDeviceAttributeMultiprocessorCount, dev) != hipSuccess) { grid = -1; return; }
        if (hipFuncSetAttribute((const void*)mega_fwd, hipFuncAttributeMaxDynamicSharedMemorySize, LDS_BYTES) != hipSuccess) { fprintf(stderr, "kernel_launch: hipFuncSetAttribute failed\n"); grid = -1; return; }
        int per_cu = 0; (void)hipOccupancyMaxActiveBlocksPerMultiprocessor(&per_cu, (const void*)mega_fwd, NWAVES * 64, LDS_BYTES); (void)hipGetLastError();
        grid = 256; if (cus != 256 || per_cu < 1) fprintf(stderr, "kernel_launch: note: %d CUs, occupancy %d\n", cus, per_cu);
    }
    if (grid < 0) return;
    const float* x = (const float*)d_in[0]; const int* positions = (const int*)d_in[1]; const float* norm_mix_g = (const float*)d_in[2]; const float* w_in = (const float*)d_in[3];
    const float* conv_w = (const float*)d_in[4]; const float* conv_b = (const float*)d_in[5]; const float* w_rg = (const float*)d_in[6]; const float* b_rg = (const float*)d_in[7];
    const float* w_ig = (const float*)d_in[8]; const float* b_ig = (const float*)d_in[9]; const float* lam = (const float*)d_in[10]; const float* sinks = (const float*)d_in[11];
    const float* w_attn_o = (const float*)d_in[12]; const float* w_lru_o = (const float*)d_in[13]; const float* w_out = (const float*)d_in[14]; const float* norm_ffn_g = (const float*)d_in[15];
    const float* w_router = (const float*)d_in[16]; const float* b_router = (const float*)d_in[17]; const float* w_gu = (const float*)d_in[18]; const float* b_gu = (const float*)d_in[19];
    const float* w_down = (const float*)d_in[20]; const float* b_down = (const float*)d_in[21]; const float* norm_final_g = (const float*)d_in[22];
    unsigned char* ws = (unsigned char*)d_ws; float* out = (float*)d_out;
    unsigned* ctl = (unsigned*)(ws + WS_CTL);
    bf16_t* Win_t = (bf16_t*)(ws + WS_WIN); bf16_t* Wcat_t = (bf16_t*)(ws + WS_WCAT); bf16_t* Wout_t = (bf16_t*)(ws + WS_WOUT); bf16_t* Wgu_t = (bf16_t*)(ws + WS_WGU); bf16_t* Wd_t = (bf16_t*)(ws + WS_WD);
    bf16_t* Wrg_t = (bf16_t*)(ws + WS_WRG); bf16_t* Wig_t = (bf16_t*)(ws + WS_WIG);
    float* x1 = (float*)(ws + WS_X1); bf16_t* h2 = (bf16_t*)(ws + WS_H2); bf16_t* act = (bf16_t*)(ws + WS_ACT); bf16_t* y = (bf16_t*)(ws + WS_Y);
    bf16_t* h = (bf16_t*)(ws + WS_H); bf16_t* q = (bf16_t*)(ws + WS_Q); bf16_t* k = (bf16_t*)(ws + WS_K); bf16_t* v = (bf16_t*)(ws + WS_V); bf16_t* xr = (bf16_t*)(ws + WS_XR); bf16_t* yg = (bf16_t*)(ws + WS_YG);
    bf16_t* ratio = (bf16_t*)(ws + WS_RATIO); bf16_t* gls = (bf16_t*)(ws + WS_GLS); bf16_t* ao = (bf16_t*)(ws + WS_AO); bf16_t* merged = (bf16_t*)(ws + WS_MERGED); float* xc = (float*)(ws + WS_XC);
    int* tok_e = (int*)(ws + WS_TOKE); float* tok_w = (float*)(ws + WS_TOKW); int* tok_p = (int*)(ws + WS_TOKP); int* slot_tok = (int*)(ws + WS_SLOT); float* logits = (float*)(ws + WS_LOGIT); float* rstd = (float*)(ws + WS_RSTD);

    (void)hipMemsetAsync(ws + WS_CTL, 0, CTL_BYTES, stream);
    Args a{};
    for (int i = 0; i < 23; ++i) a.in[i] = d_in[i];
    a.out = out; a.ws = ws;
#ifndef FORCE_MULTI
#define FORCE_MULTI 0
#endif
    if (OPT_MASK == 0x1FF && !FORCE_MULTI) { a.ph_lo = 0; a.ph_hi = NPHASE; hipLaunchKernelGGL(mega_fwd, dim3(grid), dim3(NWAVES * 64), LDS_BYTES, stream, a); return; }
    const int G = 2048, B = 256;
    for (int ph = 0; ph < NPHASE; ++ph) {
        if ((OPT_MASK >> ph) & 1) { a.ph_lo = ph; a.ph_hi = ph + 1; hipLaunchKernelGGL(mega_fwd, dim3(grid), dim3(NWAVES * 64), LDS_BYTES, stream, a); continue; }
        switch (ph) {
        case 0:
            nv_transpose<<<G, B, 0, stream>>>(w_in, DM, INW, Win_t, DM, 0, INW, 1, 1);
            nv_transpose<<<G, B, 0, stream>>>(w_attn_o, 512, DM, Wcat_t, DM, 0, DM, 0, 1);
            nv_transpose<<<G, B, 0, stream>>>(w_lru_o, 512, DM, Wcat_t, DM, 512, DM, 0, 1);
            nv_transpose<<<G, B, 0, stream>>>(w_out, DM, DM, Wout_t, DM, 0, DM, 0, 1);
            nv_transpose<<<G, B, 0, stream>>>(w_gu, DM, 2048, Wgu_t, DM, 0, 2048, 2, NE);
            nv_transpose<<<G, B, 0, stream>>>(w_down, DE, DM, Wd_t, DE, 0, DM, 0, NE);
            nv_transpose<<<G, B, 0, stream>>>(w_rg, 64, 64, Wrg_t, 64, 0, 64, 0, LH);
            nv_transpose<<<G, B, 0, stream>>>(w_ig, 64, 64, Wig_t, 64, 0, 64, 0, LH);
            nv_rmsnorm_bf16<<<G, B, 0, stream>>>(x, norm_mix_g, h, nullptr); break;
        case 1: nv_gemm1<<<G * 4, B, 0, stream>>>(h, Win_t, positions, q, k, v, xr, yg, ratio, gls); break;
        case 2:
            nv_attn<<<G, B, 0, stream>>>(q, k, v, sinks, ao);
            nv_conv<<<G, B, 0, stream>>>(xr, conv_w, conv_b, xc);
            nv_scan<<<NB * LW / 64, 64, 0, stream>>>(xc, w_rg, b_rg, w_ig, b_ig, lam, yg, ao); break;
        case 3: nv_merged<<<G * 4, B, 0, stream>>>(ao, Wcat_t, ratio, gls, merged); break;
        case 4: nv_wout<<<G * 4, B, 0, stream>>>(merged, Wout_t, x, x1); break;
        case 5:
            nv_rmsnorm_bf16<<<G, B, 0, stream>>>(x1, norm_ffn_g, h2, rstd);
            nv_logits<<<G, B, 0, stream>>>(x1, rstd, norm_ffn_g, w_router, b_router, logits);
            nv_topk<<<NTOK / 256, 256, 0, stream>>>(logits, ctl, tok_e, tok_w, tok_p, slot_tok); break;
        case 6: nv_moe1<<<G * 4, B, 0, stream>>>(ctl, slot_tok, h2, Wgu_t, b_gu, act); break;
        case 7: nv_moe2<<<G * 4, B, 0, stream>>>(ctl, act, Wd_t, b_down, y); break;
        case 8: nv_final<<<G, B, 0, stream>>>(ctl, x1, tok_e, tok_w, tok_p, y, norm_final_g, out); break;
        }
    }
}
```

```cpp
#include <hip/hip_runtime.h>
#include <stdint.h>
#include <stdio.h>

#ifndef Y_FP8
#define Y_FP8 1
#endif
#ifndef KROT
#define KROT 1
#endif
#ifndef MOE_ORDER
#define MOE_ORDER 0
#endif
#ifndef MOE_FP8
#define MOE_FP8 1
#endif
constexpr float W8_SCALE = 32.0f, W8_INV = 1.0f / 32.0f;
typedef unsigned short bf16_t;
typedef unsigned u32x4 __attribute__((ext_vector_type(4)));

constexpr int NB = 16, SEQ = 2048, NTOK = NB * SEQ, DM = 1024;
constexpr int NQH = 8, NKVH = 2, HD = 64, AW = 512, KVW = 128, LW = 512, LH = 8, LB = 64;
constexpr int INW = 3840, NE = 32, TOPK = 4, DE = 1024;
constexpr int CAP = NTOK;
constexpr int MAXTILES = NTOK * TOPK / 256 + NE;
constexpr int MAXROWS = MAXTILES * 256;

constexpr size_t MiB = 1u << 20;
constexpr size_t WS_CTL = 0, CTL_BYTES = 65536;
constexpr size_t WS_WRG = 1 * MiB;
constexpr size_t WS_WIG = WS_WRG + 65536;
constexpr size_t WS_WRT = WS_WRG + 131072;
constexpr size_t WS_TOKE = 2 * MiB;
constexpr size_t WS_TOKW = 2 * MiB + 512 * 1024;
constexpr size_t WS_TOKP = 3 * MiB;
constexpr size_t WS_SLOT = 4 * MiB;
constexpr size_t WS_LOGIT = 8 * MiB;
constexpr size_t WS_RSTD = 12 * MiB;
constexpr size_t WS_WIN = 16 * MiB;
constexpr size_t WS_WCAT = 24 * MiB;
constexpr size_t WS_WOUT = 26 * MiB;
constexpr size_t WS_WGU = 28 * MiB;
constexpr size_t WS_WD = 156 * MiB;
constexpr size_t WS_X1 = 220 * MiB;
constexpr size_t WS_H2 = 348 * MiB;
constexpr size_t WS_ACT = 412 * MiB;
constexpr size_t WS_Y = 684 * MiB;
constexpr size_t WS_H = 412 * MiB;
constexpr size_t WS_Q = 476 * MiB;
constexpr size_t WS_K = 508 * MiB;
constexpr size_t WS_V = 516 * MiB;
constexpr size_t WS_XR = 524 * MiB;
constexpr size_t WS_YG = 556 * MiB;
constexpr size_t WS_RATIO = 588 * MiB;
constexpr size_t WS_GLS = 652 * MiB;
constexpr size_t WS_AO = 716 * MiB;
constexpr size_t WS_MERGED = 780 * MiB;
constexpr size_t WS_XC = 844 * MiB;
constexpr size_t WS_END = 956 * MiB;
constexpr int CW_GCOUNT = 8192;

__device__ __forceinline__ float bf2f(bf16_t b) { return __uint_as_float(((unsigned)b) << 16); }
__device__ __forceinline__ bf16_t f2bf(float f) { return __builtin_bit_cast(unsigned short, (__bf16)f); }
__device__ __forceinline__ float sigmoidf_(float x) { return 1.0f / (1.0f + __expf(-x)); }
__device__ __forceinline__ float gelu_tanh(float x) { const float u = 0.7978845608028654f * (x + 0.044715f * x * x * x); return 0.5f * x * (1.0f + tanhf(u)); }

__host__ __device__ __forceinline__ int g1_orig(int g) {
    const int tile = g >> 8, w = g & 255, bj = w >> 7, wc = (w >> 5) & 3, j = w & 31;
    if (tile < 2) return tile * 256 + wc * 64 + bj * 32 + j;
    if (tile == 2) return wc < 2 ? 512 + wc * 64 + bj * 32 + j : 640 + (wc - 2) * 64 + bj * 32 + j;
    if (tile < 5) return 768 + (tile - 3) * 256 + w;
    if (tile < 7) return 1280 + (tile - 5) * 256 + w;
    const int t = tile - 7; return (bj ? 2816 : 1792) + 128 * t + (w & 127);
}
__host__ __device__ __forceinline__ int gu_orig(int g) { const int tile = g >> 8, w = g & 255, bj = w >> 7; return bj * 1024 + tile * 128 + (w & 127); }

__device__ __forceinline__ float dot_bf16(const bf16_t* a, const bf16_t* b, int K) {
    float s = 0.f;
    for (int k = 0; k < K; k += 8) {
        const u32x4 av = *(const u32x4*)(a + k), bv = *(const u32x4*)(b + k);
#pragma unroll
        for (int j = 0; j < 4; ++j) {
            s += __uint_as_float(av[j] << 16) * __uint_as_float(bv[j] << 16);
            s += __uint_as_float(av[j] & 0xffff0000u) * __uint_as_float(bv[j] & 0xffff0000u);
        }
    }
    return s;
}
__device__ __forceinline__ float wave_sum(float v) {
#pragma unroll
    for (int o = 1; o < 64; o <<= 1) v += __shfl_xor(v, o);
    return v;
}

#define GSTRIDE(i, n) for (size_t i = (size_t)blockIdx.x * blockDim.x + threadIdx.x; i < (size_t)(n); i += (size_t)gridDim.x * blockDim.x)

__global__ void __launch_bounds__(256) nv_transpose(const float* W, int K, int N, bf16_t* dst, int ldd, int koff, int Ng, int mode, int batch) {
    GSTRIDE(idx, (size_t)batch * Ng * K) {
        const int k = (int)(idx % K); const int g = (int)((idx / K) % Ng); const int b = (int)(idx / ((size_t)K * Ng));
        const int o = mode == 1 ? g1_orig(g) : mode == 2 ? gu_orig(g) : g;
        dst[(size_t)b * Ng * ldd + (size_t)g * ldd + koff + k] = f2bf(W[(size_t)b * K * N + (size_t)k * N + o]);
    }
}
__global__ void __launch_bounds__(256) nv_rmsnorm_bf16(const float* x, const float* g, bf16_t* out, float* rstd_out) {
    const int lane = threadIdx.x & 63; const int w = (blockIdx.x * blockDim.x + threadIdx.x) >> 6, nw = (gridDim.x * blockDim.x) >> 6;
    for (int m = w; m < NTOK; m += nw) {
        const float* xr = x + (size_t)m * DM; float v[16]; float s = 0.f;
#pragma unroll
        for (int j = 0; j < 16; ++j) { v[j] = xr[lane + 64 * j]; s += v[j] * v[j]; }
        const float r = rsqrtf(wave_sum(s) * (1.0f / DM) + 1e-6f);
#pragma unroll
        for (int j = 0; j < 16; ++j) out[(size_t)m * DM + lane + 64 * j] = f2bf(v[j] * r * g[lane + 64 * j]);
        if (rstd_out && lane == 0) rstd_out[m] = r;
    }
}
__device__ __forceinline__ void rope_cs(int pos, int j, float& c, float& s) {
    const float inv = exp2f(-(float)j * (13.287712379549449f / 32.0f));
    const double rev = (double)pos * (double)inv * 0.15915494309189535;
    const float fr = (float)(rev - floor(rev));
    s = __builtin_amdgcn_sinf(fr); c = __builtin_amdgcn_cosf(fr);
}
__global__ void __launch_bounds__(256) nv_gemm1(const bf16_t* h, const bf16_t* Wt, const int* positions, bf16_t* q, bf16_t* k, bf16_t* v, bf16_t* xr, bf16_t* yg, bf16_t* ratio, bf16_t* gls) {
    GSTRIDE(idx, (size_t)NTOK * 15 * 128) {
        const int r = (int)(idx % 128), tile = (int)((idx / 128) % 15), m = (int)(idx / (128 * 15));
        const int g0 = tile * 256 + r, g1 = g0 + 128;
        const float v0 = dot_bf16(h + (size_t)m * DM, Wt + (size_t)g0 * DM, DM), v1 = dot_bf16(h + (size_t)m * DM, Wt + (size_t)g1 * DM, DM);
        const int wc = r >> 5, j = r & 31;
        if (tile < 2 || (tile == 2 && wc < 2)) {
            float c, s; rope_cs(positions[m], j, c, s);
            const float o0 = v0 * c - v1 * s, o1 = v1 * c + v0 * s;
            if (tile < 2) { const int hq = tile * 4 + wc; q[(size_t)m * AW + hq * 64 + j] = f2bf(o0); q[(size_t)m * AW + hq * 64 + 32 + j] = f2bf(o1); }
            else { k[(size_t)m * KVW + wc * 64 + j] = f2bf(o0); k[(size_t)m * KVW + wc * 64 + 32 + j] = f2bf(o1); }
        } else if (tile == 2) { const int hv = wc - 2; v[(size_t)m * KVW + hv * 64 + j] = f2bf(v0); v[(size_t)m * KVW + hv * 64 + 32 + j] = f2bf(v1); }
        else if (tile < 5) { const int c0 = (tile - 3) * 256 + r; xr[(size_t)m * LW + c0] = f2bf(v0); xr[(size_t)m * LW + c0 + 128] = f2bf(v1); }
        else if (tile < 7) { const int c0 = (tile - 5) * 256 + r; yg[(size_t)m * LW + c0] = f2bf(gelu_tanh(v0)); yg[(size_t)m * LW + c0 + 128] = f2bf(gelu_tanh(v1)); }
        else { const int c0 = (tile - 7) * 128 + r; const float ea = __expf(-v0), eb = __expf(-v1);
            ratio[(size_t)m * DM + c0] = f2bf((1.0f + eb) / (1.0f + ea)); gls[(size_t)m * DM + c0] = f2bf(1.0f / (1.0f + eb)); }
    }
}
__global__ void __launch_bounds__(256) nv_attn(const bf16_t* q, const bf16_t* k, const bf16_t* v, const float* sinks, bf16_t* ao) {
    GSTRIDE(idx, (size_t)NTOK * NQH) {
        const int hq = (int)(idx % NQH), n = (int)(idx / NQH), s = n % SEQ, kvh = hq / 4;
        float qv[64], o[64];
#pragma unroll
        for (int d = 0; d < 64; ++d) { qv[d] = bf2f(q[(size_t)n * AW + hq * 64 + d]) * 0.125f; o[d] = 0.f; }
        const int lo = s - 127 > 0 ? s - 127 : 0; const float sink = sinks[hq];
        float mx = sink;
        for (int kp = lo; kp <= s; ++kp) { const bf16_t* kr = k + (size_t)(n - s + kp) * KVW + kvh * 64; float sc = 0.f;
#pragma unroll
            for (int d = 0; d < 64; ++d) sc += qv[d] * bf2f(kr[d]);
            mx = fmaxf(mx, sc); }
        float l = __expf(sink - mx);
        for (int kp = lo; kp <= s; ++kp) { const bf16_t* kr = k + (size_t)(n - s + kp) * KVW + kvh * 64; const bf16_t* vr = v + (size_t)(n - s + kp) * KVW + kvh * 64; float sc = 0.f;
#pragma unroll
            for (int d = 0; d < 64; ++d) sc += qv[d] * bf2f(kr[d]);
            const float p = __expf(sc - mx); l += p;
#pragma unroll
            for (int d = 0; d < 64; ++d) o[d] += p * bf2f(vr[d]); }
        const float il = 1.0f / l;
#pragma unroll
        for (int d = 0; d < 64; ++d) ao[(size_t)n * DM + hq * 64 + d] = f2bf(o[d] * il);
    }
}
__global__ void __launch_bounds__(256) nv_conv(const bf16_t* xr, const float* cw, const float* cb, float* xc) {
    GSTRIDE(idx, (size_t)NTOK * LW) {
        const int C = (int)(idx % LW), n = (int)(idx / LW), s = n % SEQ; float a = cb[C];
#pragma unroll
        for (int j = 0; j < 4; ++j) { const int ss = s - 3 + j; if (ss >= 0) a += bf2f(xr[(size_t)(n - 3 + j) * LW + C]) * cw[j * LW + C]; }
        xc[idx] = a;
    }
}
__global__ void __launch_bounds__(256) nv_scan(const float* xc, const float* w_rg, const float* b_rg, const float* w_ig, const float* b_ig, const float* lam, const bf16_t* yg, bf16_t* ao) {
    GSTRIDE(idx, (size_t)NB * LW) {
        const int C = (int)(idx % LW), b = (int)(idx / LW), hh = C / 64, cc = C % 64;
        const float sp = log1pf(__expf(-lam[C])); float hs = 0.f;
        for (int t = 0; t < SEQ; ++t) {
            const size_t n = (size_t)b * SEQ + t; const float* xrow = xc + n * LW + hh * 64; float rg = b_rg[C], ig = b_ig[C];
            for (int c = 0; c < 64; ++c) { const float x = xrow[c]; rg += x * w_rg[(hh * 64 + c) * 64 + cc]; ig += x * w_ig[(hh * 64 + c) * 64 + cc]; }
            const float r = sigmoidf_(rg), i = sigmoidf_(ig), la = -8.0f * r * sp, a = __expf(la), u = sqrtf(-expm1f(2.0f * la)) * (i * xrow[cc]);
            hs = a * hs + u;
            ao[n * DM + 512 + C] = f2bf(hs * bf2f(yg[n * LW + C]));
        }
    }
}
__global__ void __launch_bounds__(256) nv_merged(const bf16_t* ao, const bf16_t* Wcat, const bf16_t* ratio, const bf16_t* gls, bf16_t* merged) {
    GSTRIDE(idx, (size_t)NTOK * DM) {
        const int n = (int)(idx % DM), m = (int)(idx / DM);
        const float ya = dot_bf16(ao + (size_t)m * DM, Wcat + (size_t)n * DM, 512), yl = dot_bf16(ao + (size_t)m * DM + 512, Wcat + (size_t)n * DM + 512, 512);
        merged[idx] = f2bf((ya * bf2f(ratio[idx]) + yl) * bf2f(gls[idx]));
    }
}
__global__ void __launch_bounds__(256) nv_wout(const bf16_t* merged, const bf16_t* Wout, const float* x, float* x1) {
    GSTRIDE(idx, (size_t)NTOK * DM) {
        const int n = (int)(idx % DM), m = (int)(idx / DM);
        x1[idx] = x[idx] + dot_bf16(merged + (size_t)m * DM, Wout + (size_t)n * DM, DM);
    }
}
__global__ void __launch_bounds__(256) nv_logits(const float* x1, const float* rstd, const float* g, const float* Wr, const float* br, float* logits) {
    GSTRIDE(idx, (size_t)NTOK * NE) {
        const int e = (int)(idx % NE), m = (int)(idx / NE); const float r = rstd[m]; float s = 0.f;
        for (int k = 0; k < DM; ++k) s += (x1[(size_t)m * DM + k] * r * g[k]) * Wr[k * NE + e];
        logits[idx] = s + br[e];
    }
}
__global__ void __launch_bounds__(256) nv_topk(const float* logits, unsigned* ctl, int* tok_e, float* tok_w, int* tok_p, int* slot_tok) {
    GSTRIDE(idx, (size_t)NTOK) {
        const float* lg = logits + idx * NE; unsigned used = 0; float tv[4]; int te[4];
#pragma unroll
        for (int kk = 0; kk < 4; ++kk) { float best = -3.0e38f; int bi = 0;
            for (int e = 0; e < NE; ++e) { const float vv = lg[e]; if (!((used >> e) & 1u) && vv > best) { best = vv; bi = e; } }
            used |= 1u << bi; tv[kk] = best; te[kk] = bi; }
        float ex[4], sum = 0.f;
#pragma unroll
        for (int kk = 0; kk < 4; ++kk) { ex[kk] = __expf(tv[kk] - tv[0]); sum += ex[kk]; }
#pragma unroll
        for (int kk = 0; kk < 4; ++kk) { const int e = te[kk]; const unsigned p = atomicAdd(&ctl[CW_GCOUNT + 64 * e], 1u);
            tok_e[idx * 4 + kk] = e; tok_w[idx * 4 + kk] = ex[kk] / sum; tok_p[idx * 4 + kk] = (int)p; slot_tok[(size_t)e * CAP + p] = (int)idx; }
    }
}
__device__ __forceinline__ bool row_lookup(const unsigned* ctl, int row, int& e, int& pos, int& cnt) {
    int base = 0;
    for (int ee = 0; ee < NE; ++ee) { const int c = (int)ctl[CW_GCOUNT + 64 * ee]; const int pr = ((c + 255) >> 8) << 8; if (row < base + pr) { e = ee; pos = row - base; cnt = c; return true; } base += pr; }
    return false;
}
__global__ void __launch_bounds__(256) nv_moe1(const unsigned* ctl, const int* slot_tok, const bf16_t* h2, const bf16_t* Wgu, const float* bgu, bf16_t* act) {
    GSTRIDE(idx, (size_t)MAXROWS * DE) {
        const int j = (int)(idx % DE), row = (int)(idx / DE); int e, pos, cnt;
        if (!row_lookup(ctl, row, e, pos, cnt)) continue;
        const int tok = pos < cnt ? slot_tok[(size_t)e * CAP + pos] : 0;
        const int tile = j >> 7, r = j & 127, gg = tile * 256 + r, gu = gg + 128;
        float g = dot_bf16(h2 + (size_t)tok * DM, Wgu + ((size_t)e * 2048 + gg) * DM, DM) + bgu[e * 2048 + j];
        float u = dot_bf16(h2 + (size_t)tok * DM, Wgu + ((size_t)e * 2048 + gu) * DM, DM) + bgu[e * 2048 + 1024 + j];
        g = fminf(g, 7.0f); u = fminf(fmaxf(u, -7.0f), 7.0f);
        act[idx] = f2bf((u + 1.0f) * (g * sigmoidf_(1.702f * g)));
    }
}
__global__ void __launch_bounds__(256) nv_moe2(const unsigned* ctl, const bf16_t* act, const bf16_t* Wd, const float* bd, bf16_t* y) {
    GSTRIDE(idx, (size_t)MAXROWS * DM) {
        const int n = (int)(idx % DM), row = (int)(idx / DM); int e, pos, cnt;
        if (!row_lookup(ctl, row, e, pos, cnt)) continue;
        y[idx] = f2bf(dot_bf16(act + (size_t)row * DE, Wd + ((size_t)e * DM + n) * DE, DE) + bd[e * DM + n]);
    }
}
__global__ void __launch_bounds__(256) nv_final(const unsigned* ctl, const float* x1, const int* tok_e, const float* tok_w, const int* tok_p, const bf16_t* y, const float* g, float* out) {
    const int lane = threadIdx.x & 63; const int w = (blockIdx.x * blockDim.x + threadIdx.x) >> 6, nw = (gridDim.x * blockDim.x) >> 6;
    for (int m = w; m < NTOK; m += nw) {
        int yrow[4]; float ww[4];
#pragma unroll
        for (int kk = 0; kk < 4; ++kk) { const int e = tok_e[m * 4 + kk]; int base = 0; for (int ee = 0; ee < e; ++ee) base += (((int)ctl[CW_GCOUNT + 64 * ee] + 255) >> 8) << 8; yrow[kk] = base + tok_p[m * 4 + kk]; ww[kk] = tok_w[m * 4 + kk]; }
        float v[16]; float s = 0.f;
#pragma unroll
        for (int j = 0; j < 16; ++j) { const int c = lane + 64 * j; float a = x1[(size_t)m * DM + c];
#pragma unroll
            for (int kk = 0; kk < 4; ++kk) a += ww[kk] * bf2f(y[(size_t)yrow[kk] * DM + c]);
            v[j] = a; s += a * a; }
        const float r = rsqrtf(wave_sum(s) * (1.0f / DM) + 1e-6f);
#pragma unroll
        for (int j = 0; j < 16; ++j) out[(size_t)m * DM + lane + 64 * j] = v[j] * r * g[lane + 64 * j];
    }
}

#define LAS __attribute__((address_space(3)))
typedef short bf16x8 __attribute__((ext_vector_type(8)));
typedef short s16x4 __attribute__((ext_vector_type(4)));
typedef float f32x4 __attribute__((ext_vector_type(4)));
typedef float f32x16 __attribute__((ext_vector_type(16)));
typedef int i32x4 __attribute__((ext_vector_type(4)));
constexpr int NWAVES = 8;
constexpr int RING_BYTES = 131072, MISC_OFF = 147456, LDS_BYTES = 163840;
constexpr int MW_Q = 16, MW_TS = 32, MW_CNT = 72, MW_P5 = 128, MW_TE = 3072;
constexpr int CW_BAR = 4096, CW_QUEUE = 12288;

__device__ __forceinline__ unsigned cvt_pk_bf16(float lo, float hi) { unsigned r; asm volatile("v_cvt_pk_bf16_f32 %0, %1, %2" : "=v"(r) : "v"(lo), "v"(hi)); return r; }
__device__ __forceinline__ unsigned pk4_fp8(float a, float b, float c, float d) { int p = __builtin_amdgcn_cvt_pk_fp8_f32(a, b, 0, false); p = __builtin_amdgcn_cvt_pk_fp8_f32(c, d, p, true); return (unsigned)p; }
__device__ __forceinline__ float clamp448(float x) { return fminf(fmaxf(x, -448.0f), 448.0f); }
__device__ __forceinline__ float fsig(float x) { return __builtin_amdgcn_rcpf(1.0f + __builtin_amdgcn_exp2f(-1.4426950408889634f * x)); }
__device__ __forceinline__ int crow(int r, int hi) { return (r & 3) + 8 * (r >> 2) + 4 * hi; }
__device__ __forceinline__ void unpack8(const u32x4 w, float (&f)[8]) {
#pragma unroll
    for (int j = 0; j < 4; ++j) { f[2 * j] = __uint_as_float(w[j] << 16); f[2 * j + 1] = __uint_as_float(w[j] & 0xffff0000u); }
}
__host__ __device__ __forceinline__ int g1_inv(int o) {
    if (o < 512) { const int head = o >> 6, d = o & 63; return (head >> 2) * 256 + (d >> 5) * 128 + (head & 3) * 32 + (d & 31); }
    if (o < 640) { const int hk = (o - 512) >> 6, d = o & 63; return 512 + (d >> 5) * 128 + hk * 32 + (d & 31); }
    if (o < 768) { const int hv = (o - 640) >> 6, d = o & 63; return 512 + (d >> 5) * 128 + (2 + hv) * 32 + (d & 31); }
    if (o < 1792) return o;
    if (o < 2816) { const int c = o - 1792; return (7 + (c >> 7)) * 256 + (c & 127); }
    const int c = o - 2816; return (7 + (c >> 7)) * 256 + 128 + (c & 127);
}
__host__ __device__ __forceinline__ int gu_inv(int o) { const int bj = o >> 10, c = o & 1023; return (c >> 7) * 256 + bj * 128 + (c & 127); }

#define XB_TMO      128
#define XB_XCNT(j)  (256  + 64 * (j))
#define XB_XSUB(j)  (1280 + 64 * (j))
#define XB_XGEN(j)  (2304 + 64 * (j))
#define XB_TOP      3328
#define XB_TOPGEN   3392
#define XCD_BAR_WORDS 3456
#define XB_SPIN_CAP (1u << 18)
__device__ __forceinline__ unsigned xb_ld(unsigned* p)              { return __hip_atomic_load(p, __ATOMIC_RELAXED, __HIP_MEMORY_SCOPE_AGENT); }
__device__ __forceinline__ unsigned xb_add(unsigned* p, unsigned v) { return __hip_atomic_fetch_add(p, v, __ATOMIC_RELAXED, __HIP_MEMORY_SCOPE_AGENT); }
__device__ __forceinline__ unsigned xb_xcc_id() { return (unsigned)__builtin_amdgcn_s_getreg((3 << 11) | 20) & 0xFu; }
#define XB_SPIN(cond, bar) do { unsigned _sp = 0; while (cond) { __builtin_amdgcn_s_sleep(1); \
    if ((++_sp & 255u) == 0u) { if (xb_ld(&(bar)[XB_TMO])) break; if (_sp > XB_SPIN_CAP) { atomicAdd(&(bar)[XB_TMO], 1u); break; } } } } while (0)
struct XcdBarrier { unsigned* bar; unsigned x; volatile LAS unsigned* st; };
__device__ __forceinline__ XcdBarrier xcd_barrier_post(unsigned* bar, volatile LAS unsigned* st) {
    XcdBarrier b; b.bar = bar; b.x = xb_xcc_id(); b.st = st;
    if (threadIdx.x == 0) (void)xb_add(&bar[XB_XCNT(b.x)], 1u);
    return b;
}
__device__ __forceinline__ void xcd_barrier_complete(unsigned* bar, unsigned x, unsigned& nloc, unsigned& nx) {
    const unsigned G = gridDim.x * gridDim.y * gridDim.z;
    unsigned sum, cnt, mine, sp = 0u;
    for (;;) {
        sum = 0u; cnt = 0u; mine = 0u;
#pragma unroll
        for (unsigned j = 0; j < 16; ++j) { const unsigned c = xb_ld(&bar[XB_XCNT(j)]); sum += c; cnt += (c > 0u) ? 1u : 0u; mine = (j == x) ? c : mine; }
        if (sum == G) break;
        __builtin_amdgcn_s_sleep(1);
        if ((++sp & 255u) == 0u) { if (xb_ld(&bar[XB_TMO])) break; if (sp > XB_SPIN_CAP) { atomicAdd(&bar[XB_TMO], 1u); break; } }
    }
    nloc = mine > 0u ? mine : 1u; nx = cnt > 0u ? cnt : 1u;
}
__device__ __forceinline__ void xcd_barrier(const XcdBarrier& b) {
    asm volatile("s_waitcnt vmcnt(0)" ::: "memory");
    __syncthreads();
    if (threadIdx.x == 0) {
        unsigned* bar = b.bar;
        __builtin_amdgcn_s_waitcnt(0);
        unsigned nloc = b.st[0], nx = b.st[1];
        if (nloc == 0u) { xcd_barrier_complete(bar, b.x, nloc, nx); b.st[0] = nloc; b.st[1] = nx; }
        const unsigned old = xb_add(&bar[XB_XSUB(b.x)], 1u);
        const unsigned gen = old / nloc;
        if (old + 1u == (gen + 1u) * nloc) {
            __builtin_amdgcn_fence(__ATOMIC_RELEASE, "agent");
            asm volatile("s_waitcnt vmcnt(0)" ::: "memory");
            const unsigned og = xb_add(&bar[XB_TOP], 1u);
            const unsigned tg = og / nx;
            if (og + 1u == (tg + 1u) * nx) xb_add(&bar[XB_TOPGEN], 1u);
            else XB_SPIN(xb_ld(&bar[XB_TOPGEN]) == tg, bar);
            __builtin_amdgcn_fence(__ATOMIC_ACQUIRE, "agent");
            xb_add(&bar[XB_XGEN(b.x)], 1u);
            asm volatile("s_waitcnt vmcnt(0)" ::: "memory");
        } else {
            XB_SPIN(xb_ld(&bar[XB_XGEN(b.x)]) == gen, bar);
            __builtin_amdgcn_fence(__ATOMIC_ACQUIRE, "agent");
            asm volatile("s_waitcnt vmcnt(0)" ::: "memory");
        }
    }
    __syncthreads();
}

namespace pg8 {
constexpr int BM = 256, BK = 64, HALF = 128, HTB = HALF * BK * 2, STAGE_BYTES = 8 * HTB, NXCD = 8, WGM = 8, KK = 1024, NT = KK / BK;
__host__ __device__ __forceinline__ int lds_byte(int r, int c) { const int st = (r >> 4) * 2 + (c >> 5), rr = r & 15, cc = c & 31, ob = rr * 64 + cc * 2; return st * 1024 + (ob ^ (((ob >> 9) & 1) << 5)); }
__host__ __device__ __forceinline__ void stage_rc(int b, int& R, int& C) { const int st = b / 1024, sb = b % 1024, swz = sb ^ (((sb >> 9) & 1) << 5); R = (st >> 1) * 16 + swz / 64; C = (st & 1) * 32 + (swz % 64) / 2; }
__host__ __device__ __forceinline__ int perm32(int rho) { const int n = rho >> 4, i = rho & 15; return 8 * (i >> 2) + 4 * n + (i & 3); }
struct Unit { int pm, pn, e, nvalid; };
constexpr unsigned KSTEP = BK * 2;

struct DenseSched {
    const bf16_t* A; const bf16_t* Bt; int nM, nN, nwg, G, c, it;
    __device__ void init(const bf16_t* A_, const bf16_t* Bt_, int M, int N, int G_, int c_) { A = A_; Bt = Bt_; nM = M / BM; nN = N / BM; nwg = nM * nN; G = G_; c = c_; it = 0; }
    __device__ __forceinline__ bool next(Unit& u) {
        const long L = (long)it * G + c; ++it; if (L >= nwg) return false;
        int wgid = (int)L; { const int q = nwg / NXCD, r = nwg % NXCD, xcd = wgid % NXCD, off = wgid / NXCD; wgid = (xcd < r ? xcd * (q + 1) : r * (q + 1) + (xcd - r) * q) + off; }
        const int nig = WGM * nN, gid = wgid / nig, fm = gid * WGM, gsz = (nM - fm) < WGM ? (nM - fm) : WGM;
        u.pm = fm + ((wgid % nig) % gsz); u.pn = (wgid % nig) / gsz; u.e = 0; u.nvalid = 256; return true;
    }
    __device__ __forceinline__ unsigned a_base(const Unit& u) const { return (unsigned)u.pm * (unsigned)(BM * KK * 2); }
    __device__ __forceinline__ unsigned b_base(const Unit& u) const { return (unsigned)u.pn * (unsigned)(BM * KK * 2); }
    __device__ __forceinline__ void a_rows(const Unit&, const int (&R)[2], int (&rows)[2][2]) const {
#pragma unroll
        for (int h = 0; h < 2; ++h)
#pragma unroll
            for (int i = 0; i < 2; ++i) rows[h][i] = R[i] + HALF * h;
    }
};
template <bool GATHER, int EB> struct MoeSched {
    const void* A; const void* Bt; const int* slot_tok; const volatile LAS int* ts; const volatile LAS int* cnt; int NPN, ntiles, Lmax, G, c, it;
    __device__ void init(const void* A_, const void* Bt_, const int* slot_tok_, const volatile LAS int* ts_, const volatile LAS int* cnt_, int NPN_, int G_, int c_) {
        A = A_; Bt = Bt_; slot_tok = slot_tok_; ts = ts_; cnt = cnt_; NPN = NPN_; G = G_; c = c_; it = 0; ntiles = __builtin_amdgcn_readfirstlane(ts[NE]); Lmax = ((ntiles + 7) / 8) * 8 * NPN; }
    __device__ __forceinline__ bool next(Unit& u) {
        for (;;) {
#if MOE_ORDER == 1
            const int U = ntiles * NPN, per = (U + G - 1) / G, uu = c * per + it; ++it; if (it > per || uu >= U) return false;
            const int m = uu / NPN, j = uu;
#elif MOE_ORDER == 2
            const int x = c & 7, nper = G >> 3; int lin = it * nper + (c >> 3); ++it;
            int m = -1, j = 0;
            for (int k = 0; k < NE / 8; ++k) { const int e2 = x + 8 * k, t0 = __builtin_amdgcn_readfirstlane(ts[e2]), nt2 = __builtin_amdgcn_readfirstlane(ts[e2 + 1]) - t0, nu = nt2 * NPN;
                if (m < 0) { if (lin < nu) { m = t0 + lin / NPN; j = lin % NPN; } else lin -= nu; } }
            if (m < 0) return false;
#else
            const int L = it * G + c; ++it; if (L >= Lmax) return false;
            const int xcd = L & 7, j = L >> 3, m = (j / NPN) * 8 + xcd; if (m >= ntiles) continue;
#endif
            const int e = __builtin_amdgcn_readfirstlane(ts[MW_TE - MW_TS + m]);
            u.pm = m; u.pn = j % NPN; u.e = e; u.nvalid = __builtin_amdgcn_readfirstlane(cnt[e]) - 256 * (m - __builtin_amdgcn_readfirstlane(ts[e])); return true;
        }
    }
    __device__ __forceinline__ unsigned a_base(const Unit& u) const { return GATHER ? 0u : (unsigned)u.pm * (unsigned)(BM * KK * EB); }
    __device__ __forceinline__ unsigned b_base(const Unit& u) const { return (unsigned)(u.e * NPN + u.pn) * (unsigned)(BM * KK * EB); }
    __device__ __forceinline__ void a_rows(const Unit& u, const int (&R)[2], int (&rows)[2][2]) const {
#pragma unroll
        for (int h = 0; h < 2; ++h)
#pragma unroll
            for (int i = 0; i < 2; ++i) {
                const int r = R[i] + HALF * h;
                if (GATHER) { const int last = u.nvalid - 1; rows[h][i] = slot_tok[(size_t)u.e * CAP + 256 * (u.pm - __builtin_amdgcn_readfirstlane(ts[u.e])) + (r < last ? r : last)]; }
                else rows[h][i] = r;
            }
    }
};

template <class Epi, class Sched, bool ALIGN_EPI, int EB, int KREP = 1>
__device__ __forceinline__ void gemm_phase(LAS unsigned char* lds, Sched& S, const Epi& E) {
    constexpr int PITCH = KK * EB, NTL = PITCH / 128; constexpr unsigned HSTEP = (unsigned)HALF * PITCH;
    const __amdgpu_buffer_rsrc_t rsrcA = __builtin_amdgcn_make_buffer_rsrc((void*)S.A, 0, 0xFFFFFFFF, 0x00020000), rsrcB = __builtin_amdgcn_make_buffer_rsrc((void*)S.Bt, 0, 0xFFFFFFFF, 0x00020000);
    typedef int v8i_t __attribute__((ext_vector_type(8)));
    const int tid = threadIdx.x, wid = __builtin_amdgcn_readfirstlane(tid >> 6), lane = tid & 63, wr = wid >> 2, wc = wid & 3, fr = lane & 15, fq = lane >> 4;
    unsigned voffB[2];
#pragma unroll
    for (int i = 0; i < 2; ++i) { int R, C; stage_rc(tid * 16 + i * 8192, R, C); const int Rb = Epi::PERM ? ((R & ~31) + perm32(R & 31)) : R; voffB[i] = (unsigned)(Rb * PITCH + C * 2); }
    const unsigned ldsw = (unsigned)wid * 1024u;
    const int aoff = lds_byte(wr * 64 + fr, fq * 8), boff = lds_byte(wc * 32 + fr, fq * 8);
#define PG8_SA(b, h) (((b) * 2 + (h)) * HTB)
#define PG8_SB(b, h) ((4 + (b) * 2 + (h)) * HTB)
#define PG8_STAGEA(bufoff, soff, voff) do { _Pragma("unroll") for (int _i = 0; _i < 2; ++_i) \
        __builtin_amdgcn_raw_ptr_buffer_load_lds(rsrcA, (LAS void*)(lds + (bufoff) + ldsw + _i * 8192), 16, (voff)[_i], (soff), 0, 0); } while (0)
#define PG8_STAGEB(bufoff, soff, voff) do { _Pragma("unroll") for (int _i = 0; _i < 2; ++_i) \
        __builtin_amdgcn_raw_ptr_buffer_load_lds(rsrcB, (LAS void*)(lds + (bufoff) + ldsw + _i * 8192), 16, (voff)[_i], (soff), 0, 0); } while (0)
#define PG8_LDA(dst, b, h) do { _Pragma("unroll") for (int m = 0; m < 4; ++m) _Pragma("unroll") for (int k = 0; k < 2; ++k) dst[m][k] = *(const LAS bf16x8*)(lds + PG8_SA(b, h) + aoff + m * 2048 + k * 1024); } while (0)
#define PG8_LDB(dst, b, h) do { _Pragma("unroll") for (int n = 0; n < 2; ++n) _Pragma("unroll") for (int k = 0; k < 2; ++k) dst[n][k] = *(const LAS bf16x8*)(lds + PG8_SB(b, h) + boff + n * 2048 + k * 1024); } while (0)
#define PG8_MMA(ai, bj, At, Bt) do { __builtin_amdgcn_s_setprio(1); _Pragma("unroll") for (int m = 0; m < 4; ++m) _Pragma("unroll") for (int n = 0; n < 2; ++n) { \
        if constexpr (EB == 2) { _Pragma("unroll") for (int k = 0; k < 2; ++k) acc[ai][bj][m][n] = __builtin_amdgcn_mfma_f32_16x16x32_bf16(Bt[n][k], At[m][k], acc[ai][bj][m][n], 0, 0, 0); } \
        else { const v8i_t b8 = __builtin_shufflevector(__builtin_bit_cast(i32x4, Bt[n][0]), __builtin_bit_cast(i32x4, Bt[n][1]), 0, 1, 2, 3, 4, 5, 6, 7); \
               const v8i_t a8 = __builtin_shufflevector(__builtin_bit_cast(i32x4, At[m][0]), __builtin_bit_cast(i32x4, At[m][1]), 0, 1, 2, 3, 4, 5, 6, 7); \
               asm volatile("v_mfma_f32_16x16x128_f8f6f4 %0, %1, %2, %0" : "+v"(acc[ai][bj][m][n]) : "v"(b8), "v"(a8)); } } \
        __builtin_amdgcn_s_setprio(0); } while (0)
#define PG8_WAIT_V(n) asm volatile("s_waitcnt vmcnt(" #n ")" ::: "memory")
#define PG8_WAIT_L(n) asm volatile("s_waitcnt lgkmcnt(" #n ")" ::: "memory")
#define PG8_BAR __builtin_amdgcn_s_barrier()
#define PG8_SCHED __builtin_amdgcn_sched_barrier(0)
    Unit cur, nxt;
    if (!S.next(cur)) return;
    f32x4 acc[2][2][4][2];
#pragma unroll
    for (int a = 0; a < 2; ++a)
#pragma unroll
        for (int b = 0; b < 2; ++b)
#pragma unroll
            for (int m = 0; m < 4; ++m)
#pragma unroll
                for (int n = 0; n < 2; ++n) acc[a][b][m][n] = (f32x4){0.f, 0.f, 0.f, 0.f};
    bf16x8 At[4][2], B0[2][2], B1[2][2];
    unsigned vA[2][2], vN[2][2]; typename Epi::Pre pre;
#define PG8_AOFF(u, v) do { int _R[2], _C[2]; _Pragma("unroll") for (int _i = 0; _i < 2; ++_i) stage_rc(tid * 16 + _i * 8192, _R[_i], _C[_i]); int _rows[2][2]; S.a_rows(u, _R, _rows); \
        _Pragma("unroll") for (int _h = 0; _h < 2; ++_h) _Pragma("unroll") for (int _i = 0; _i < 2; ++_i) v[_h][_i] = (unsigned)(_rows[_h][_i] * PITCH + _C[_i] * 2); } while (0)
    PG8_AOFF(cur, vA);
    unsigned cA = S.a_base(cur), cB = S.b_base(cur);
#define PG8_ROT(u) ((KROT && !Epi::HAS_MID) ? (((u).pm + (u).pn) & (NTL - 1)) : 0)
#define PG8_KO(i, rot) ((unsigned)(((i) + (rot)) & (NTL - 1)) * KSTEP)
    int rotc = PG8_ROT(cur), rotn = 0;
    PG8_STAGEB(PG8_SB(0, 0), cB + PG8_KO(0, rotc), voffB); PG8_STAGEB(PG8_SB(0, 1), cB + HSTEP + PG8_KO(0, rotc), voffB); PG8_STAGEA(PG8_SA(0, 0), cA + PG8_KO(0, rotc), vA[0]); PG8_STAGEA(PG8_SA(0, 1), cA + PG8_KO(0, rotc), vA[1]);
    if (wr == 1) PG8_BAR;
    PG8_WAIT_V(2); PG8_BAR;
    PG8_STAGEB(PG8_SB(1, 0), cB + PG8_KO(1, rotc), voffB); PG8_STAGEA(PG8_SA(1, 0), cA + PG8_KO(1, rotc), vA[0]); PG8_STAGEB(PG8_SB(1, 1), cB + HSTEP + PG8_KO(1, rotc), voffB);
    PG8_WAIT_V(6); PG8_BAR;
    int krep = 0;
    for (;;) {
        bool has_next;
        if (KREP > 1 && krep + 1 < KREP) { has_next = true; nxt = cur; } else has_next = S.next(nxt);
        const unsigned nA = has_next ? S.a_base(nxt) : cA, nB = has_next ? S.b_base(nxt) : cB;
        rotn = has_next ? PG8_ROT(nxt) : rotc;
        if (has_next) PG8_AOFF(nxt, vN);
        else {
#pragma unroll
            for (int h = 0; h < 2; ++h)
#pragma unroll
                for (int i = 0; i < 2; ++i) vN[h][i] = vA[h][i];
        }
#pragma unroll 1
        for (int t = 0; t < NTL; t += 2) {
            const bool last = (t == NTL - 2);
            const unsigned a1 = cA + PG8_KO(t + 1, rotc);
            const unsigned a2 = last ? nA + PG8_KO(0, rotn) : cA + PG8_KO(t + 2, rotc), b2 = last ? nB + PG8_KO(0, rotn) : cB + PG8_KO(t + 2, rotc);
            const unsigned a3 = last ? nA + PG8_KO(1, rotn) : cA + PG8_KO(t + 3, rotc), b3 = last ? nB + PG8_KO(1, rotn) : cB + PG8_KO(t + 3, rotc);
            unsigned v2[2][2];
#pragma unroll
            for (int h = 0; h < 2; ++h)
#pragma unroll
                for (int i = 0; i < 2; ++i) v2[h][i] = last ? vN[h][i] : vA[h][i];
            if constexpr (Epi::HAS_MID) { if (t == NTL / 2) E.mid(acc, cur, wr, wc, fr, fq); }
            if (last) pre = E.load_pre(cur, wr, wc, fr, fq);
            PG8_LDB(B0, 0, 0); PG8_LDB(B1, 0, 1); PG8_SCHED; PG8_LDA(At, 0, 0); PG8_STAGEA(PG8_SA(1, 1), a1, vA[1]);
            PG8_WAIT_V(8); PG8_WAIT_L(0); PG8_BAR; PG8_MMA(0, 0, At, B0); PG8_MMA(0, 1, At, B1); PG8_BAR; PG8_SCHED;
            PG8_LDA(At, 0, 1); PG8_STAGEB(PG8_SB(0, 0), b2, voffB); PG8_STAGEB(PG8_SB(0, 1), b2 + HSTEP, voffB); PG8_STAGEA(PG8_SA(0, 0), a2, v2[0]);
            PG8_WAIT_V(8); PG8_WAIT_L(0); PG8_BAR; PG8_MMA(1, 0, At, B0); PG8_MMA(1, 1, At, B1); PG8_BAR; PG8_SCHED;
            PG8_LDB(B0, 1, 0); PG8_LDB(B1, 1, 1); PG8_SCHED; PG8_LDA(At, 1, 0); PG8_STAGEA(PG8_SA(0, 1), a2, v2[1]);
            PG8_WAIT_V(8); PG8_WAIT_L(0); PG8_BAR; PG8_MMA(0, 0, At, B0); PG8_MMA(0, 1, At, B1); PG8_BAR; PG8_SCHED;
            PG8_LDA(At, 1, 1); PG8_STAGEB(PG8_SB(1, 0), b3, voffB); PG8_STAGEB(PG8_SB(1, 1), b3 + HSTEP, voffB); PG8_STAGEA(PG8_SA(1, 0), a3, v2[0]);
            PG8_WAIT_V(8); PG8_WAIT_L(0); PG8_BAR; PG8_MMA(1, 0, At, B0); PG8_MMA(1, 1, At, B1); PG8_BAR; PG8_SCHED;
        }
        if (KREP > 1 && ++krep < KREP) { cur = nxt; cA = nA; cB = nB; continue; }
        krep = 0;
        if constexpr (ALIGN_EPI) { if (wr == 0) PG8_BAR; }
        if constexpr (EB == 1) asm volatile("s_nop 15\n\ts_nop 15" ::: "memory");
        E(acc, cur, wr, wc, fr, fq, pre);
        if (!has_next) break;
#pragma unroll
        for (int a = 0; a < 2; ++a)
#pragma unroll
            for (int b = 0; b < 2; ++b)
#pragma unroll
                for (int m = 0; m < 4; ++m)
#pragma unroll
                    for (int n = 0; n < 2; ++n) acc[a][b][m][n] = (f32x4){0.f, 0.f, 0.f, 0.f};
        cur = nxt; cA = nA; cB = nB; rotc = rotn;
#pragma unroll
        for (int h = 0; h < 2; ++h)
#pragma unroll
            for (int i = 0; i < 2; ++i) vA[h][i] = vN[h][i];
        if constexpr (ALIGN_EPI) { if (wr == 1) PG8_BAR; }
    }
    PG8_WAIT_V(0);
    if constexpr (!ALIGN_EPI) { if (wr == 0) PG8_BAR; }
    PG8_BAR;
#undef PG8_AOFF
#undef PG8_ROT
#undef PG8_KO
#undef PG8_SA
#undef PG8_SB
#undef PG8_STAGEA
#undef PG8_STAGEB
#undef PG8_LDA
#undef PG8_LDB
#undef PG8_MMA
#undef PG8_WAIT_V
#undef PG8_WAIT_L
#undef PG8_BAR
#undef PG8_SCHED
}

struct EpiG1 {
    static constexpr bool PERM = true, HAS_MID = false;
    struct Pre {}; __device__ __forceinline__ Pre load_pre(const Unit&, int, int, int, int) const { return Pre{}; }
    const int* pos; bf16_t *q, *k, *v, *xr, *yg, *ratio, *gls;
    __device__ __forceinline__ void mid(f32x4 (&)[2][2][4][2], const Unit&, int, int, int, int) const {}
    __device__ __forceinline__ void operator()(const f32x4 (&acc)[2][2][4][2], const Unit& u, int wr, int wc, int fr, int fq, const Pre& pre) const {
        const int row0 = u.pm * BM + wr * 64 + fr, j0 = 8 * fq, pn = u.pn;
        const bool rope = (pn < 2) || (pn == 2 && wc < 2);
        typedef float f2 __attribute__((ext_vector_type(2)));
        f2 invf[4];
#pragma unroll
        for (int e = 0; e < 4; ++e) { invf[e].x = exp2f(-(float)(j0 + 2 * e) * (13.287712379549449f / 32.0f)) * 0.15915494309189535f; invf[e].y = exp2f(-(float)(j0 + 2 * e + 1) * (13.287712379549449f / 32.0f)) * 0.15915494309189535f; }
#pragma unroll
        for (int ai = 0; ai < 2; ++ai)
#pragma unroll
            for (int m = 0; m < 4; ++m) {
                const int row = row0 + ai * HALF + m * 16;
                f2 lo[4], hi[4];
#pragma unroll
                for (int e = 0; e < 2; ++e) { lo[e] = (f2){acc[ai][0][m][0][2 * e], acc[ai][0][m][0][2 * e + 1]}; lo[2 + e] = (f2){acc[ai][0][m][1][2 * e], acc[ai][0][m][1][2 * e + 1]};
                    hi[e] = (f2){acc[ai][1][m][0][2 * e], acc[ai][1][m][0][2 * e + 1]}; hi[2 + e] = (f2){acc[ai][1][m][1][2 * e], acc[ai][1][m][1][2 * e + 1]}; }
                bf16_t* d0; bf16_t* d1;
                if (rope) {
                    const float p = (float)pos[row];
#pragma unroll
                    for (int e = 0; e < 4; ++e) { const f2 rev = invf[e] * p; f2 sn, cs;
                        const float r0 = __builtin_amdgcn_fractf(rev.x), r1 = __builtin_amdgcn_fractf(rev.y);
                        sn.x = __builtin_amdgcn_sinf(r0); sn.y = __builtin_amdgcn_sinf(r1); cs.x = __builtin_amdgcn_cosf(r0); cs.y = __builtin_amdgcn_cosf(r1);
                        const f2 a = lo[e], bb = hi[e]; lo[e] = a * cs - bb * sn; hi[e] = bb * cs + a * sn; }
                    if (pn < 2) { d0 = q + (size_t)row * AW + (pn * 4 + wc) * 64 + j0; } else { d0 = k + (size_t)row * KVW + wc * 64 + j0; }
                    d1 = d0 + 32;
                } else if (pn == 2) { d0 = v + (size_t)row * KVW + (wc - 2) * 64 + j0; d1 = d0 + 32; }
                else if (pn < 5) { d0 = xr + (size_t)row * LW + (pn - 3) * 256 + wc * 32 + j0; d1 = d0 + 128; }
                else if (pn < 7) {
#pragma unroll
                    for (int e = 0; e < 4; ++e) {
#pragma unroll
                        for (int hf = 0; hf < 2; ++hf) { const f2 a = hf ? hi[e] : lo[e]; const f2 z = (a * ((a * a) * 0.044715f + 1.0f)) * (-1.5957691216057308f * 1.4426950408889634f);
                            f2 d; d.x = __builtin_amdgcn_exp2f(z.x); d.y = __builtin_amdgcn_exp2f(z.y); d = d + 1.0f; f2 r; r.x = __builtin_amdgcn_rcpf(d.x); r.y = __builtin_amdgcn_rcpf(d.y);
                            if (hf) hi[e] = a * r; else lo[e] = a * r; } }
                    d0 = yg + (size_t)row * LW + (pn - 5) * 256 + wc * 32 + j0; d1 = d0 + 128;
                } else {
#pragma unroll
                    for (int e = 0; e < 4; ++e) { f2 a = lo[e], bb = hi[e];
                        a.x = __builtin_amdgcn_fmed3f(a.x, -30.f, 30.f); a.y = __builtin_amdgcn_fmed3f(a.y, -30.f, 30.f); bb.x = __builtin_amdgcn_fmed3f(bb.x, -30.f, 30.f); bb.y = __builtin_amdgcn_fmed3f(bb.y, -30.f, 30.f);
                        const f2 za = a * (-1.4426950408889634f), zb = bb * (-1.4426950408889634f); f2 da, db;
                        da.x = __builtin_amdgcn_exp2f(za.x); da.y = __builtin_amdgcn_exp2f(za.y); db.x = __builtin_amdgcn_exp2f(zb.x); db.y = __builtin_amdgcn_exp2f(zb.y); da = da + 1.0f; db = db + 1.0f;
                        f2 ia, ib; ia.x = __builtin_amdgcn_rcpf(da.x); ia.y = __builtin_amdgcn_rcpf(da.y); ib.x = __builtin_amdgcn_rcpf(db.x); ib.y = __builtin_amdgcn_rcpf(db.y);
                        lo[e] = db * ia; hi[e] = ib; }
                    d0 = ratio + (size_t)row * DM + (pn - 7) * 128 + wc * 32 + j0; d1 = gls + (size_t)row * DM + (pn - 7) * 128 + wc * 32 + j0;
                }
                u32x4 w0, w1;
#pragma unroll
                for (int e = 0; e < 4; ++e) { w0[e] = cvt_pk_bf16(lo[e].x, lo[e].y); w1[e] = cvt_pk_bf16(hi[e].x, hi[e].y); }
                *(u32x4*)d0 = w0; *(u32x4*)d1 = w1;
            }
    }
};
struct EpiMerged {
    static constexpr bool PERM = true, HAS_MID = true;
    struct Pre {}; __device__ __forceinline__ Pre load_pre(const Unit&, int, int, int, int) const { return Pre{}; }
    const bf16_t* ratio; const bf16_t* gls; bf16_t* merged;
    __device__ __forceinline__ void mid(f32x4 (&acc)[2][2][4][2], const Unit& u, int wr, int wc, int fr, int fq) const {
        int off0 = (u.pm * BM + wr * 64 + fr) * DM + u.pn * BM + wc * 32 + 8 * fq;
        asm volatile("" : "+v"(off0));
#pragma unroll
        for (int ai = 0; ai < 2; ++ai)
#pragma unroll
            for (int m = 0; m < 4; ++m)
            {
#pragma unroll
                for (int bj = 0; bj < 2; ++bj) { const u32x4 w = *(const u32x4*)(ratio + (size_t)(unsigned)(off0 + (ai * HALF + m * 16) * DM + bj * HALF)); float f[8]; unpack8(w, f);
#pragma unroll
                    for (int e = 0; e < 4; ++e) { acc[ai][bj][m][0][e] *= f[e]; acc[ai][bj][m][1][e] *= f[4 + e]; } }
                if (m & 1) asm volatile("" ::: "memory"); }
    }
    __device__ __forceinline__ void operator()(const f32x4 (&acc)[2][2][4][2], const Unit& u, int wr, int wc, int fr, int fq, const Pre& pre) const {
        const int row0 = u.pm * BM + wr * 64 + fr, col0 = u.pn * BM + wc * 32 + 8 * fq;
#pragma unroll
        for (int ai = 0; ai < 2; ++ai)
#pragma unroll
            for (int m = 0; m < 4; ++m)
#pragma unroll
                for (int bj = 0; bj < 2; ++bj) { const size_t off = (size_t)(row0 + ai * HALF + m * 16) * DM + col0 + bj * HALF; const u32x4 w = *(const u32x4*)(gls + off); float f[8]; unpack8(w, f);
                    u32x4 o;
#pragma unroll
                    for (int e = 0; e < 2; ++e) { o[e] = cvt_pk_bf16(acc[ai][bj][m][0][2 * e] * f[2 * e], acc[ai][bj][m][0][2 * e + 1] * f[2 * e + 1]);
                        o[2 + e] = cvt_pk_bf16(acc[ai][bj][m][1][2 * e] * f[4 + 2 * e], acc[ai][bj][m][1][2 * e + 1] * f[4 + 2 * e + 1]); }
                    *(u32x4*)(merged + off) = o; }
    }
};
struct EpiX1 {
    static constexpr bool PERM = false, HAS_MID = false;
    struct Pre {}; __device__ __forceinline__ Pre load_pre(const Unit&, int, int, int, int) const { return Pre{}; }
    const float* x; float* x1;
    __device__ __forceinline__ void mid(f32x4 (&)[2][2][4][2], const Unit&, int, int, int, int) const {}
    __device__ __forceinline__ void operator()(const f32x4 (&acc)[2][2][4][2], const Unit& u, int wr, int wc, int fr, int fq, const Pre& pre) const {
        const int row0 = u.pm * BM + wr * 64 + fr, col0 = u.pn * BM + wc * 32 + 4 * fq;
#pragma unroll
        for (int ai = 0; ai < 2; ++ai)
#pragma unroll
            for (int m = 0; m < 4; ++m)
#pragma unroll
                for (int bj = 0; bj < 2; ++bj)
#pragma unroll
                    for (int n = 0; n < 2; ++n) { const size_t off = (size_t)(row0 + ai * HALF + m * 16) * DM + col0 + bj * HALF + n * 16; *(f32x4*)(x1 + off) = *(const f32x4*)(x + off) + acc[ai][bj][m][n]; }
    }
};
struct EpiD {
    static constexpr bool PERM = true, HAS_MID = false;
    struct Pre {}; __device__ __forceinline__ Pre load_pre(const Unit&, int, int, int, int) const { return Pre{}; }
    bf16_t* d;
    __device__ __forceinline__ void mid(f32x4 (&)[2][2][4][2], const Unit&, int, int, int, int) const {}
    __device__ __forceinline__ void operator()(const f32x4 (&acc)[2][2][4][2], const Unit& u, int wr, int wc, int fr, int fq, const Pre& pre) const {
        const int row0 = u.pm * BM + wr * 64 + fr, col0 = u.pn * BM + wc * 32 + 8 * fq;
#pragma unroll
        for (int ai = 0; ai < 2; ++ai)
#pragma unroll
            for (int m = 0; m < 4; ++m)
#pragma unroll
                for (int bj = 0; bj < 2; ++bj) { const f32x4 v0 = acc[ai][bj][m][0], v1 = acc[ai][bj][m][1]; u32x4 w;
                    w[0] = cvt_pk_bf16(v0[0], v0[1]); w[1] = cvt_pk_bf16(v0[2], v0[3]); w[2] = cvt_pk_bf16(v1[0], v1[1]); w[3] = cvt_pk_bf16(v1[2], v1[3]);
                    *(u32x4*)(d + (size_t)(row0 + ai * HALF + m * 16) * DM + col0 + bj * HALF) = w; }
    }
};
struct EpiAct {
    static constexpr bool PERM = true, HAS_MID = false;
    const float* bgu; void* act; float sc;
    struct Pre { f32x4 b[4]; };
    __device__ __forceinline__ Pre load_pre(const Unit& u, int wr, int wc, int fr, int fq) const { const float* bp = bgu + (size_t)u.e * 2048 + u.pn * 128 + wc * 32 + 8 * fq;
        Pre p; p.b[0] = *(const f32x4*)bp; p.b[1] = *(const f32x4*)(bp + 4); p.b[2] = *(const f32x4*)(bp + 1024); p.b[3] = *(const f32x4*)(bp + 1028); return p; }
    __device__ __forceinline__ void mid(f32x4 (&)[2][2][4][2], const Unit&, int, int, int, int) const {}
    __device__ __forceinline__ void operator()(const f32x4 (&acc)[2][2][4][2], const Unit& u, int wr, int wc, int fr, int fq, const Pre& pre) const {
        const int row0 = u.pm * BM + wr * 64 + fr, j0 = u.pn * 128 + wc * 32 + 8 * fq;
        typedef float f2 __attribute__((ext_vector_type(2)));
        f2 bg[4], bu[4];
#pragma unroll
        for (int q = 0; q < 2; ++q) { bg[q] = (f2){pre.b[0][2 * q], pre.b[0][2 * q + 1]}; bg[2 + q] = (f2){pre.b[1][2 * q], pre.b[1][2 * q + 1]}; bu[q] = (f2){pre.b[2][2 * q], pre.b[2][2 * q + 1]}; bu[2 + q] = (f2){pre.b[3][2 * q], pre.b[3][2 * q + 1]}; }
#pragma unroll
        for (int ai = 0; ai < 2; ++ai)
#pragma unroll
            for (int m = 0; m < 4; ++m) {
                float o[8];
#pragma unroll
                for (int q = 0; q < 4; ++q) {
                    const f32x4 ga = acc[ai][0][m][q >> 1], ua = acc[ai][1][m][q >> 1]; const int e0 = 2 * (q & 1);
                    f2 g = (f2){ga[e0], ga[e0 + 1]} * sc + bg[q], uu = (f2){ua[e0], ua[e0 + 1]} * sc + bu[q];
                    g.x = fminf(g.x, 7.0f); g.y = fminf(g.y, 7.0f); uu.x = __builtin_amdgcn_fmed3f(uu.x, -7.0f, 7.0f); uu.y = __builtin_amdgcn_fmed3f(uu.y, -7.0f, 7.0f);
                    const f2 z = g * (-1.702f * 1.4426950408889634f); f2 d; d.x = __builtin_amdgcn_exp2f(z.x); d.y = __builtin_amdgcn_exp2f(z.y); d = d + 1.0f;
                    f2 r; r.x = __builtin_amdgcn_rcpf(d.x); r.y = __builtin_amdgcn_rcpf(d.y);
                    const f2 res = (uu + 1.0f) * (g * r); o[2 * q] = res.x; o[2 * q + 1] = res.y; }
                const size_t off = (size_t)(row0 + ai * HALF + m * 16) * DE + j0;
                if (MOE_FP8) { *(unsigned long long*)((unsigned char*)act + off) = (unsigned long long)pk4_fp8(o[0], o[1], o[2], o[3]) | ((unsigned long long)pk4_fp8(o[4], o[5], o[6], o[7]) << 32); }
                else { u32x4 w;
#pragma unroll
                    for (int e = 0; e < 4; ++e) w[e] = cvt_pk_bf16(o[2 * e], o[2 * e + 1]);
                    *(u32x4*)((bf16_t*)act + off) = w; }
            }
    }
};
struct EpiY {
    static constexpr bool PERM = true, HAS_MID = false;
    const float* bd; bf16_t* y; float sc;
    struct Pre { f32x4 b[4]; };
    __device__ __forceinline__ Pre load_pre(const Unit& u, int wr, int wc, int fr, int fq) const { const float* bp = bd + (size_t)u.e * DM + u.pn * BM + wc * 32 + 8 * fq;
        Pre p; p.b[0] = *(const f32x4*)bp; p.b[1] = *(const f32x4*)(bp + 4); p.b[2] = *(const f32x4*)(bp + HALF); p.b[3] = *(const f32x4*)(bp + HALF + 4); return p; }
    __device__ __forceinline__ void mid(f32x4 (&)[2][2][4][2], const Unit&, int, int, int, int) const {}
    __device__ __forceinline__ void operator()(const f32x4 (&acc)[2][2][4][2], const Unit& u, int wr, int wc, int fr, int fq, const Pre& pre) const {
        const int row0 = u.pm * BM + wr * 64 + fr, col0 = u.pn * BM + wc * 32 + 8 * fq;
#pragma unroll
        for (int bj = 0; bj < 2; ++bj) {
            const f32x4 b0 = pre.b[2 * bj], b1 = pre.b[2 * bj + 1];
#pragma unroll
            for (int ai = 0; ai < 2; ++ai)
#pragma unroll
                for (int m = 0; m < 4; ++m) { const f32x4 v0 = acc[ai][bj][m][0] * sc + b0, v1 = acc[ai][bj][m][1] * sc + b1;
                    const size_t off = (size_t)(row0 + ai * HALF + m * 16) * DM + col0 + bj * HALF;
                    if (Y_FP8) *(unsigned long long*)((unsigned char*)y + off) = (unsigned long long)pk4_fp8(clamp448(v0[0]), clamp448(v0[1]), clamp448(v0[2]), clamp448(v0[3])) | ((unsigned long long)pk4_fp8(clamp448(v1[0]), clamp448(v1[1]), clamp448(v1[2]), clamp448(v1[3])) << 32);
                    else { u32x4 w; w[0] = cvt_pk_bf16(v0[0], v0[1]); w[1] = cvt_pk_bf16(v0[2], v0[3]); w[2] = cvt_pk_bf16(v1[0], v1[1]); w[3] = cvt_pk_bf16(v1[2], v1[3]);
                        *(u32x4*)(y + off) = w; } }
        }
    }
};
}

struct Frame {
    LAS unsigned char* lds; volatile LAS unsigned* MISC; unsigned* ctl;
    int tid, lane, wave, vcu, G;
    const float *x, *norm_mix_g, *w_in, *conv_w, *conv_b, *w_rg, *b_rg, *w_ig, *b_ig, *lam, *sinks, *w_attn_o, *w_lru_o, *w_out, *norm_ffn_g, *w_router, *b_router, *w_gu, *b_gu, *w_down, *b_down, *norm_final_g;
    const int* positions; float* out;
    unsigned char* ws;
    __device__ __forceinline__ bf16_t* Win_t() const { return (bf16_t*)(ws + WS_WIN); }
    __device__ __forceinline__ bf16_t* Wcat_t() const { return (bf16_t*)(ws + WS_WCAT); }
    __device__ __forceinline__ bf16_t* Wout_t() const { return (bf16_t*)(ws + WS_WOUT); }
    __device__ __forceinline__ bf16_t* Wgu_t() const { return (bf16_t*)(ws + WS_WGU); }
    __device__ __forceinline__ bf16_t* Wd_t() const { return (bf16_t*)(ws + WS_WD); }
    __device__ __forceinline__ bf16_t* Wrg_t() const { return (bf16_t*)(ws + WS_WRG); }
    __device__ __forceinline__ bf16_t* Wig_t() const { return (bf16_t*)(ws + WS_WIG); }
    __device__ __forceinline__ bf16_t* Wrt() const { return (bf16_t*)(ws + WS_WRT); }
    __device__ __forceinline__ bf16_t* h() const { return (bf16_t*)(ws + WS_H); }
    __device__ __forceinline__ bf16_t* q() const { return (bf16_t*)(ws + WS_Q); }
    __device__ __forceinline__ bf16_t* k() const { return (bf16_t*)(ws + WS_K); }
    __device__ __forceinline__ bf16_t* v() const { return (bf16_t*)(ws + WS_V); }
    __device__ __forceinline__ bf16_t* xr() const { return (bf16_t*)(ws + WS_XR); }
    __device__ __forceinline__ bf16_t* yg() const { return (bf16_t*)(ws + WS_YG); }
    __device__ __forceinline__ bf16_t* ratio() const { return (bf16_t*)(ws + WS_RATIO); }
    __device__ __forceinline__ bf16_t* gls() const { return (bf16_t*)(ws + WS_GLS); }
    __device__ __forceinline__ bf16_t* ao() const { return (bf16_t*)(ws + WS_AO); }
    __device__ __forceinline__ bf16_t* merged() const { return (bf16_t*)(ws + WS_MERGED); }
    __device__ __forceinline__ bf16_t* h2() const { return (bf16_t*)(ws + WS_H2); }
    __device__ __forceinline__ bf16_t* act() const { return (bf16_t*)(ws + WS_ACT); }
    __device__ __forceinline__ bf16_t* y() const { return (bf16_t*)(ws + WS_Y); }
    __device__ __forceinline__ float* x1() const { return (float*)(ws + WS_X1); }
    __device__ __forceinline__ bf16_t* dmix() const { return (bf16_t*)(ws + WS_X1); }
    __device__ __forceinline__ float* tok_w() const { return (float*)(ws + WS_TOKW); }
    __device__ __forceinline__ int* tok_e() const { return (int*)(ws + WS_TOKE); }
    __device__ __forceinline__ int* tok_p() const { return (int*)(ws + WS_TOKP); }
    __device__ __forceinline__ int* slot_tok() const { return (int*)(ws + WS_SLOT); }
};

struct XDesc { const float* src; unsigned char* dst; int N, ldd, kind, n0; };
constexpr int XA_IN = 16 * 60, XA_AO = 8 * 16, XA_OUT = 16 * 16, XA_G = LH, XA_N = XA_IN + 2 * XA_AO + XA_OUT + 2 * XA_G;
constexpr int XB_GU = NE * 16 * 32, XB_D = NE * 16 * 16, XB_N = XB_GU + XB_D;
__device__ __forceinline__ XDesc x_desc(const Frame& F, int list, int r) {
    XDesc d;
    if (list == 1) {
        if (r < XB_GU) { const int e = r >> 9, rr = r & 511, kb = rr >> 5, nb = rr & 31; d.src = F.w_gu + (size_t)e * DM * 2048 + (size_t)(64 * kb) * 2048 + 64 * nb; d.N = 2048; d.n0 = 64 * nb; d.ldd = DM;
            d.kind = MOE_FP8 ? 2 : 4; d.dst = (unsigned char*)F.Wgu_t() + ((size_t)e * 2048 * DM + 64 * kb) * (MOE_FP8 ? 1 : 2); return d; }
        r -= XB_GU; { const int e = r >> 8, rr = r & 255, kb = rr >> 4, nb = rr & 15; d.src = F.w_down + (size_t)e * DE * DM + (size_t)(64 * kb) * DM + 64 * nb; d.N = DM; d.n0 = 64 * nb; d.ldd = DE;
            d.kind = MOE_FP8 ? 3 : 0; d.dst = (unsigned char*)F.Wd_t() + ((size_t)e * DM * DE + 64 * kb) * (MOE_FP8 ? 1 : 2); return d; }
    }
    if (r < XA_IN) { const int kb = r / 60, nb = r % 60; d.src = F.w_in + (size_t)(64 * kb) * INW + 64 * nb; d.N = INW; d.n0 = 64 * nb; d.ldd = DM; d.kind = 1; d.dst = (unsigned char*)(F.Win_t() + 64 * kb); return d; } r -= XA_IN;
    if (r < XA_AO) { const int kb = r >> 4, nb = r & 15; d.src = F.w_attn_o + (size_t)(64 * kb) * DM + 64 * nb; d.N = DM; d.n0 = 64 * nb; d.ldd = DM; d.kind = 0; d.dst = (unsigned char*)(F.Wcat_t() + 64 * kb); return d; } r -= XA_AO;
    if (r < XA_AO) { const int kb = r >> 4, nb = r & 15; d.src = F.w_lru_o + (size_t)(64 * kb) * DM + 64 * nb; d.N = DM; d.n0 = 64 * nb; d.ldd = DM; d.kind = 0; d.dst = (unsigned char*)(F.Wcat_t() + 512 + 64 * kb); return d; } r -= XA_AO;
    if (r < XA_OUT) { const int kb = r >> 4, nb = r & 15; d.src = F.w_out + (size_t)(64 * kb) * DM + 64 * nb; d.N = DM; d.n0 = 64 * nb; d.ldd = DM; d.kind = 0; d.dst = (unsigned char*)(F.Wout_t() + 64 * kb); return d; } r -= XA_OUT;
    if (r < XA_G) { d.src = F.w_rg + r * 4096; d.N = 64; d.n0 = 0; d.ldd = 64; d.kind = 0; d.dst = (unsigned char*)(F.Wrg_t() + r * 4096); return d; } r -= XA_G;
    d.src = F.w_ig + r * 4096; d.N = 64; d.n0 = 0; d.ldd = 64; d.kind = 0; d.dst = (unsigned char*)(F.Wig_t() + r * 4096); return d;
}
__device__ __forceinline__ void xpose_write(LAS float* scr, const float (&v)[64], int lane) {
#pragma unroll
    for (int i = 0; i < 64; ++i) scr[i * 64 + (lane ^ (i & 31))] = v[i];
    asm volatile("" ::: "memory");
}
__device__ __forceinline__ void xpose_store(const XDesc& d, LAS float* scr, int lane) {
    const int c = lane & 7, nn = lane >> 3;
#pragma unroll
    for (int j = 0; j < 8; ++j) {
        const int n = nn + 8 * j, o = d.n0 + n;
        const int row = d.kind == 1 ? g1_inv(o) : (d.kind == 2 || d.kind == 4) ? gu_inv(o) : o;
        float f[8];
#pragma unroll
        for (int e = 0; e < 8; ++e) { const int kx = 8 * c + e; f[e] = scr[kx * 64 + (n ^ (kx & 31))]; }
        if (d.kind == 2 || d.kind == 3) {
#pragma unroll
            for (int e = 0; e < 8; ++e) f[e] = clamp448(f[e] * W8_SCALE);
            *(unsigned long long*)(d.dst + (size_t)row * d.ldd + 8 * c) = (unsigned long long)pk4_fp8(f[0], f[1], f[2], f[3]) | ((unsigned long long)pk4_fp8(f[4], f[5], f[6], f[7]) << 32);
        } else { u32x4 w; w.x = cvt_pk_bf16(f[0], f[1]); w.y = cvt_pk_bf16(f[2], f[3]); w.z = cvt_pk_bf16(f[4], f[5]); w.w = cvt_pk_bf16(f[6], f[7]);
            *(u32x4*)(d.dst + ((size_t)row * d.ldd + 8 * c) * 2) = w; }
    }
    asm volatile("s_waitcnt lgkmcnt(0)" ::: "memory");
}
__device__ __forceinline__ void xpose_run(const Frame& F, int list, int first, int count, int stride) {
    LAS float* scr = (LAS float*)(F.lds + F.wave * 16384);
    const int lane = F.lane;
    float va[64], vb[64];
    int ia = first, ib = first + stride;
    if (ia >= count) return;
    XDesc da = x_desc(F, list, ia), db = da;
#pragma unroll
    for (int i = 0; i < 64; ++i) va[i] = da.src[(size_t)i * da.N + lane];
    if (ib < count) { db = x_desc(F, list, ib);
#pragma unroll
        for (int i = 0; i < 64; ++i) vb[i] = db.src[(size_t)i * db.N + lane]; }
    for (;;) {
        {
            xpose_write(scr, va, lane);
            const XDesc dc = da; const int na = ia + 2 * stride;
            if (na < count) { da = x_desc(F, list, na);
#pragma unroll
                for (int i = 0; i < 64; ++i) va[i] = da.src[(size_t)i * da.N + lane]; }
            xpose_store(dc, scr, lane); ia = na;
        }
        if (ib >= count) break;
        {
            xpose_write(scr, vb, lane);
            const XDesc dc = db; const int nb = ib + 2 * stride;
            if (nb < count) { db = x_desc(F, list, nb);
#pragma unroll
                for (int i = 0; i < 64; ++i) vb[i] = db.src[(size_t)i * db.N + lane]; }
            xpose_store(dc, scr, lane); ib = nb;
        }
        if (ia >= count) break;
    }
}
__device__ __forceinline__ void xq8_load(const XDesc& d, f32x4 (&v)[16], int lane) {
    const float* p = d.src + (size_t)(lane & 3) * d.N + 4 * (lane >> 2);
#pragma unroll
    for (int i = 0; i < 16; ++i) v[i] = *(const f32x4*)(p + (size_t)(4 * i) * d.N);
}
__device__ __forceinline__ void xq8_store(const XDesc& d, const f32x4 (&v)[16], int lane) {
    const int kq = lane & 3; const unsigned selA = 0x0c0c0000u | ((4u + kq) << 8) | (unsigned)kq, selB = ((4u + kq) << 24) | ((unsigned)kq << 16) | 0x0c0cu;
    unsigned T[16];
#pragma unroll
    for (int i = 0; i < 16; ++i) {
        const int D = (int)pk4_fp8(clamp448(v[i].x * W8_SCALE), clamp448(v[i].y * W8_SCALE), clamp448(v[i].z * W8_SCALE), clamp448(v[i].w * W8_SCALE));
        const unsigned x0 = (unsigned)__builtin_amdgcn_mov_dpp(D, 0x00, 0xf, 0xf, true), x1 = (unsigned)__builtin_amdgcn_mov_dpp(D, 0x55, 0xf, 0xf, true),
                       x2 = (unsigned)__builtin_amdgcn_mov_dpp(D, 0xaa, 0xf, 0xf, true), x3 = (unsigned)__builtin_amdgcn_mov_dpp(D, 0xff, 0xf, 0xf, true);
        T[i] = __builtin_amdgcn_perm(x1, x0, selA) | __builtin_amdgcn_perm(x3, x2, selB);
    }
    const int o = d.n0 + 4 * (lane >> 2) + kq; const int row = d.kind == 2 ? gu_inv(o) : o;
    unsigned char* op = d.dst + (size_t)row * d.ldd;
#pragma unroll
    for (int q = 0; q < 4; ++q) *(u32x4*)(op + 16 * q) = (u32x4){T[4 * q], T[4 * q + 1], T[4 * q + 2], T[4 * q + 3]};
}
__device__ __forceinline__ void xq8_run(const Frame& F, int first, int count) {
    const int lane = F.lane; f32x4 va[16], vb[16];
    int ia = first, ib = first + 1; if (ia >= count) return;
    XDesc da = x_desc(F, 1, ia), db = da; xq8_load(da, va, lane);
    if (ib < count) { db = x_desc(F, 1, ib); xq8_load(db, vb, lane); }
    for (;;) {
        { const XDesc dc = da; f32x4 t[16];
#pragma unroll
          for (int i = 0; i < 16; ++i) t[i] = va[i];
          ia += 2; if (ia < count) { da = x_desc(F, 1, ia); xq8_load(da, va, lane); }
          xq8_store(dc, t, lane); }
        if (ib >= count) break;
        { const XDesc dc = db; f32x4 t[16];
#pragma unroll
          for (int i = 0; i < 16; ++i) t[i] = vb[i];
          ib += 2; if (ib < count) { db = x_desc(F, 1, ib); xq8_load(db, vb, lane); }
          xq8_store(dc, t, lane); }
        if (ia >= count) break;
    }
}
#ifndef XQ_DPP
#define XQ_DPP 0
#endif
#ifndef P1_XWG
#define P1_XWG 42
#endif
constexpr int XQ_TILES = 16, XQ_ITEMS = XB_N / XQ_TILES;
#ifndef XQ_P1
#define XQ_P1 576
#endif
constexpr int CW_XQ1 = 12288 + 64, CW_XQ2 = 12288 + 128;
__device__ __forceinline__ int wg_pull(Frame& F, int cw) {
    if (F.tid == 0) F.MISC[MW_Q] = atomicAdd(&F.ctl[cw], 1u);
    __syncthreads();
    const int item = (int)F.MISC[MW_Q];
    __syncthreads();
    return item;
}
__device__ __forceinline__ void xq_item(Frame& F, int idx) { const int t0 = idx * XQ_TILES + F.wave * 2; if (MOE_FP8 && XQ_DPP) xq8_run(F, t0, t0 + 2); else xpose_run(F, 1, t0, t0 + 2, 1); }
__device__ __forceinline__ void p0_prologue(Frame& F) {
    const int gw = F.vcu * NWAVES + F.wave, NGW = F.G * NWAVES;
    xpose_run(F, 0, gw, XA_N, NGW);
    for (int idx = gw * 64 + F.lane; idx < NE * DM; idx += NGW * 64) { const int e = idx >> 10, kx = idx & 1023; F.Wrt()[idx] = f2bf(F.w_router[kx * NE + e]); }
    f32x4 gv[4];
#pragma unroll
    for (int j = 0; j < 4; ++j) gv[j] = *(const f32x4*)(F.norm_mix_g + 4 * F.lane + 256 * j);
    for (int m0 = gw * 4; m0 < NTOK; m0 += NGW * 4) {
        f32x4 v[4][4];
#pragma unroll
        for (int r = 0; r < 4; ++r)
#pragma unroll
            for (int j = 0; j < 4; ++j) v[r][j] = *((const f32x4*)(F.x + (size_t)(m0 + r) * DM) + F.lane + 64 * j);
#pragma unroll
        for (int r = 0; r < 4; ++r) { float s = 0.f;
#pragma unroll
            for (int j = 0; j < 4; ++j) s += (v[r][j].x * v[r][j].x + v[r][j].y * v[r][j].y) + (v[r][j].z * v[r][j].z + v[r][j].w * v[r][j].w);
            const float rs = rsqrtf(wave_sum(s) * (1.0f / DM) + 1e-6f);
            unsigned long long* o8 = (unsigned long long*)(F.h() + (size_t)(m0 + r) * DM) + F.lane;
#pragma unroll
            for (int j = 0; j < 4; ++j) o8[64 * j] = (unsigned long long)cvt_pk_bf16(v[r][j].x * rs * gv[j].x, v[r][j].y * rs * gv[j].y) | ((unsigned long long)cvt_pk_bf16(v[r][j].z * rs * gv[j].z, v[r][j].w * rs * gv[j].w) << 32); }
    }
}

__device__ __forceinline__ s16x4 vtr(const LAS unsigned char* p) { typedef short v4i16_t __attribute__((ext_vector_type(4))); return __builtin_bit_cast(s16x4, __builtin_amdgcn_ds_read_tr16_b64_v4i16((LAS v4i16_t*)p)); }
constexpr int AT_KS = 0, AT_VS = 36864, AT_LS = 36864 + 32768;
__device__ __forceinline__ void attn_unit(Frame& F, int unit) {
    const int b = unit >> 5, kvh = (unit >> 4) & 1, qb = unit & 15;
    const int tid = F.tid, lane = F.lane, wid = F.wave, hi = lane >> 5, iq = lane & 31;
    const size_t n0 = (size_t)b * SEQ + 128 * qb;
    LAS unsigned char* Ks = F.lds + AT_KS; LAS unsigned char* Vs = F.lds + AT_VS; LAS float* Ls = (LAS float*)(F.lds + AT_LS) + wid * 32;
#pragma unroll
    for (int i = 0; i < 4; ++i) {
        const int ch = tid + 512 * i, key = ch >> 3, c = ch & 7; const bool valid = (qb > 0) || (key >= 128);
        u32x4 kv = (u32x4){0u, 0u, 0u, 0u}, vv = (u32x4){0u, 0u, 0u, 0u};
        if (valid) { const size_t tok = n0 - 128 + key; kv = *(const u32x4*)(F.k() + tok * KVW + kvh * 64 + c * 8); vv = *(const u32x4*)(F.v() + tok * KVW + kvh * 64 + c * 8); }
        *(LAS u32x4*)(Ks + key * 144 + c * 16) = kv;
        *(LAS u32x4*)(Vs + ((key >> 3) * 2 + (c >> 2)) * 512 + (key & 7) * 64 + (c & 3) * 16) = vv;
    }
    __syncthreads();
    const int g = wid >> 1, qh = wid & 1, hq = kvh * 4 + g;
    const float sink2 = F.sinks[hq] * 1.4426950408889634f; const float c2 = 0.125f * 1.4426950408889634f;
    const int voff = (4 * hi + ((lane & 15) >> 2)) * 64 + ((lane >> 4) & 1) * 32 + (lane & 3) * 8;
#pragma unroll 1
    for (int sb = 0; sb < 2; ++sb) {
        const int s1 = 2 * qh + sb; const size_t nq = n0 + 32 * s1 + iq;
        bf16x8 qf[4];
#pragma unroll
        for (int s = 0; s < 4; ++s) qf[s] = *(const bf16x8*)(F.q() + nq * AW + hq * 64 + 16 * s + 8 * hi);
        f32x16 p[5];
#pragma unroll
        for (int tt = 0; tt < 5; ++tt) {
            p[tt] = (f32x16){0.f, 0.f, 0.f, 0.f, 0.f, 0.f, 0.f, 0.f, 0.f, 0.f, 0.f, 0.f, 0.f, 0.f, 0.f, 0.f};
#pragma unroll
            for (int s = 0; s < 4; ++s) { const bf16x8 kf = *(const LAS bf16x8*)(Ks + (32 * (s1 + tt) + iq) * 144 + (16 * s + 8 * hi) * 2); p[tt] = __builtin_amdgcn_mfma_f32_32x32x16_bf16(kf, qf[s], p[tt], 0, 0, 0); }
        }
        float mx = sink2;
#pragma unroll
        for (int tt = 0; tt < 5; ++tt) {
            const bool tile_ok = (qb > 0) || (s1 + tt >= 4);
#pragma unroll
            for (int r = 0; r < 16; ++r) { const int kk = crow(r, hi); bool ok = tile_ok; if (tt == 0) ok = ok && (kk >= iq + 1); if (tt == 4) ok = ok && (kk <= iq);
                const float sc = ok ? p[tt][r] * c2 : -INFINITY; p[tt][r] = sc; mx = fmaxf(mx, sc); }
        }
        mx = fmaxf(mx, __shfl_xor(mx, 32));
        float l = 0.f;
#pragma unroll
        for (int tt = 0; tt < 5; ++tt)
#pragma unroll
            for (int r = 0; r < 16; ++r) { const float e = __builtin_amdgcn_exp2f(p[tt][r] - mx); p[tt][r] = e; l += e; }
        l += __shfl_xor(l, 32); l += __builtin_amdgcn_exp2f(sink2 - mx);
        f32x16 o[2];
        o[0] = (f32x16){0.f, 0.f, 0.f, 0.f, 0.f, 0.f, 0.f, 0.f, 0.f, 0.f, 0.f, 0.f, 0.f, 0.f, 0.f, 0.f}; o[1] = o[0];
#pragma unroll
        for (int tt = 0; tt < 5; ++tt)
#pragma unroll
            for (int s2 = 0; s2 < 2; ++s2) {
                u32x4 pw;
#pragma unroll
                for (int e = 0; e < 4; ++e) pw[e] = cvt_pk_bf16(p[tt][8 * s2 + 2 * e], p[tt][8 * s2 + 2 * e + 1]);
                const bf16x8 pa = __builtin_bit_cast(bf16x8, pw);
                const int sub = 4 * (s1 + tt) + 2 * s2;
#pragma unroll
                for (int db = 0; db < 2; ++db) {
                    const s16x4 lo = vtr(Vs + (sub * 2 + db) * 512 + voff), hi4 = vtr(Vs + ((sub + 1) * 2 + db) * 512 + voff);
                    const bf16x8 vb = (bf16x8){lo[0], lo[1], lo[2], lo[3], hi4[0], hi4[1], hi4[2], hi4[3]};
                    o[db] = __builtin_amdgcn_mfma_f32_32x32x16_bf16(pa, vb, o[db], 0, 0, 0);
                }
            }
        if (hi == 0) Ls[iq] = __builtin_amdgcn_rcpf(l);
        asm volatile("s_waitcnt lgkmcnt(0)" ::: "memory");
#pragma unroll
        for (int r = 0; r < 16; ++r) { const int qr = crow(r, hi); const float il = Ls[qr]; bf16_t* op = F.ao() + (n0 + 32 * s1 + qr) * DM + hq * 64 + iq;
            op[0] = f2bf(o[0][r] * il); op[32] = f2bf(o[1][r] * il); }
        asm volatile("s_waitcnt lgkmcnt(0)" ::: "memory");
    }
    __syncthreads();
}
constexpr int LR_XA = 0, LR_AS = 18432, LR_US = LR_AS + 32768, LR_CH = LR_US + 32768, LR_HC = LR_CH + 4096;
__device__ __forceinline__ void lru_unit(Frame& F, int unit) {
    const int b = unit >> 3, hh = unit & 7, C0 = 64 * hh;
    const int tid = F.tid, lane = F.lane, wid = F.wave, hi = lane >> 5;
    LAS unsigned char* XA = F.lds + LR_XA; LAS float* AS = (LAS float*)(F.lds + LR_AS); LAS float* US = (LAS float*)(F.lds + LR_US); LAS float* CH = (LAS float*)(F.lds + LR_CH); LAS float* HC = (LAS float*)(F.lds + LR_HC);
    const int tb = wid >> 1, cb = wid & 1, cm = 32 * cb + (lane & 31), Cm = C0 + cm;
    bf16x8 brg[4], big[4];
#pragma unroll
    for (int s = 0; s < 4; ++s) { brg[s] = *(const bf16x8*)(F.Wrg_t() + hh * 4096 + cm * 64 + 16 * s + 8 * hi); big[s] = *(const bf16x8*)(F.Wig_t() + hh * 4096 + cm * 64 + 16 * s + 8 * hi); }
    const float brg_b = F.b_rg[Cm], big_b = F.b_ig[Cm], sp8 = 8.0f * log1pf(__expf(-F.lam[Cm])) * 1.4426950408889634f;
    const int cs = tid & 63, js = wid, Cs = C0 + cs;
    const int tokc = tid >> 2, cq = tid & 3, Cq = C0 + 16 * cq;
    if (tid < 64) HC[tid] = 0.f;
    u32x4 xn[4][2];
    {
#pragma unroll
        for (int j = 0; j < 4; ++j) { const int tt = tokc - 3 + j;
#pragma unroll
            for (int hf = 0; hf < 2; ++hf) xn[j][hf] = tt >= 0 ? *(const u32x4*)(F.xr() + ((size_t)b * SEQ + tt) * LW + Cq + 8 * hf) : (u32x4){0u, 0u, 0u, 0u}; }
    }
#pragma unroll 1
    for (int tile = 0; tile < SEQ / 128; ++tile) {
        const int t0 = 128 * tile;
        {
            float xc[16];
#pragma unroll
            for (int e4 = 0; e4 < 4; ++e4) { const f32x4 cbv = *(const f32x4*)(F.conv_b + Cq + 4 * e4); xc[4 * e4] = cbv.x; xc[4 * e4 + 1] = cbv.y; xc[4 * e4 + 2] = cbv.z; xc[4 * e4 + 3] = cbv.w; }
#pragma unroll
            for (int j = 0; j < 4; ++j) { float xf[16]; { float t8[8]; unpack8(xn[j][0], t8);
#pragma unroll
                    for (int e = 0; e < 8; ++e) xf[e] = t8[e]; unpack8(xn[j][1], t8);
#pragma unroll
                    for (int e = 0; e < 8; ++e) xf[8 + e] = t8[e]; }
#pragma unroll
                for (int e4 = 0; e4 < 4; ++e4) { const f32x4 w = *(const f32x4*)(F.conv_w + j * LW + Cq + 4 * e4); xc[4 * e4] += xf[4 * e4] * w.x; xc[4 * e4 + 1] += xf[4 * e4 + 1] * w.y; xc[4 * e4 + 2] += xf[4 * e4 + 2] * w.z; xc[4 * e4 + 3] += xf[4 * e4 + 3] * w.w; } }
            u32x4 w0, w1;
#pragma unroll
            for (int e = 0; e < 4; ++e) { w0[e] = cvt_pk_bf16(xc[2 * e], xc[2 * e + 1]); w1[e] = cvt_pk_bf16(xc[8 + 2 * e], xc[8 + 2 * e + 1]); }
            *(LAS u32x4*)(XA + tokc * 144 + cq * 32) = w0; *(LAS u32x4*)(XA + tokc * 144 + cq * 32 + 16) = w1;
        }
        if (tile + 1 < SEQ / 128) {
#pragma unroll
            for (int j = 0; j < 4; ++j) { const size_t tt = (size_t)b * SEQ + t0 + 128 + tokc - 3 + j;
                xn[j][0] = *(const u32x4*)(F.xr() + tt * LW + Cq); xn[j][1] = *(const u32x4*)(F.xr() + tt * LW + Cq + 8); }
        }
        bf16_t ygv[16];
#pragma unroll
        for (int tt = 0; tt < 16; ++tt) ygv[tt] = F.yg()[((size_t)b * SEQ + t0 + 16 * js + tt) * LW + Cs];
        __syncthreads();
        {
            f32x16 drg = (f32x16){0.f, 0.f, 0.f, 0.f, 0.f, 0.f, 0.f, 0.f, 0.f, 0.f, 0.f, 0.f, 0.f, 0.f, 0.f, 0.f}, dig = drg;
#pragma unroll
            for (int s = 0; s < 4; ++s) { const bf16x8 af = *(const LAS bf16x8*)(XA + (32 * tb + (lane & 31)) * 144 + (16 * s + 8 * hi) * 2);
                drg = __builtin_amdgcn_mfma_f32_32x32x16_bf16(af, brg[s], drg, 0, 0, 0); dig = __builtin_amdgcn_mfma_f32_32x32x16_bf16(af, big[s], dig, 0, 0, 0); }
#pragma unroll
            for (int r = 0; r < 16; ++r) { const int t = 32 * tb + crow(r, hi);
                const float xcv = bf2f(*(const LAS bf16_t*)(XA + t * 144 + cm * 2));
                const float rg = fsig(drg[r] + brg_b), ig = fsig(dig[r] + big_b);
                const float la2 = -rg * sp8;
                const float a = __builtin_amdgcn_exp2f(la2);
                const float x2 = 2.0f * 0.6931471805599453f * la2;
                const float omp = -x2 * (1.0f + x2 * (0.5f + x2 * (0.16666667f + x2 * 0.041666668f))), omd = __builtin_fmaf(-a, a, 1.0f);
                const float om = x2 > -0.4f ? omp : omd;
                AS[t * 64 + cm] = a; US[t * 64 + cm] = __builtin_amdgcn_sqrtf(om) * (ig * xcv); }
        }
        __syncthreads();
        float av[16], uv[16]; float Ap = 1.f, Hp = 0.f;
#pragma unroll
        for (int tt = 0; tt < 16; ++tt) { av[tt] = AS[(16 * js + tt) * 64 + cs]; uv[tt] = US[(16 * js + tt) * 64 + cs]; }
#pragma unroll
        for (int tt = 0; tt < 16; ++tt) { Hp = av[tt] * Hp + uv[tt]; Ap *= av[tt]; }
        CH[js * 64 + cs] = Ap; CH[512 + js * 64 + cs] = Hp;
        __syncthreads();
        float hcur = HC[cs];
        for (int jj = 0; jj < js; ++jj) hcur = CH[jj * 64 + cs] * hcur + CH[512 + jj * 64 + cs];
#pragma unroll
        for (int tt = 0; tt < 16; ++tt) { hcur = av[tt] * hcur + uv[tt]; F.ao()[((size_t)b * SEQ + t0 + 16 * js + tt) * DM + 512 + Cs] = f2bf(hcur * bf2f(ygv[tt])); }
        __syncthreads();
        if (js == 7) HC[cs] = hcur;
    }
    __syncthreads();
}
__device__ __forceinline__ void p2_mixers(Frame& F) {
    constexpr int NLRU = NB * LH, NATT = NB * NKVH * (SEQ / 128);
    for (;;) {
        const int item = wg_pull(F, CW_QUEUE);
        if (item >= NLRU + NATT) break;
        if (item < NLRU) lru_unit(F, item); else attn_unit(F, item - NLRU);
    }
    for (;;) { const int idx = XQ_P1 + wg_pull(F, CW_XQ2); if (idx >= XQ_ITEMS) break; xq_item(F, idx); }
}

__device__ __forceinline__ void moe_tables(Frame& F) {
    if (F.tid < 64) {
        const int e = F.tid & 31; const int c = (int)__hip_atomic_load(&F.ctl[CW_GCOUNT + 64 * e], __ATOMIC_RELAXED, __HIP_MEMORY_SCOPE_AGENT);
        const int nt = (c + 255) >> 8; int inc = nt;
#pragma unroll
        for (int o = 1; o < 32; o <<= 1) { const int v = __shfl_up(inc, o, 32); if ((F.tid & 31) >= o) inc += v; }
        if (F.tid < 32) { F.MISC[MW_TS + e] = (unsigned)(inc - nt); F.MISC[MW_CNT + e] = (unsigned)c; if (e == 31) F.MISC[MW_TS + NE] = (unsigned)inc; }
    }
    __syncthreads();
    for (int m = F.tid; m < MAXTILES; m += NWAVES * 64) { int e = 0; for (int ee = 1; ee < NE; ++ee) e = (m >= (int)F.MISC[MW_TS + ee]) ? ee : e; F.MISC[MW_TE + m] = (unsigned)e; }
    __syncthreads();
}

__device__ __forceinline__ f32x4 x1_piece(const Frame& F, size_t row, int lane, int j) {
    const f32x4 xv = *((const f32x4*)(F.x + row * DM) + lane + 64 * j);
    const unsigned long long t = *((const unsigned long long*)(F.dmix() + row * DM) + lane + 64 * j); const unsigned lo = (unsigned)t, hi = (unsigned)(t >> 32);
    return xv + (f32x4){__uint_as_float(lo << 16), __uint_as_float(lo & 0xffff0000u), __uint_as_float(hi << 16), __uint_as_float(hi & 0xffff0000u)};
}
constexpr int P5_WT = 0, P5_AT = 66048, P5_ROW = 2064;
__device__ __forceinline__ void p5_router(Frame& F) {
    LAS unsigned char* WT = F.lds + P5_WT; LAS unsigned char* AT = F.lds + P5_AT;
    LAS float* PART = (LAS float*)AT;
    LAS float* LG = (LAS float*)(F.lds + MISC_OFF) + MW_P5;
    LAS float* RS = LG + 32 * 33;
    volatile LAS int* LCNT = (volatile LAS int*)(F.lds + MISC_OFF) + MW_P5 + 1280;
    volatile LAS int* LBASE = LCNT + 32;
    LAS int* PE = (LAS int*)(F.lds + MISC_OFF) + MW_P5 + 1280 + 64;
    LAS float* PW = (LAS float*)(PE + 512);
    const int tid = F.tid, lane = F.lane, wid = F.wave, hi = lane >> 5;
    for (int i = tid; i < NE * 128; i += NWAVES * 64) { const int e = i >> 7, c = i & 127; *(LAS u32x4*)(WT + e * P5_ROW + c * 16) = *(const u32x4*)(F.Wrt() + e * DM + c * 8); }
    if (tid < 32) LCNT[tid] = 0;
    const int row_base = F.vcu * 128;
    f32x4 gv[4];
#pragma unroll
    for (int j = 0; j < 4; ++j) gv[j] = *(const f32x4*)(F.norm_ffn_g + 4 * lane + 256 * j);
    f32x4 xn[4][4];
#pragma unroll
    for (int rr = 0; rr < 4; ++rr)
#pragma unroll
        for (int j = 0; j < 4; ++j) xn[rr][j] = x1_piece(F, (size_t)(row_base + wid * 4 + rr), lane, j);
#pragma unroll 1
    for (int it = 0; it < 4; ++it) {
        const int r0 = row_base + it * 32 + wid * 4;
#pragma unroll
        for (int rr = 0; rr < 4; ++rr) { float s = 0.f;
#pragma unroll
            for (int j = 0; j < 4; ++j) s += (xn[rr][j].x * xn[rr][j].x + xn[rr][j].y * xn[rr][j].y) + (xn[rr][j].z * xn[rr][j].z + xn[rr][j].w * xn[rr][j].w);
            const float rs = rsqrtf(wave_sum(s) * (1.0f / DM) + 1e-6f);
            unsigned long long* o8 = (unsigned long long*)(F.h2() + (size_t)(r0 + rr) * DM) + lane;
            unsigned* o4 = (unsigned*)((unsigned char*)F.h2() + (size_t)(r0 + rr) * DM) + lane;
#pragma unroll
            for (int j = 0; j < 4; ++j) { const f32x4 hv = xn[rr][j] * gv[j] * rs;
                if (MOE_FP8) o4[64 * j] = pk4_fp8(clamp448(hv.x), clamp448(hv.y), clamp448(hv.z), clamp448(hv.w));
                else o8[64 * j] = (unsigned long long)cvt_pk_bf16(hv.x, hv.y) | ((unsigned long long)cvt_pk_bf16(hv.z, hv.w) << 32);
                *(LAS unsigned long long*)(AT + (wid * 4 + rr) * P5_ROW + (4 * lane + 256 * j) * 2) = (unsigned long long)cvt_pk_bf16(hv.x, hv.y) | ((unsigned long long)cvt_pk_bf16(hv.z, hv.w) << 32); } }
        if (it + 1 < 4) {
#pragma unroll
            for (int rr = 0; rr < 4; ++rr)
#pragma unroll
                for (int j = 0; j < 4; ++j) xn[rr][j] = x1_piece(F, (size_t)(r0 + 32 + rr), lane, j);
        }
        __syncthreads();
        {
            f32x16 acc = (f32x16){0.f, 0.f, 0.f, 0.f, 0.f, 0.f, 0.f, 0.f, 0.f, 0.f, 0.f, 0.f, 0.f, 0.f, 0.f, 0.f};
#pragma unroll
            for (int s = 0; s < 8; ++s) { const int ko = (16 * (8 * wid + s) + 8 * hi) * 2;
                const bf16x8 af = *(const LAS bf16x8*)(AT + (lane & 31) * P5_ROW + ko), bfr = *(const LAS bf16x8*)(WT + (lane & 31) * P5_ROW + ko);
                acc = __builtin_amdgcn_mfma_f32_32x32x16_bf16(af, bfr, acc, 0, 0, 0); }
            __syncthreads();
#pragma unroll
            for (int r = 0; r < 16; ++r) PART[(wid * 16 + r) * 64 + lane] = acc[r];
        }
        __syncthreads();
#pragma unroll
        for (int q = 0; q < 2; ++q) { const int r = (tid >> 6) + 8 * q, ln = tid & 63; float sum = 0.f;
#pragma unroll
            for (int w = 0; w < 8; ++w) sum += PART[(w * 16 + r) * 64 + ln];
            LG[crow(r, ln >> 5) * 33 + (ln & 31)] = sum + F.b_router[ln & 31]; }
        __syncthreads();
        if (tid < 32) {
            const LAS float* lg = LG + tid * 33; unsigned used = 0; float tv[4]; int te[4];
#pragma unroll
            for (int kk = 0; kk < 4; ++kk) { float best = -3.0e38f; int bi = 0;
                for (int e = 0; e < NE; ++e) { const float vv = lg[e]; if (!((used >> e) & 1u) && vv > best) { best = vv; bi = e; } }
                used |= 1u << bi; tv[kk] = best; te[kk] = bi; }
            float ex[4], sum = 0.f;
#pragma unroll
            for (int kk = 0; kk < 4; ++kk) { ex[kk] = __expf(tv[kk] - tv[0]); sum += ex[kk]; }
            const float inv = 1.0f / sum; const int lr = it * 32 + tid;
#pragma unroll
            for (int kk = 0; kk < 4; ++kk) { const int lp = __hip_atomic_fetch_add((LAS int*)&LCNT[te[kk]], 1, __ATOMIC_RELAXED, __HIP_MEMORY_SCOPE_WORKGROUP); PE[lr * 4 + kk] = te[kk] | (lp << 8); PW[lr * 4 + kk] = ex[kk] * inv; }
        }
    }
    __syncthreads();
    if (tid < 32) { const int c = LCNT[tid]; LBASE[tid] = c ? (int)atomicAdd(&F.ctl[CW_GCOUNT + 64 * tid], (unsigned)c) : 0; }
    __syncthreads();
    { const int pe = PE[tid], e = pe & 255, lp = pe >> 8, pos = LBASE[e] + lp, row = row_base + (tid >> 2);
      F.tok_e()[row * 4 + (tid & 3)] = e; F.tok_w()[row * 4 + (tid & 3)] = PW[tid]; F.tok_p()[row * 4 + (tid & 3)] = pos; F.slot_tok()[(size_t)e * CAP + pos] = row; }
}

struct P8Row { f32x4 x[4]; unsigned yv[4][4]; float w[4]; };
__device__ __forceinline__ void p8_load(const Frame& F, int m, int lane, P8Row& r) {
    const int4 e4 = *(const int4*)(F.tok_e() + m * 4), p4 = *(const int4*)(F.tok_p() + m * 4); const f32x4 w4 = *(const f32x4*)(F.tok_w() + m * 4);
    const int ee[4] = {e4.x, e4.y, e4.z, e4.w}, pp[4] = {p4.x, p4.y, p4.z, p4.w}; r.w[0] = w4.x; r.w[1] = w4.y; r.w[2] = w4.z; r.w[3] = w4.w;
#pragma unroll
    for (int kk = 0; kk < 4; ++kk) { const size_t yrow = (size_t)256 * F.MISC[MW_TS + ee[kk]] + pp[kk];
        const unsigned* yp = (const unsigned*)((const unsigned char*)F.y() + yrow * DM) + lane;
#pragma unroll
        for (int j = 0; j < 4; ++j) r.yv[kk][j] = yp[64 * j]; }
#pragma unroll
    for (int j = 0; j < 4; ++j) r.x[j] = x1_piece(F, (size_t)m, lane, j);
}
__device__ __forceinline__ void p8_final(Frame& F) {
    static_assert(Y_FP8 && MOE_FP8, "p8_final reads fp8 y rows");
    const int gw = F.vcu * NWAVES + F.wave, NGW = F.G * NWAVES, lane = F.lane;
    f32x4 gv[4];
#pragma unroll
    for (int j = 0; j < 4; ++j) gv[j] = *(const f32x4*)(F.norm_final_g + 4 * lane + 256 * j);
    if (gw >= NTOK) return;
    P8Row cur, nxt; p8_load(F, gw, lane, cur);
    for (int m = gw; m < NTOK; m += NGW) {
        const int mn = m + NGW;
        if (mn < NTOK) p8_load(F, mn, lane, nxt);
        f32x4 v[4];
#pragma unroll
        for (int j = 0; j < 4; ++j) v[j] = cur.x[j];
#pragma unroll
        for (int kk = 0; kk < 4; ++kk)
#pragma unroll
            for (int j = 0; j < 4; ++j) { const int t = (int)cur.yv[kk][j]; const auto lo2 = __builtin_amdgcn_cvt_pk_f32_fp8(t, false), hi2 = __builtin_amdgcn_cvt_pk_f32_fp8(t, true); const float w = cur.w[kk];
                v[j].x += w * lo2[0]; v[j].y += w * lo2[1]; v[j].z += w * hi2[0]; v[j].w += w * hi2[1]; }
        float s = 0.f;
#pragma unroll
        for (int j = 0; j < 4; ++j) s += (v[j].x * v[j].x + v[j].y * v[j].y) + (v[j].z * v[j].z + v[j].w * v[j].w);
        const float rs = rsqrtf(wave_sum(s) * (1.0f / DM) + 1e-6f);
#pragma unroll
        for (int j = 0; j < 4; ++j) *((f32x4*)(F.out + (size_t)m * DM) + lane + 64 * j) = v[j] * rs * gv[j];
        cur = nxt;
    }
}

constexpr int NPHASE = 9;
struct Args { const void* in[23]; float* out; unsigned char* ws; int ph_lo, ph_hi; };
__global__ void __launch_bounds__(NWAVES * 64, 2) mega_fwd(Args args) {
    extern __shared__ __attribute__((aligned(16))) unsigned char lds_raw[];
    Frame F;
    F.lds = (LAS unsigned char*)lds_raw; F.MISC = (volatile LAS unsigned*)(F.lds + MISC_OFF);
    F.tid = threadIdx.x; F.lane = F.tid & 63; F.wave = __builtin_amdgcn_readfirstlane(F.tid >> 6);
    F.G = gridDim.x; { const int bx = blockIdx.x; F.vcu = (F.G % 8 == 0) ? (bx % 8) * (F.G / 8) + bx / 8 : bx; }
    unsigned char* ws = args.ws; F.ctl = (unsigned*)(ws + WS_CTL);
    F.x = (const float*)args.in[0]; F.positions = (const int*)args.in[1]; F.norm_mix_g = (const float*)args.in[2]; F.w_in = (const float*)args.in[3];
    F.conv_w = (const float*)args.in[4]; F.conv_b = (const float*)args.in[5]; F.w_rg = (const float*)args.in[6]; F.b_rg = (const float*)args.in[7];
    F.w_ig = (const float*)args.in[8]; F.b_ig = (const float*)args.in[9]; F.lam = (const float*)args.in[10]; F.sinks = (const float*)args.in[11];
    F.w_attn_o = (const float*)args.in[12]; F.w_lru_o = (const float*)args.in[13]; F.w_out = (const float*)args.in[14]; F.norm_ffn_g = (const float*)args.in[15];
    F.w_router = (const float*)args.in[16]; F.b_router = (const float*)args.in[17]; F.w_gu = (const float*)args.in[18]; F.b_gu = (const float*)args.in[19];
    F.w_down = (const float*)args.in[20]; F.b_down = (const float*)args.in[21]; F.norm_final_g = (const float*)args.in[22]; F.out = args.out;
    F.ws = ws;
    for (int u = F.tid; u < (LDS_BYTES - MISC_OFF) / 4; u += NWAVES * 64) ((LAS unsigned*)(F.lds + MISC_OFF))[u] = 0u;
    __syncthreads();
    const int lo = args.ph_lo, hi = args.ph_hi;
    const bool multi = (hi - lo) > 1;
    XcdBarrier bar; bar.bar = F.ctl + CW_BAR; bar.x = 0; bar.st = nullptr;
    if (multi) bar = xcd_barrier_post(F.ctl + CW_BAR, F.MISC + 8);
#ifndef PH_ONLY
#define PH_ONLY -1
#endif
#define IN(k) ((PH_ONLY < 0 || PH_ONLY == (k)) && lo <= (k) && (k) < hi)
#define SEAM(k) do { if (IN(k) && IN((k) + 1)) xcd_barrier(bar); } while (0)
#ifndef PROBE_K
#define PROBE_K -1
#endif
    unsigned long long pr_t0 = 0, pr_t1 = 0;
#define PSTAMP(k) do { if (PROBE_K >= 0) { if ((k) == PROBE_K) pr_t0 = __builtin_amdgcn_s_memrealtime(); if ((k) == PROBE_K + 1) pr_t1 = __builtin_amdgcn_s_memrealtime(); } } while (0)
    PSTAMP(0);
    if (IN(0)) { p0_prologue(F); SEAM(0); }
    PSTAMP(1);
    if (IN(1)) {
        const int ngemm = (P1_XWG > 0 && (int)F.G > P1_XWG) ? (int)F.G - P1_XWG : (int)F.G;
        if ((int)blockIdx.x < ngemm) { pg8::DenseSched S; S.init(F.h(), F.Win_t(), NTOK, INW, ngemm, (int)blockIdx.x);
            pg8::EpiG1 E{F.positions, F.q(), F.k(), F.v(), F.xr(), F.yg(), F.ratio(), F.gls()};
            pg8::gemm_phase<pg8::EpiG1, pg8::DenseSched, true, 2>(F.lds, S, E); }
        else { for (;;) { const int idx = wg_pull(F, CW_XQ1); if (idx >= XQ_P1) break; xq_item(F, idx); } }
        SEAM(1); }
    PSTAMP(2);
    if (IN(2)) { p2_mixers(F); SEAM(2); }
    PSTAMP(3);
    if (IN(3)) { pg8::DenseSched S; S.init(F.ao(), F.Wcat_t(), NTOK, DM, F.G, (int)blockIdx.x);
        pg8::EpiMerged E{F.ratio(), F.gls(), F.merged()};
        pg8::gemm_phase<pg8::EpiMerged, pg8::DenseSched, true, 2>(F.lds, S, E); SEAM(3); }
    PSTAMP(4);
    if (IN(4)) { pg8::DenseSched S; S.init(F.merged(), F.Wout_t(), NTOK, DM, F.G, (int)blockIdx.x);
        pg8::EpiD E{F.dmix()};
        pg8::gemm_phase<pg8::EpiD, pg8::DenseSched, true, 2>(F.lds, S, E); SEAM(4); }
    PSTAMP(5);
    if (IN(5)) { p5_router(F); SEAM(5); }
    PSTAMP(6);
    if (IN(6)) { moe_tables(F); constexpr int EB = MOE_FP8 ? 1 : 2;
        pg8::MoeSched<true, EB> S; S.init(F.h2(), F.Wgu_t(), F.slot_tok(), (const volatile LAS int*)(F.MISC + MW_TS), (const volatile LAS int*)(F.MISC + MW_CNT), 8, F.G, (int)blockIdx.x);
        pg8::EpiAct E{F.b_gu, F.act(), MOE_FP8 ? W8_INV : 1.0f};
        pg8::gemm_phase<pg8::EpiAct, pg8::MoeSched<true, EB>, true, EB>(F.lds, S, E); SEAM(6); }
    PSTAMP(7);
    if (IN(7)) { moe_tables(F); constexpr int EB = MOE_FP8 ? 1 : 2;
        pg8::MoeSched<false, EB> S; S.init(F.act(), F.Wd_t(), F.slot_tok(), (const volatile LAS int*)(F.MISC + MW_TS), (const volatile LAS int*)(F.MISC + MW_CNT), 4, F.G, (int)blockIdx.x);
#ifndef KREP7
#define KREP7 1
#endif
        pg8::EpiY E{F.b_down, F.y(), (MOE_FP8 ? W8_INV : 1.0f) / KREP7};
        pg8::gemm_phase<pg8::EpiY, pg8::MoeSched<false, EB>, true, EB, KREP7>(F.lds, S, E); SEAM(7); }
    PSTAMP(8);
    if (IN(8)) { moe_tables(F); p8_final(F); }
    PSTAMP(9);
    if (PROBE_K >= 0 && blockIdx.x == 0 && F.tid == 0) { const unsigned long long d = pr_t1 - pr_t0, te = __builtin_amdgcn_s_memrealtime(); while (__builtin_amdgcn_s_memrealtime() - te < d) __builtin_amdgcn_s_sleep(8); }
#undef IN
#undef SEAM
}

#ifndef OPT_MASK
#define OPT_MASK 0x1FF
#define FORCE_MULTI 0
#endif
extern "C" void kernel_launch(void* const* d_in, const int* in_sizes, int n_in, void* d_out, int out_size, void* d_ws, size_t ws_size, hipStream_t stream) {
    if (n_in != 23 || ws_size < WS_END) { fprintf(stderr, "kernel_launch: unexpected inputs (%d) or workspace (%zu)\n", n_in, ws_size); return; }
    static int grid = 0;
    if (grid == 0) {
        int dev = 0, cus = 0;
        if (hipGetDevice(&dev) != hipSuccess || hipDeviceGetAttribute(&cus, hipDeviceAttributeMultiprocessorCount, dev) != hipSuccess) { grid = -1; return; }
        if (hipFuncSetAttribute((const void*)mega_fwd, hipFuncAttributeMaxDynamicSharedMemorySize, LDS_BYTES) != hipSuccess) { fprintf(stderr, "kernel_launch: hipFuncSetAttribute failed\n"); grid = -1; return; }
        int per_cu = 0; (void)hipOccupancyMaxActiveBlocksPerMultiprocessor(&per_cu, (const void*)mega_fwd, NWAVES * 64, LDS_BYTES); (void)hipGetLastError();
        grid = 256; if (cus != 256 || per_cu < 1) fprintf(stderr, "kernel_launch: note: %d CUs, occupancy %d\n", cus, per_cu);
    }
    if (grid < 0) return;
    const float* x = (const float*)d_in[0]; const int* positions = (const int*)d_in[1]; const float* norm_mix_g = (const float*)d_in[2]; const float* w_in = (const float*)d_in[3];
    const float* conv_w = (const float*)d_in[4]; const float* conv_b = (const float*)d_in[5]; const float* w_rg = (const float*)d_in[6]; const float* b_rg = (const float*)d_in[7];
    const float* w_ig = (const float*)d_in[8]; const float* b_ig = (const float*)d_in[9]; const float* lam = (const float*)d_in[10]; const float* sinks = (const float*)d_in[11];
    const float* w_attn_o = (const float*)d_in[12]; const float* w_lru_o = (const float*)d_in[13]; const float* w_out = (const float*)d_in[14]; const float* norm_ffn_g = (const float*)d_in[15];
    const float* w_router = (const float*)d_in[16]; const float* b_router = (const float*)d_in[17]; const float* w_gu = (const float*)d_in[18]; const float* b_gu = (const float*)d_in[19];
    const float* w_down = (const float*)d_in[20]; const float* b_down = (const float*)d_in[21]; const float* norm_final_g = (const float*)d_in[22];
    unsigned char* ws = (unsigned char*)d_ws; float* out = (float*)d_out;
    unsigned* ctl = (unsigned*)(ws + WS_CTL);
    bf16_t* Win_t = (bf16_t*)(ws + WS_WIN); bf16_t* Wcat_t = (bf16_t*)(ws + WS_WCAT); bf16_t* Wout_t = (bf16_t*)(ws + WS_WOUT); bf16_t* Wgu_t = (bf16_t*)(ws + WS_WGU); bf16_t* Wd_t = (bf16_t*)(ws + WS_WD);
    bf16_t* Wrg_t = (bf16_t*)(ws + WS_WRG); bf16_t* Wig_t = (bf16_t*)(ws + WS_WIG);
    float* x1 = (float*)(ws + WS_X1); bf16_t* h2 = (bf16_t*)(ws + WS_H2); bf16_t* act = (bf16_t*)(ws + WS_ACT); bf16_t* y = (bf16_t*)(ws + WS_Y);
    bf16_t* h = (bf16_t*)(ws + WS_H); bf16_t* q = (bf16_t*)(ws + WS_Q); bf16_t* k = (bf16_t*)(ws + WS_K); bf16_t* v = (bf16_t*)(ws + WS_V); bf16_t* xr = (bf16_t*)(ws + WS_XR); bf16_t* yg = (bf16_t*)(ws + WS_YG);
    bf16_t* ratio = (bf16_t*)(ws + WS_RATIO); bf16_t* gls = (bf16_t*)(ws + WS_GLS); bf16_t* ao = (bf16_t*)(ws + WS_AO); bf16_t* merged = (bf16_t*)(ws + WS_MERGED); float* xc = (float*)(ws + WS_XC);
    int* tok_e = (int*)(ws + WS_TOKE); float* tok_w = (float*)(ws + WS_TOKW); int* tok_p = (int*)(ws + WS_TOKP); int* slot_tok = (int*)(ws + WS_SLOT); float* logits = (float*)(ws + WS_LOGIT); float* rstd = (float*)(ws + WS_RSTD);

    (void)hipMemsetAsync(ws + WS_CTL, 0, CTL_BYTES, stream);
    Args a{};
    for (int i = 0; i < 23; ++i) a.in[i] = d_in[i];
    a.out = out; a.ws = ws;
#ifndef FORCE_MULTI
#define FORCE_MULTI 0
#endif
    if (OPT_MASK == 0x1FF && !FORCE_MULTI) { a.ph_lo = 0; a.ph_hi = NPHASE; hipLaunchKernelGGL(mega_fwd, dim3(grid), dim3(NWAVES * 64), LDS_BYTES, stream, a); return; }
    const int G = 2048, B = 256;
    for (int ph = 0; ph < NPHASE; ++ph) {
        if ((OPT_MASK >> ph) & 1) { a.ph_lo = ph; a.ph_hi = ph + 1; hipLaunchKernelGGL(mega_fwd, dim3(grid), dim3(NWAVES * 64), LDS_BYTES, stream, a); continue; }
        switch (ph) {
        case 0:
            nv_transpose<<<G, B, 0, stream>>>(w_in, DM, INW, Win_t, DM, 0, INW, 1, 1);
            nv_transpose<<<G, B, 0, stream>>>(w_attn_o, 512, DM, Wcat_t, DM, 0, DM, 0, 1);
            nv_transpose<<<G, B, 0, stream>>>(w_lru_o, 512, DM, Wcat_t, DM, 512, DM, 0, 1);
            nv_transpose<<<G, B, 0, stream>>>(w_out, DM, DM, Wout_t, DM, 0, DM, 0, 1);
            nv_transpose<<<G, B, 0, stream>>>(w_gu, DM, 2048, Wgu_t, DM, 0, 2048, 2, NE);
            nv_transpose<<<G, B, 0, stream>>>(w_down, DE, DM, Wd_t, DE, 0, DM, 0, NE);
            nv_transpose<<<G, B, 0, stream>>>(w_rg, 64, 64, Wrg_t, 64, 0, 64, 0, LH);
            nv_transpose<<<G, B, 0, stream>>>(w_ig, 64, 64, Wig_t, 64, 0, 64, 0, LH);
            nv_rmsnorm_bf16<<<G, B, 0, stream>>>(x, norm_mix_g, h, nullptr); break;
        case 1: nv_gemm1<<<G * 4, B, 0, stream>>>(h, Win_t, positions, q, k, v, xr, yg, ratio, gls); break;
        case 2:
            nv_attn<<<G, B, 0, stream>>>(q, k, v, sinks, ao);
            nv_conv<<<G, B, 0, stream>>>(xr, conv_w, conv_b, xc);
            nv_scan<<<NB * LW / 64, 64, 0, stream>>>(xc, w_rg, b_rg, w_ig, b_ig, lam, yg, ao); break;
        case 3: nv_merged<<<G * 4, B, 0, stream>>>(ao, Wcat_t, ratio, gls, merged); break;
        case 4: nv_wout<<<G * 4, B, 0, stream>>>(merged, Wout_t, x, x1); break;
        case 5:
            nv_rmsnorm_bf16<<<G, B, 0, stream>>>(x1, norm_ffn_g, h2, rstd);
            nv_logits<<<G, B, 0, stream>>>(x1, rstd, norm_ffn_g, w_router, b_router, logits);
            nv_topk<<<NTOK / 256, 256, 0, stream>>>(logits, ctl, tok_e, tok_w, tok_p, slot_tok); break;
        case 6: nv_moe1<<<G * 4, B, 0, stream>>>(ctl, slot_tok, h2, Wgu_t, b_gu, act); break;
        case 7: nv_moe2<<<G * 4, B, 0, stream>>>(ctl, act, Wd_t, b_down, y); break;
        case 8: nv_final<<<G, B, 0, stream>>>(ctl, x1, tok_e, tok_w, tok_p, y, norm_final_g, out); break;
        }
    }
}
```

```cpp
#include <hip/hip_runtime.h>
#include <stdint.h>
#include <stdio.h>

#ifndef Y_FP8
#define Y_FP8 1
#endif
#ifndef KROT
#define KROT 1
#endif
#ifndef MOE_ORDER
#define MOE_ORDER 0
#endif
#ifndef MOE_FP8
#define MOE_FP8 1
#endif
constexpr float W8_SCALE = 32.0f, W8_INV = 1.0f / 32.0f;
typedef unsigned short bf16_t;
typedef unsigned u32x4 __attribute__((ext_vector_type(4)));

constexpr int NB = 16, SEQ = 2048, NTOK = NB * SEQ, DM = 1024;
constexpr int NQH = 8, NKVH = 2, HD = 64, AW = 512, KVW = 128, LW = 512, LH = 8, LB = 64;
constexpr int INW = 3840, NE = 32, TOPK = 4, DE = 1024;
constexpr int CAP = NTOK;
constexpr int MAXTILES = NTOK * TOPK / 256 + NE;
constexpr int MAXROWS = MAXTILES * 256;

constexpr size_t MiB = 1u << 20;
constexpr size_t WS_CTL = 0, CTL_BYTES = 65536;
constexpr size_t WS_WRG = 1 * MiB;
constexpr size_t WS_WIG = WS_WRG + 65536;
constexpr size_t WS_WRT = WS_WRG + 131072;
constexpr size_t WS_TOKE = 2 * MiB;
constexpr size_t WS_TOKW = 2 * MiB + 512 * 1024;
constexpr size_t WS_TOKP = 3 * MiB;
constexpr size_t WS_SLOT = 4 * MiB;
constexpr size_t WS_LOGIT = 8 * MiB;
constexpr size_t WS_RSTD = 12 * MiB;
constexpr size_t WS_WIN = 16 * MiB;
constexpr size_t WS_WCAT = 24 * MiB;
constexpr size_t WS_WOUT = 26 * MiB;
constexpr size_t WS_WGU = 28 * MiB;
constexpr size_t WS_WD = 156 * MiB;
constexpr size_t WS_X1 = 220 * MiB;
constexpr size_t WS_H2 = 348 * MiB;
constexpr size_t WS_ACT = 412 * MiB;
constexpr size_t WS_Y = 684 * MiB;
constexpr size_t WS_H = 412 * MiB;
constexpr size_t WS_Q = 476 * MiB;
constexpr size_t WS_K = 508 * MiB;
constexpr size_t WS_V = 516 * MiB;
constexpr size_t WS_XR = 524 * MiB;
constexpr size_t WS_YG = 556 * MiB;
constexpr size_t WS_RATIO = 588 * MiB;
constexpr size_t WS_GLS = 652 * MiB;
constexpr size_t WS_AO = 716 * MiB;
constexpr size_t WS_MERGED = 780 * MiB;
constexpr size_t WS_XC = 844 * MiB;
constexpr size_t WS_END = 956 * MiB;
constexpr int CW_GCOUNT = 8192;

__device__ __forceinline__ float bf2f(bf16_t b) { return __uint_as_float(((unsigned)b) << 16); }
__device__ __forceinline__ bf16_t f2bf(float f) { return __builtin_bit_cast(unsigned short, (__bf16)f); }
__device__ __forceinline__ float sigmoidf_(float x) { return 1.0f / (1.0f + __expf(-x)); }
__device__ __forceinline__ float gelu_tanh(float x) { const float u = 0.7978845608028654f * (x + 0.044715f * x * x * x); return 0.5f * x * (1.0f + tanhf(u)); }

__host__ __device__ __forceinline__ int g1_orig(int g) {
    const int tile = g >> 8, w = g & 255, bj = w >> 7, wc = (w >> 5) & 3, j = w & 31;
    if (tile < 2) return tile * 256 + wc * 64 + bj * 32 + j;
    if (tile == 2) return wc < 2 ? 512 + wc * 64 + bj * 32 + j : 640 + (wc - 2) * 64 + bj * 32 + j;
    if (tile < 5) return 768 + (tile - 3) * 256 + w;
    if (tile < 7) return 1280 + (tile - 5) * 256 + w;
    const int t = tile - 7; return (bj ? 2816 : 1792) + 128 * t + (w & 127);
}
__host__ __device__ __forceinline__ int gu_orig(int g) { const int tile = g >> 8, w = g & 255, bj = w >> 7; return bj * 1024 + tile * 128 + (w & 127); }

__device__ __forceinline__ float dot_bf16(const bf16_t* a, const bf16_t* b, int K) {
    float s = 0.f;
    for (int k = 0; k < K; k += 8) {
        const u32x4 av = *(const u32x4*)(a + k), bv = *(const u32x4*)(b + k);
#pragma unroll
        for (int j = 0; j < 4; ++j) {
            s += __uint_as_float(av[j] << 16) * __uint_as_float(bv[j] << 16);
            s += __uint_as_float(av[j] & 0xffff0000u) * __uint_as_float(bv[j] & 0xffff0000u);
        }
    }
    return s;
}
__device__ __forceinline__ float wave_sum(float v) {
#pragma unroll
    for (int o = 1; o < 64; o <<= 1) v += __shfl_xor(v, o);
    return v;
}

#define GSTRIDE(i, n) for (size_t i = (size_t)blockIdx.x * blockDim.x + threadIdx.x; i < (size_t)(n); i += (size_t)gridDim.x * blockDim.x)

__global__ void __launch_bounds__(256) nv_transpose(const float* W, int K, int N, bf16_t* dst, int ldd, int koff, int Ng, int mode, int batch) {
    GSTRIDE(idx, (size_t)batch * Ng * K) {
        const int k = (int)(idx % K); const int g = (int)((idx / K) % Ng); const int b = (int)(idx / ((size_t)K * Ng));
        const int o = mode == 1 ? g1_orig(g) : mode == 2 ? gu_orig(g) : g;
        dst[(size_t)b * Ng * ldd + (size_t)g * ldd + koff + k] = f2bf(W[(size_t)b * K * N + (size_t)k * N + o]);
    }
}
__global__ void __launch_bounds__(256) nv_rmsnorm_bf16(const float* x, const float* g, bf16_t* out, float* rstd_out) {
    const int lane = threadIdx.x & 63; const int w = (blockIdx.x * blockDim.x + threadIdx.x) >> 6, nw = (gridDim.x * blockDim.x) >> 6;
    for (int m = w; m < NTOK; m += nw) {
        const float* xr = x + (size_t)m * DM; float v[16]; float s = 0.f;
#pragma unroll
        for (int j = 0; j < 16; ++j) { v[j] = xr[lane + 64 * j]; s += v[j] * v[j]; }
        const float r = rsqrtf(wave_sum(s) * (1.0f / DM) + 1e-6f);
#pragma unroll
        for (int j = 0; j < 16; ++j) out[(size_t)m * DM + lane + 64 * j] = f2bf(v[j] * r * g[lane + 64 * j]);
        if (rstd_out && lane == 0) rstd_out[m] = r;
    }
}
__device__ __forceinline__ void rope_cs(int pos, int j, float& c, float& s) {
    const float inv = exp2f(-(float)j * (13.287712379549449f / 32.0f));
    const double rev = (double)pos * (double)inv * 0.15915494309189535;
    const float fr = (float)(rev - floor(rev));
    s = __builtin_amdgcn_sinf(fr); c = __builtin_amdgcn_cosf(fr);
}
__global__ void __launch_bounds__(256) nv_gemm1(const bf16_t* h, const bf16_t* Wt, const int* positions, bf16_t* q, bf16_t* k, bf16_t* v, bf16_t* xr, bf16_t* yg, bf16_t* ratio, bf16_t* gls) {
    GSTRIDE(idx, (size_t)NTOK * 15 * 128) {
        const int r = (int)(idx % 128), tile = (int)((idx / 128) % 15), m = (int)(idx / (128 * 15));
        const int g0 = tile * 256 + r, g1 = g0 + 128;
        const float v0 = dot_bf16(h + (size_t)m * DM, Wt + (size_t)g0 * DM, DM), v1 = dot_bf16(h + (size_t)m * DM, Wt + (size_t)g1 * DM, DM);
        const int wc = r >> 5, j = r & 31;
        if (tile < 2 || (tile == 2 && wc < 2)) {
            float c, s; rope_cs(positions[m], j, c, s);
            const float o0 = v0 * c - v1 * s, o1 = v1 * c + v0 * s;
            if (tile < 2) { const int hq = tile * 4 + wc; q[(size_t)m * AW + hq * 64 + j] = f2bf(o0); q[(size_t)m * AW + hq * 64 + 32 + j] = f2bf(o1); }
            else { k[(size_t)m * KVW + wc * 64 + j] = f2bf(o0); k[(size_t)m * KVW + wc * 64 + 32 + j] = f2bf(o1); }
        } else if (tile == 2) { const int hv = wc - 2; v[(size_t)m * KVW + hv * 64 + j] = f2bf(v0); v[(size_t)m * KVW + hv * 64 + 32 + j] = f2bf(v1); }
        else if (tile < 5) { const int c0 = (tile - 3) * 256 + r; xr[(size_t)m * LW + c0] = f2bf(v0); xr[(size_t)m * LW + c0 + 128] = f2bf(v1); }
        else if (tile < 7) { const int c0 = (tile - 5) * 256 + r; yg[(size_t)m * LW + c0] = f2bf(gelu_tanh(v0)); yg[(size_t)m * LW + c0 + 128] = f2bf(gelu_tanh(v1)); }
        else { const int c0 = (tile - 7) * 128 + r; const float ea = __expf(-v0), eb = __expf(-v1);
            ratio[(size_t)m * DM + c0] = f2bf((1.0f + eb) / (1.0f + ea)); gls[(size_t)m * DM + c0] = f2bf(1.0f / (1.0f + eb)); }
    }
}
__global__ void __launch_bounds__(256) nv_attn(const bf16_t* q, const bf16_t* k, const bf16_t* v, const float* sinks, bf16_t* ao) {
    GSTRIDE(idx, (size_t)NTOK * NQH) {
        const int hq = (int)(idx % NQH), n = (int)(idx / NQH), s = n % SEQ, kvh = hq / 4;
        float qv[64], o[64];
#pragma unroll
        for (int d = 0; d < 64; ++d) { qv[d] = bf2f(q[(size_t)n * AW + hq * 64 + d]) * 0.125f; o[d] = 0.f; }
        const int lo = s - 127 > 0 ? s - 127 : 0; const float sink = sinks[hq];
        float mx = sink;
        for (int kp = lo; kp <= s; ++kp) { const bf16_t* kr = k + (size_t)(n - s + kp) * KVW + kvh * 64; float sc = 0.f;
#pragma unroll
            for (int d = 0; d < 64; ++d) sc += qv[d] * bf2f(kr[d]);
            mx = fmaxf(mx, sc); }
        float l = __expf(sink - mx);
        for (int kp = lo; kp <= s; ++kp) { const bf16_t* kr = k + (size_t)(n - s + kp) * KVW + kvh * 64; const bf16_t* vr = v + (size_t)(n - s + kp) * KVW + kvh * 64; float sc = 0.f;
#pragma unroll
            for (int d = 0; d < 64; ++d) sc += qv[d] * bf2f(kr[d]);
            const float p = __expf(sc - mx); l += p;
#pragma unroll
            for (int d = 0; d < 64; ++d) o[d] += p * bf2f(vr[d]); }
        const float il = 1.0f / l;
#pragma unroll
        for (int d = 0; d < 64; ++d) ao[(size_t)n * DM + hq * 64 + d] = f2bf(o[d] * il);
    }
}
__global__ void __launch_bounds__(256) nv_conv(const bf16_t* xr, const float* cw, const float* cb, float* xc) {
    GSTRIDE(idx, (size_t)NTOK * LW) {
        const int C = (int)(idx % LW), n = (int)(idx / LW), s = n % SEQ; float a = cb[C];
#pragma unroll
        for (int j = 0; j < 4; ++j) { const int ss = s - 3 + j; if (ss >= 0) a += bf2f(xr[(size_t)(n - 3 + j) * LW + C]) * cw[j * LW + C]; }
        xc[idx] = a;
    }
}
__global__ void __launch_bounds__(256) nv_scan(const float* xc, const float* w_rg, const float* b_rg, const float* w_ig, const float* b_ig, const float* lam, const bf16_t* yg, bf16_t* ao) {
    GSTRIDE(idx, (size_t)NB * LW) {
        const int C = (int)(idx % LW), b = (int)(idx / LW), hh = C / 64, cc = C % 64;
        const float sp = log1pf(__expf(-lam[C])); float hs = 0.f;
        for (int t = 0; t < SEQ; ++t) {
            const size_t n = (size_t)b * SEQ + t; const float* xrow = xc + n * LW + hh * 64; float rg = b_rg[C], ig = b_ig[C];
            for (int c = 0; c < 64; ++c) { const float x = xrow[c]; rg += x * w_rg[(hh * 64 + c) * 64 + cc]; ig += x * w_ig[(hh * 64 + c) * 64 + cc]; }
            const float r = sigmoidf_(rg), i = sigmoidf_(ig), la = -8.0f * r * sp, a = __expf(la), u = sqrtf(-expm1f(2.0f * la)) * (i * xrow[cc]);
            hs = a * hs + u;
            ao[n * DM + 512 + C] = f2bf(hs * bf2f(yg[n * LW + C]));
        }
    }
}
__global__ void __launch_bounds__(256) nv_merged(const bf16_t* ao, const bf16_t* Wcat, const bf16_t* ratio, const bf16_t* gls, bf16_t* merged) {
    GSTRIDE(idx, (size_t)NTOK * DM) {
        const int n = (int)(idx % DM), m = (int)(idx / DM);
        const float ya = dot_bf16(ao + (size_t)m * DM, Wcat + (size_t)n * DM, 512), yl = dot_bf16(ao + (size_t)m * DM + 512, Wcat + (size_t)n * DM + 512, 512);
        merged[idx] = f2bf((ya * bf2f(ratio[idx]) + yl) * bf2f(gls[idx]));
    }
}
__global__ void __launch_bounds__(256) nv_wout(const bf16_t* merged, const bf16_t* Wout, const float* x, float* x1) {
    GSTRIDE(idx, (size_t)NTOK * DM) {
        const int n = (int)(idx % DM), m = (int)(idx / DM);
        x1[idx] = x[idx] + dot_bf16(merged + (size_t)m * DM, Wout + (size_t)n * DM, DM);
    }
}
__global__ void __launch_bounds__(256) nv_logits(const float* x1, const float* rstd, const float* g, const float* Wr, const float* br, float* logits) {
    GSTRIDE(idx, (size_t)NTOK * NE) {
        const int e = (int)(idx % NE), m = (int)(idx / NE); const float r = rstd[m]; float s = 0.f;
        for (int k = 0; k < DM; ++k) s += (x1[(size_t)m * DM + k] * r * g[k]) * Wr[k * NE + e];
        logits[idx] = s + br[e];
    }
}
__global__ void __launch_bounds__(256) nv_topk(const float* logits, unsigned* ctl, int* tok_e, float* tok_w, int* tok_p, int* slot_tok) {
    GSTRIDE(idx, (size_t)NTOK) {
        const float* lg = logits + idx * NE; unsigned used = 0; float tv[4]; int te[4];
#pragma unroll
        for (int kk = 0; kk < 4; ++kk) { float best = -3.0e38f; int bi = 0;
            for (int e = 0; e < NE; ++e) { const float vv = lg[e]; if (!((used >> e) & 1u) && vv > best) { best = vv; bi = e; } }
            used |= 1u << bi; tv[kk] = best; te[kk] = bi; }
        float ex[4], sum = 0.f;
#pragma unroll
        for (int kk = 0; kk < 4; ++kk) { ex[kk] = __expf(tv[kk] - tv[0]); sum += ex[kk]; }
#pragma unroll
        for (int kk = 0; kk < 4; ++kk) { const int e = te[kk]; const unsigned p = atomicAdd(&ctl[CW_GCOUNT + 64 * e], 1u);
            tok_e[idx * 4 + kk] = e; tok_w[idx * 4 + kk] = ex[kk] / sum; tok_p[idx * 4 + kk] = (int)p; slot_tok[(size_t)e * CAP + p] = (int)idx; }
    }
}
__device__ __forceinline__ bool row_lookup(const unsigned* ctl, int row, int& e, int& pos, int& cnt) {
    int base = 0;
    for (int ee = 0; ee < NE; ++ee) { const int c = (int)ctl[CW_GCOUNT + 64 * ee]; const int pr = ((c + 255) >> 8) << 8; if (row < base + pr) { e = ee; pos = row - base; cnt = c; return true; } base += pr; }
    return false;
}
__global__ void __launch_bounds__(256) nv_moe1(const unsigned* ctl, const int* slot_tok, const bf16_t* h2, const bf16_t* Wgu, const float* bgu, bf16_t* act) {
    GSTRIDE(idx, (size_t)MAXROWS * DE) {
        const int j = (int)(idx % DE), row = (int)(idx / DE); int e, pos, cnt;
        if (!row_lookup(ctl, row, e, pos, cnt)) continue;
        const int tok = pos < cnt ? slot_tok[(size_t)e * CAP + pos] : 0;
        const int tile = j >> 7, r = j & 127, gg = tile * 256 + r, gu = gg + 128;
        float g = dot_bf16(h2 + (size_t)tok * DM, Wgu + ((size_t)e * 2048 + gg) * DM, DM) + bgu[e * 2048 + j];
        float u = dot_bf16(h2 + (size_t)tok * DM, Wgu + ((size_t)e * 2048 + gu) * DM, DM) + bgu[e * 2048 + 1024 + j];
        g = fminf(g, 7.0f); u = fminf(fmaxf(u, -7.0f), 7.0f);
        act[idx] = f2bf((u + 1.0f) * (g * sigmoidf_(1.702f * g)));
    }
}
__global__ void __launch_bounds__(256) nv_moe2(const unsigned* ctl, const bf16_t* act, const bf16_t* Wd, const float* bd, bf16_t* y) {
    GSTRIDE(idx, (size_t)MAXROWS * DM) {
        const int n = (int)(idx % DM), row = (int)(idx / DM); int e, pos, cnt;
        if (!row_lookup(ctl, row, e, pos, cnt)) continue;
        y[idx] = f2bf(dot_bf16(act + (size_t)row * DE, Wd + ((size_t)e * DM + n) * DE, DE) + bd[e * DM + n]);
    }
}
__global__ void __launch_bounds__(256) nv_final(const unsigned* ctl, const float* x1, const int* tok_e, const float* tok_w, const int* tok_p, const bf16_t* y, const float* g, float* out) {
    const int lane = threadIdx.x & 63; const int w = (blockIdx.x * blockDim.x + threadIdx.x) >> 6, nw = (gridDim.x * blockDim.x) >> 6;
    for (int m = w; m < NTOK; m += nw) {
        int yrow[4]; float ww[4];
#pragma unroll
        for (int kk = 0; kk < 4; ++kk) { const int e = tok_e[m * 4 + kk]; int base = 0; for (int ee = 0; ee < e; ++ee) base += (((int)ctl[CW_GCOUNT + 64 * ee] + 255) >> 8) << 8; yrow[kk] = base + tok_p[m * 4 + kk]; ww[kk] = tok_w[m * 4 + kk]; }
        float v[16]; float s = 0.f;
#pragma unroll
        for (int j = 0; j < 16; ++j) { const int c = lane + 64 * j; float a = x1[(size_t)m * DM + c];
#pragma unroll
            for (int kk = 0; kk < 4; ++kk) a += ww[kk] * bf2f(y[(size_t)yrow[kk] * DM + c]);
            v[j] = a; s += a * a; }
        const float r = rsqrtf(wave_sum(s) * (1.0f / DM) + 1e-6f);
#pragma unroll
        for (int j = 0; j < 16; ++j) out[(size_t)m * DM + lane + 64 * j] = v[j] * r * g[lane + 64 * j];
    }
}

#define LAS __attribute__((address_space(3)))
typedef short bf16x8 __attribute__((ext_vector_type(8)));
typedef short s16x4 __attribute__((ext_vector_type(4)));
typedef float f32x4 __attribute__((ext_vector_type(4)));
typedef float f32x16 __attribute__((ext_vector_type(16)));
typedef int i32x4 __attribute__((ext_vector_type(4)));
constexpr int NWAVES = 8;
constexpr int RING_BYTES = 131072, MISC_OFF = 147456, LDS_BYTES = 163840;
constexpr int MW_Q = 16, MW_TS = 32, MW_CNT = 72, MW_P5 = 128, MW_TE = 3072;
constexpr int CW_BAR = 4096, CW_QUEUE = 12288;

__device__ __forceinline__ unsigned cvt_pk_bf16(float lo, float hi) { unsigned r; asm volatile("v_cvt_pk_bf16_f32 %0, %1, %2" : "=v"(r) : "v"(lo), "v"(hi)); return r; }
__device__ __forceinline__ unsigned pk4_fp8(float a, float b, float c, float d) { int p = __builtin_amdgcn_cvt_pk_fp8_f32(a, b, 0, false); p = __builtin_amdgcn_cvt_pk_fp8_f32(c, d, p, true); return (unsigned)p; }
__device__ __forceinline__ float clamp448(float x) { return fminf(fmaxf(x, -448.0f), 448.0f); }
__device__ __forceinline__ float fsig(float x) { return __builtin_amdgcn_rcpf(1.0f + __builtin_amdgcn_exp2f(-1.4426950408889634f * x)); }
__device__ __forceinline__ int crow(int r, int hi) { return (r & 3) + 8 * (r >> 2) + 4 * hi; }
__device__ __forceinline__ void unpack8(const u32x4 w, float (&f)[8]) {
#pragma unroll
    for (int j = 0; j < 4; ++j) { f[2 * j] = __uint_as_float(w[j] << 16); f[2 * j + 1] = __uint_as_float(w[j] & 0xffff0000u); }
}
__host__ __device__ __forceinline__ int g1_inv(int o) {
    if (o < 512) { const int head = o >> 6, d = o & 63; return (head >> 2) * 256 + (d >> 5) * 128 + (head & 3) * 32 + (d & 31); }
    if (o < 640) { const int hk = (o - 512) >> 6, d = o & 63; return 512 + (d >> 5) * 128 + hk * 32 + (d & 31); }
    if (o < 768) { const int hv = (o - 640) >> 6, d = o & 63; return 512 + (d >> 5) * 128 + (2 + hv) * 32 + (d & 31); }
    if (o < 1792) return o;
    if (o < 2816) { const int c = o - 1792; return (7 + (c >> 7)) * 256 + (c & 127); }
    const int c = o - 2816; return (7 + (c >> 7)) * 256 + 128 + (c & 127);
}
__host__ __device__ __forceinline__ int y16_inv(int o) { const int r = o & 255; return (o & ~255) + ((r >> 3) & 1) * 128 + (r >> 6) * 32 + ((r >> 4) & 3) * 8 + (r & 7); }
__host__ __device__ __forceinline__ int gu_inv(int o) { const int bj = o >> 10, c = o & 1023; return (c >> 7) * 256 + bj * 128 + (c & 127); }

#define XB_TMO      128
#define XB_XCNT(j)  (256  + 64 * (j))
#define XB_XSUB(j)  (1280 + 64 * (j))
#define XB_XGEN(j)  (2304 + 64 * (j))
#define XB_TOP      3328
#define XB_TOPGEN   3392
#define XCD_BAR_WORDS 3456
#define XB_SPIN_CAP (1u << 18)
__device__ __forceinline__ unsigned xb_ld(unsigned* p)              { return __hip_atomic_load(p, __ATOMIC_RELAXED, __HIP_MEMORY_SCOPE_AGENT); }
__device__ __forceinline__ unsigned xb_add(unsigned* p, unsigned v) { return __hip_atomic_fetch_add(p, v, __ATOMIC_RELAXED, __HIP_MEMORY_SCOPE_AGENT); }
__device__ __forceinline__ unsigned xb_xcc_id() { return (unsigned)__builtin_amdgcn_s_getreg((3 << 11) | 20) & 0xFu; }
#define XB_SPIN(cond, bar) do { unsigned _sp = 0; while (cond) { __builtin_amdgcn_s_sleep(1); \
    if ((++_sp & 255u) == 0u) { if (xb_ld(&(bar)[XB_TMO])) break; if (_sp > XB_SPIN_CAP) { atomicAdd(&(bar)[XB_TMO], 1u); break; } } } } while (0)
struct XcdBarrier { unsigned* bar; unsigned x; volatile LAS unsigned* st; };
__device__ __forceinline__ XcdBarrier xcd_barrier_post(unsigned* bar, volatile LAS unsigned* st) {
    XcdBarrier b; b.bar = bar; b.x = xb_xcc_id(); b.st = st;
    if (threadIdx.x == 0) (void)xb_add(&bar[XB_XCNT(b.x)], 1u);
    return b;
}
__device__ __forceinline__ void xcd_barrier_complete(unsigned* bar, unsigned x, unsigned& nloc, unsigned& nx) {
    const unsigned G = gridDim.x * gridDim.y * gridDim.z;
    unsigned sum, cnt, mine, sp = 0u;
    for (;;) {
        sum = 0u; cnt = 0u; mine = 0u;
#pragma unroll
        for (unsigned j = 0; j < 16; ++j) { const unsigned c = xb_ld(&bar[XB_XCNT(j)]); sum += c; cnt += (c > 0u) ? 1u : 0u; mine = (j == x) ? c : mine; }
        if (sum == G) break;
        __builtin_amdgcn_s_sleep(1);
        if ((++sp & 255u) == 0u) { if (xb_ld(&bar[XB_TMO])) break; if (sp > XB_SPIN_CAP) { atomicAdd(&bar[XB_TMO], 1u); break; } }
    }
    nloc = mine > 0u ? mine : 1u; nx = cnt > 0u ? cnt : 1u;
}
__device__ __forceinline__ void xcd_barrier(const XcdBarrier& b) {
    asm volatile("s_waitcnt vmcnt(0)" ::: "memory");
    __syncthreads();
    if (threadIdx.x == 0) {
        unsigned* bar = b.bar;
        __builtin_amdgcn_s_waitcnt(0);
        unsigned nloc = b.st[0], nx = b.st[1];
        if (nloc == 0u) { xcd_barrier_complete(bar, b.x, nloc, nx); b.st[0] = nloc; b.st[1] = nx; }
        const unsigned old = xb_add(&bar[XB_XSUB(b.x)], 1u);
        const unsigned gen = old / nloc;
        if (old + 1u == (gen + 1u) * nloc) {
            __builtin_amdgcn_fence(__ATOMIC_RELEASE, "agent");
            asm volatile("s_waitcnt vmcnt(0)" ::: "memory");
            const unsigned og = xb_add(&bar[XB_TOP], 1u);
            const unsigned tg = og / nx;
            if (og + 1u == (tg + 1u) * nx) xb_add(&bar[XB_TOPGEN], 1u);
            else XB_SPIN(xb_ld(&bar[XB_TOPGEN]) == tg, bar);
            __builtin_amdgcn_fence(__ATOMIC_ACQUIRE, "agent");
            xb_add(&bar[XB_XGEN(b.x)], 1u);
            asm volatile("s_waitcnt vmcnt(0)" ::: "memory");
        } else {
            XB_SPIN(xb_ld(&bar[XB_XGEN(b.x)]) == gen, bar);
            __builtin_amdgcn_fence(__ATOMIC_ACQUIRE, "agent");
            asm volatile("s_waitcnt vmcnt(0)" ::: "memory");
        }
    }
    __syncthreads();
}

namespace pg8 {
constexpr int BM = 256, BK = 64, HALF = 128, HTB = HALF * BK * 2, STAGE_BYTES = 8 * HTB, NXCD = 8, WGM = 8, KK = 1024, NT = KK / BK;
__host__ __device__ __forceinline__ int lds_byte(int r, int c) { const int st = (r >> 4) * 2 + (c >> 5), rr = r & 15, cc = c & 31, ob = rr * 64 + cc * 2; return st * 1024 + (ob ^ (((ob >> 9) & 1) << 5)); }
__host__ __device__ __forceinline__ void stage_rc(int b, int& R, int& C) { const int st = b / 1024, sb = b % 1024, swz = sb ^ (((sb >> 9) & 1) << 5); R = (st >> 1) * 16 + swz / 64; C = (st & 1) * 32 + (swz % 64) / 2; }
__host__ __device__ __forceinline__ int perm32(int rho) { const int n = rho >> 4, i = rho & 15; return 8 * (i >> 2) + 4 * n + (i & 3); }
struct Unit { int pm, pn, e, nvalid; };
constexpr unsigned KSTEP = BK * 2;

struct DenseSched {
    const bf16_t* A; const bf16_t* Bt; int nM, nN, nwg, G, c, it;
    __device__ void init(const bf16_t* A_, const bf16_t* Bt_, int M, int N, int G_, int c_) { A = A_; Bt = Bt_; nM = M / BM; nN = N / BM; nwg = nM * nN; G = G_; c = c_; it = 0; }
    __device__ __forceinline__ bool next(Unit& u) {
        const long L = (long)it * G + c; ++it; if (L >= nwg) return false;
        int wgid = (int)L; { const int q = nwg / NXCD, r = nwg % NXCD, xcd = wgid % NXCD, off = wgid / NXCD; wgid = (xcd < r ? xcd * (q + 1) : r * (q + 1) + (xcd - r) * q) + off; }
        const int nig = WGM * nN, gid = wgid / nig, fm = gid * WGM, gsz = (nM - fm) < WGM ? (nM - fm) : WGM;
        u.pm = fm + ((wgid % nig) % gsz); u.pn = (wgid % nig) / gsz; u.e = 0; u.nvalid = 256; return true;
    }
    __device__ __forceinline__ int rot(const Unit& u) const { return u.pm + u.pn; }
    __device__ __forceinline__ unsigned a_base(const Unit& u) const { return (unsigned)u.pm * (unsigned)(BM * KK * 2); }
    __device__ __forceinline__ unsigned b_base(const Unit& u) const { return (unsigned)u.pn * (unsigned)(BM * KK * 2); }
    __device__ __forceinline__ void a_rows(const Unit&, const int (&R)[2], int (&rows)[2][2]) const {
#pragma unroll
        for (int h = 0; h < 2; ++h)
#pragma unroll
            for (int i = 0; i < 2; ++i) rows[h][i] = R[i] + HALF * h;
    }
};
template <bool GATHER, int EB> struct MoeSched {
    const void* A; const void* Bt; const int* slot_tok; const volatile LAS int* ts; const volatile LAS int* cnt; int NPN, ntiles, Lmax, G, c, it;
    __device__ void init(const void* A_, const void* Bt_, const int* slot_tok_, const volatile LAS int* ts_, const volatile LAS int* cnt_, int NPN_, int G_, int c_) {
        A = A_; Bt = Bt_; slot_tok = slot_tok_; ts = ts_; cnt = cnt_; NPN = NPN_; G = G_; c = c_; it = 0; ntiles = __builtin_amdgcn_readfirstlane(ts[NE]); Lmax = ((ntiles + 7) / 8) * 8 * NPN; }
    __device__ __forceinline__ bool next(Unit& u) {
        for (;;) {
#if MOE_ORDER == 1
            const int U = ntiles * NPN, per = (U + G - 1) / G, uu = c * per + it; ++it; if (it > per || uu >= U) return false;
            const int m = uu / NPN, j = uu;
#elif MOE_ORDER == 2
            const int x = c & 7, nper = G >> 3; int lin = it * nper + (c >> 3); ++it;
            int m = -1, j = 0;
            for (int k = 0; k < NE / 8; ++k) { const int e2 = x + 8 * k, t0 = __builtin_amdgcn_readfirstlane(ts[e2]), nt2 = __builtin_amdgcn_readfirstlane(ts[e2 + 1]) - t0, nu = nt2 * NPN;
                if (m < 0) { if (lin < nu) { m = t0 + lin / NPN; j = lin % NPN; } else lin -= nu; } }
            if (m < 0) return false;
#else
            const int L = it * G + c; ++it; if (L >= Lmax) return false;
            const int xcd = L & 7, j = L >> 3, m = (j / NPN) * 8 + xcd; if (m >= ntiles) continue;
#endif
            const int e = __builtin_amdgcn_readfirstlane(ts[MW_TE - MW_TS + m]);
            u.pm = m; u.pn = j % NPN; u.e = e; u.nvalid = __builtin_amdgcn_readfirstlane(cnt[e]) - 256 * (m - __builtin_amdgcn_readfirstlane(ts[e])); return true;
        }
    }
    __device__ __forceinline__ int rot(const Unit& u) const { return (u.pm >> 3) + u.pn; }
    __device__ __forceinline__ unsigned a_base(const Unit& u) const { return GATHER ? 0u : (unsigned)u.pm * (unsigned)(BM * KK * EB); }
    __device__ __forceinline__ unsigned b_base(const Unit& u) const { return (unsigned)(u.e * NPN + u.pn) * (unsigned)(BM * KK * EB); }
    __device__ __forceinline__ void a_rows(const Unit& u, const int (&R)[2], int (&rows)[2][2]) const {
#pragma unroll
        for (int h = 0; h < 2; ++h)
#pragma unroll
            for (int i = 0; i < 2; ++i) {
                const int r = R[i] + HALF * h;
                if (GATHER) { const int last = u.nvalid - 1; rows[h][i] = slot_tok[(size_t)u.e * CAP + 256 * (u.pm - __builtin_amdgcn_readfirstlane(ts[u.e])) + (r < last ? r : last)]; }
                else rows[h][i] = r;
            }
    }
};

template <class Epi, class Sched, bool ALIGN_EPI, int EB, int KREP = 1>
__device__ __forceinline__ void gemm_phase(LAS unsigned char* lds, Sched& S, const Epi& E) {
    constexpr int PITCH = KK * EB, NTL = PITCH / 128; constexpr unsigned HSTEP = (unsigned)HALF * PITCH;
    const __amdgpu_buffer_rsrc_t rsrcA = __builtin_amdgcn_make_buffer_rsrc((void*)S.A, 0, 0xFFFFFFFF, 0x00020000), rsrcB = __builtin_amdgcn_make_buffer_rsrc((void*)S.Bt, 0, 0xFFFFFFFF, 0x00020000);
    typedef int v8i_t __attribute__((ext_vector_type(8)));
    const int tid = threadIdx.x, wid = __builtin_amdgcn_readfirstlane(tid >> 6), lane = tid & 63, wr = wid >> 2, wc = wid & 3, fr = lane & 15, fq = lane >> 4;
    unsigned voffB[2];
#pragma unroll
    for (int i = 0; i < 2; ++i) { int R, C; stage_rc(tid * 16 + i * 8192, R, C); const int Rb = Epi::PERM ? ((R & ~31) + perm32(R & 31)) : R; voffB[i] = (unsigned)(Rb * PITCH + C * 2); }
    const unsigned ldsw = (unsigned)wid * 1024u;
    const int aoff = lds_byte(wr * 64 + fr, fq * 8), boff = lds_byte(wc * 32 + fr, fq * 8);
#define PG8_SA(b, h) (((b) * 2 + (h)) * HTB)
#define PG8_SB(b, h) ((4 + (b) * 2 + (h)) * HTB)
#define PG8_STAGEA(bufoff, soff, voff) do { _Pragma("unroll") for (int _i = 0; _i < 2; ++_i) \
        __builtin_amdgcn_raw_ptr_buffer_load_lds(rsrcA, (LAS void*)(lds + (bufoff) + ldsw + _i * 8192), 16, (voff)[_i], (soff), 0, 0); } while (0)
#define PG8_STAGEB(bufoff, soff, voff) do { _Pragma("unroll") for (int _i = 0; _i < 2; ++_i) \
        __builtin_amdgcn_raw_ptr_buffer_load_lds(rsrcB, (LAS void*)(lds + (bufoff) + ldsw + _i * 8192), 16, (voff)[_i], (soff), 0, 0); } while (0)
#define PG8_LDA(dst, b, h) do { _Pragma("unroll") for (int m = 0; m < 4; ++m) _Pragma("unroll") for (int k = 0; k < 2; ++k) dst[m][k] = *(const LAS bf16x8*)(lds + PG8_SA(b, h) + aoff + m * 2048 + k * 1024); } while (0)
#define PG8_LDB(dst, b, h) do { _Pragma("unroll") for (int n = 0; n < 2; ++n) _Pragma("unroll") for (int k = 0; k < 2; ++k) dst[n][k] = *(const LAS bf16x8*)(lds + PG8_SB(b, h) + boff + n * 2048 + k * 1024); } while (0)
#define PG8_MMA(ai, bj, At, Bt) do { __builtin_amdgcn_s_setprio(1); _Pragma("unroll") for (int m = 0; m < 4; ++m) _Pragma("unroll") for (int n = 0; n < 2; ++n) { \
        if constexpr (EB == 2) { _Pragma("unroll") for (int k = 0; k < 2; ++k) acc[ai][bj][m][n] = __builtin_amdgcn_mfma_f32_16x16x32_bf16(Bt[n][k], At[m][k], acc[ai][bj][m][n], 0, 0, 0); } \
        else { const v8i_t b8 = __builtin_shufflevector(__builtin_bit_cast(i32x4, Bt[n][0]), __builtin_bit_cast(i32x4, Bt[n][1]), 0, 1, 2, 3, 4, 5, 6, 7); \
               const v8i_t a8 = __builtin_shufflevector(__builtin_bit_cast(i32x4, At[m][0]), __builtin_bit_cast(i32x4, At[m][1]), 0, 1, 2, 3, 4, 5, 6, 7); \
               asm volatile("v_mfma_f32_16x16x128_f8f6f4 %0, %1, %2, %0" : "+v"(acc[ai][bj][m][n]) : "v"(b8), "v"(a8)); } } \
        __builtin_amdgcn_s_setprio(0); } while (0)
#define PG8_WAIT_V(n) asm volatile("s_waitcnt vmcnt(" #n ")" ::: "memory")
#define PG8_WAIT_L(n) asm volatile("s_waitcnt lgkmcnt(" #n ")" ::: "memory")
#define PG8_BAR __builtin_amdgcn_s_barrier()
#define PG8_SCHED __builtin_amdgcn_sched_barrier(0)
    Unit cur, nxt;
    if (!S.next(cur)) return;
    f32x4 acc[2][2][4][2];
#pragma unroll
    for (int a = 0; a < 2; ++a)
#pragma unroll
        for (int b = 0; b < 2; ++b)
#pragma unroll
            for (int m = 0; m < 4; ++m)
#pragma unroll
                for (int n = 0; n < 2; ++n) acc[a][b][m][n] = (f32x4){0.f, 0.f, 0.f, 0.f};
    bf16x8 At[4][2], B0[2][2], B1[2][2];
    unsigned vA[2][2], vN[2][2]; typename Epi::Pre pre;
#define PG8_AOFF(u, v) do { int _R[2], _C[2]; _Pragma("unroll") for (int _i = 0; _i < 2; ++_i) stage_rc(tid * 16 + _i * 8192, _R[_i], _C[_i]); int _rows[2][2]; S.a_rows(u, _R, _rows); \
        _Pragma("unroll") for (int _h = 0; _h < 2; ++_h) _Pragma("unroll") for (int _i = 0; _i < 2; ++_i) v[_h][_i] = (unsigned)(_rows[_h][_i] * PITCH + _C[_i] * 2); } while (0)
    PG8_AOFF(cur, vA);
    unsigned cA = S.a_base(cur), cB = S.b_base(cur);
#define PG8_ROT(u) ((KROT && !Epi::HAS_MID) ? (S.rot(u) & (NTL - 1)) : 0)
#define PG8_KO(i, rot) ((unsigned)(((i) + (rot)) & (NTL - 1)) * KSTEP)
    int rotc = PG8_ROT(cur), rotn = 0;
    PG8_STAGEB(PG8_SB(0, 0), cB + PG8_KO(0, rotc), voffB); PG8_STAGEB(PG8_SB(0, 1), cB + HSTEP + PG8_KO(0, rotc), voffB); PG8_STAGEA(PG8_SA(0, 0), cA + PG8_KO(0, rotc), vA[0]); PG8_STAGEA(PG8_SA(0, 1), cA + PG8_KO(0, rotc), vA[1]);
    if (wr == 1) PG8_BAR;
    PG8_WAIT_V(2); PG8_BAR;
    PG8_STAGEB(PG8_SB(1, 0), cB + PG8_KO(1, rotc), voffB); PG8_STAGEA(PG8_SA(1, 0), cA + PG8_KO(1, rotc), vA[0]); PG8_STAGEB(PG8_SB(1, 1), cB + HSTEP + PG8_KO(1, rotc), voffB);
    PG8_WAIT_V(6); PG8_BAR;
    int krep = 0;
    for (;;) {
        bool has_next;
        if (KREP > 1 && krep + 1 < KREP) { has_next = true; nxt = cur; } else has_next = S.next(nxt);
        const unsigned nA = has_next ? S.a_base(nxt) : cA, nB = has_next ? S.b_base(nxt) : cB;
        rotn = has_next ? PG8_ROT(nxt) : rotc;
        if (has_next) PG8_AOFF(nxt, vN);
        else {
#pragma unroll
            for (int h = 0; h < 2; ++h)
#pragma unroll
                for (int i = 0; i < 2; ++i) vN[h][i] = vA[h][i];
        }
#pragma unroll 1
        for (int t = 0; t < NTL; t += 2) {
            const bool last = (t == NTL - 2);
            const unsigned a1 = cA + PG8_KO(t + 1, rotc);
            const unsigned a2 = last ? nA + PG8_KO(0, rotn) : cA + PG8_KO(t + 2, rotc), b2 = last ? nB + PG8_KO(0, rotn) : cB + PG8_KO(t + 2, rotc);
            const unsigned a3 = last ? nA + PG8_KO(1, rotn) : cA + PG8_KO(t + 3, rotc), b3 = last ? nB + PG8_KO(1, rotn) : cB + PG8_KO(t + 3, rotc);
            unsigned v2[2][2];
#pragma unroll
            for (int h = 0; h < 2; ++h)
#pragma unroll
                for (int i = 0; i < 2; ++i) v2[h][i] = last ? vN[h][i] : vA[h][i];
            if constexpr (Epi::HAS_MID) { if (t == NTL / 2) E.mid(acc, cur, wr, wc, fr, fq); }
            if (last) pre = E.load_pre(cur, wr, wc, fr, fq);
            PG8_LDB(B0, 0, 0); PG8_LDB(B1, 0, 1); PG8_SCHED; PG8_LDA(At, 0, 0); PG8_STAGEA(PG8_SA(1, 1), a1, vA[1]);
            PG8_WAIT_V(8); PG8_WAIT_L(0); PG8_BAR; PG8_MMA(0, 0, At, B0); PG8_MMA(0, 1, At, B1); PG8_BAR; PG8_SCHED;
            PG8_LDA(At, 0, 1); PG8_STAGEB(PG8_SB(0, 0), b2, voffB); PG8_STAGEB(PG8_SB(0, 1), b2 + HSTEP, voffB); PG8_STAGEA(PG8_SA(0, 0), a2, v2[0]);
            PG8_WAIT_V(8); PG8_WAIT_L(0); PG8_BAR; PG8_MMA(1, 0, At, B0); PG8_MMA(1, 1, At, B1); PG8_BAR; PG8_SCHED;
            PG8_LDB(B0, 1, 0); PG8_LDB(B1, 1, 1); PG8_SCHED; PG8_LDA(At, 1, 0); PG8_STAGEA(PG8_SA(0, 1), a2, v2[1]);
            PG8_WAIT_V(8); PG8_WAIT_L(0); PG8_BAR; PG8_MMA(0, 0, At, B0); PG8_MMA(0, 1, At, B1); PG8_BAR; PG8_SCHED;
            PG8_LDA(At, 1, 1); PG8_STAGEB(PG8_SB(1, 0), b3, voffB); PG8_STAGEB(PG8_SB(1, 1), b3 + HSTEP, voffB); PG8_STAGEA(PG8_SA(1, 0), a3, v2[0]);
            PG8_WAIT_V(8); PG8_WAIT_L(0); PG8_BAR; PG8_MMA(1, 0, At, B0); PG8_MMA(1, 1, At, B1); PG8_BAR; PG8_SCHED;
        }
        if (KREP > 1 && ++krep < KREP) { cur = nxt; cA = nA; cB = nB; continue; }
        krep = 0;
        if constexpr (ALIGN_EPI) { if (wr == 0) PG8_BAR; }
        if constexpr (EB == 1) asm volatile("s_nop 15\n\ts_nop 15" ::: "memory");
        E(acc, cur, wr, wc, fr, fq, pre);
        if (!has_next) break;
#pragma unroll
        for (int a = 0; a < 2; ++a)
#pragma unroll
            for (int b = 0; b < 2; ++b)
#pragma unroll
                for (int m = 0; m < 4; ++m)
#pragma unroll
                    for (int n = 0; n < 2; ++n) acc[a][b][m][n] = (f32x4){0.f, 0.f, 0.f, 0.f};
        cur = nxt; cA = nA; cB = nB; rotc = rotn;
#pragma unroll
        for (int h = 0; h < 2; ++h)
#pragma unroll
            for (int i = 0; i < 2; ++i) vA[h][i] = vN[h][i];
        if constexpr (ALIGN_EPI) { if (wr == 1) PG8_BAR; }
    }
    PG8_WAIT_V(0);
    if constexpr (!ALIGN_EPI) { if (wr == 0) PG8_BAR; }
    PG8_BAR;
#undef PG8_AOFF
#undef PG8_ROT
#undef PG8_KO
#undef PG8_SA
#undef PG8_SB
#undef PG8_STAGEA
#undef PG8_STAGEB
#undef PG8_LDA
#undef PG8_LDB
#undef PG8_MMA
#undef PG8_WAIT_V
#undef PG8_WAIT_L
#undef PG8_BAR
#undef PG8_SCHED
}

struct EpiG1 {
    static constexpr bool PERM = true, HAS_MID = false;
    struct Pre {}; __device__ __forceinline__ Pre load_pre(const Unit&, int, int, int, int) const { return Pre{}; }
    const int* pos; bf16_t *q, *k, *v, *xr, *yg, *ratio, *gls;
    __device__ __forceinline__ void mid(f32x4 (&)[2][2][4][2], const Unit&, int, int, int, int) const {}
    __device__ __forceinline__ void operator()(const f32x4 (&acc)[2][2][4][2], const Unit& u, int wr, int wc, int fr, int fq, const Pre& pre) const {
        const int row0 = u.pm * BM + wr * 64 + fr, j0 = 8 * fq, pn = u.pn;
        const bool rope = (pn < 2) || (pn == 2 && wc < 2);
        typedef float f2 __attribute__((ext_vector_type(2)));
        f2 invf[4];
#pragma unroll
        for (int e = 0; e < 4; ++e) { invf[e].x = exp2f(-(float)(j0 + 2 * e) * (13.287712379549449f / 32.0f)) * 0.15915494309189535f; invf[e].y = exp2f(-(float)(j0 + 2 * e + 1) * (13.287712379549449f / 32.0f)) * 0.15915494309189535f; }
#pragma unroll
        for (int ai = 0; ai < 2; ++ai)
#pragma unroll
            for (int m = 0; m < 4; ++m) {
                const int row = row0 + ai * HALF + m * 16;
                f2 lo[4], hi[4];
#pragma unroll
                for (int e = 0; e < 2; ++e) { lo[e] = (f2){acc[ai][0][m][0][2 * e], acc[ai][0][m][0][2 * e + 1]}; lo[2 + e] = (f2){acc[ai][0][m][1][2 * e], acc[ai][0][m][1][2 * e + 1]};
                    hi[e] = (f2){acc[ai][1][m][0][2 * e], acc[ai][1][m][0][2 * e + 1]}; hi[2 + e] = (f2){acc[ai][1][m][1][2 * e], acc[ai][1][m][1][2 * e + 1]}; }
                bf16_t* d0; bf16_t* d1;
                if (rope) {
                    const float p = (float)pos[row];
#pragma unroll
                    for (int e = 0; e < 4; ++e) { const f2 rev = invf[e] * p; f2 sn, cs;
                        const float r0 = __builtin_amdgcn_fractf(rev.x), r1 = __builtin_amdgcn_fractf(rev.y);
                        sn.x = __builtin_amdgcn_sinf(r0); sn.y = __builtin_amdgcn_sinf(r1); cs.x = __builtin_amdgcn_cosf(r0); cs.y = __builtin_amdgcn_cosf(r1);
                        const f2 a = lo[e], bb = hi[e]; lo[e] = a * cs - bb * sn; hi[e] = bb * cs + a * sn; }
                    if (pn < 2) { d0 = q + (size_t)row * AW + (pn * 4 + wc) * 64 + j0; } else { d0 = k + (size_t)row * KVW + wc * 64 + j0; }
                    d1 = d0 + 32;
                } else if (pn == 2) { d0 = v + (size_t)row * KVW + (wc - 2) * 64 + j0; d1 = d0 + 32; }
                else if (pn < 5) { d0 = xr + (size_t)row * LW + (pn - 3) * 256 + wc * 32 + j0; d1 = d0 + 128; }
                else if (pn < 7) {
#pragma unroll
                    for (int e = 0; e < 4; ++e) {
#pragma unroll
                        for (int hf = 0; hf < 2; ++hf) { const f2 a = hf ? hi[e] : lo[e]; const f2 z = (a * ((a * a) * 0.044715f + 1.0f)) * (-1.5957691216057308f * 1.4426950408889634f);
                            f2 d; d.x = __builtin_amdgcn_exp2f(z.x); d.y = __builtin_amdgcn_exp2f(z.y); d = d + 1.0f; f2 r; r.x = __builtin_amdgcn_rcpf(d.x); r.y = __builtin_amdgcn_rcpf(d.y);
                            if (hf) hi[e] = a * r; else lo[e] = a * r; } }
                    d0 = yg + (size_t)row * LW + (pn - 5) * 256 + wc * 32 + j0; d1 = d0 + 128;
                } else {
#pragma unroll
                    for (int e = 0; e < 4; ++e) { f2 a = lo[e], bb = hi[e];
                        a.x = __builtin_amdgcn_fmed3f(a.x, -30.f, 30.f); a.y = __builtin_amdgcn_fmed3f(a.y, -30.f, 30.f); bb.x = __builtin_amdgcn_fmed3f(bb.x, -30.f, 30.f); bb.y = __builtin_amdgcn_fmed3f(bb.y, -30.f, 30.f);
                        const f2 za = a * (-1.4426950408889634f), zb = bb * (-1.4426950408889634f); f2 da, db;
                        da.x = __builtin_amdgcn_exp2f(za.x); da.y = __builtin_amdgcn_exp2f(za.y); db.x = __builtin_amdgcn_exp2f(zb.x); db.y = __builtin_amdgcn_exp2f(zb.y); da = da + 1.0f; db = db + 1.0f;
                        f2 ia, ib; ia.x = __builtin_amdgcn_rcpf(da.x); ia.y = __builtin_amdgcn_rcpf(da.y); ib.x = __builtin_amdgcn_rcpf(db.x); ib.y = __builtin_amdgcn_rcpf(db.y);
                        lo[e] = db * ia; hi[e] = ib; }
                    d0 = ratio + (size_t)row * DM + (pn - 7) * 128 + wc * 32 + j0; d1 = gls + (size_t)row * DM + (pn - 7) * 128 + wc * 32 + j0;
                }
                u32x4 w0, w1;
#pragma unroll
                for (int e = 0; e < 4; ++e) { w0[e] = cvt_pk_bf16(lo[e].x, lo[e].y); w1[e] = cvt_pk_bf16(hi[e].x, hi[e].y); }
                *(u32x4*)d0 = w0; *(u32x4*)d1 = w1;
            }
    }
};
struct EpiMerged {
    static constexpr bool PERM = true, HAS_MID = true;
    struct Pre {}; __device__ __forceinline__ Pre load_pre(const Unit&, int, int, int, int) const { return Pre{}; }
    const bf16_t* ratio; const bf16_t* gls; bf16_t* merged;
    __device__ __forceinline__ void mid(f32x4 (&acc)[2][2][4][2], const Unit& u, int wr, int wc, int fr, int fq) const {
        int off0 = (u.pm * BM + wr * 64 + fr) * DM + u.pn * BM + wc * 32 + 8 * fq;
        asm volatile("" : "+v"(off0));
#pragma unroll
        for (int ai = 0; ai < 2; ++ai)
#pragma unroll
            for (int m = 0; m < 4; ++m)
            {
#pragma unroll
                for (int bj = 0; bj < 2; ++bj) { const u32x4 w = *(const u32x4*)(ratio + (size_t)(unsigned)(off0 + (ai * HALF + m * 16) * DM + bj * HALF)); float f[8]; unpack8(w, f);
#pragma unroll
                    for (int e = 0; e < 4; ++e) { acc[ai][bj][m][0][e] *= f[e]; acc[ai][bj][m][1][e] *= f[4 + e]; } }
                if (m & 1) asm volatile("" ::: "memory"); }
    }
    __device__ __forceinline__ void operator()(const f32x4 (&acc)[2][2][4][2], const Unit& u, int wr, int wc, int fr, int fq, const Pre& pre) const {
        const int row0 = u.pm * BM + wr * 64 + fr, col0 = u.pn * BM + wc * 32 + 8 * fq;
#pragma unroll
        for (int ai = 0; ai < 2; ++ai)
#pragma unroll
            for (int m = 0; m < 4; ++m)
#pragma unroll
                for (int bj = 0; bj < 2; ++bj) { const size_t off = (size_t)(row0 + ai * HALF + m * 16) * DM + col0 + bj * HALF; const u32x4 w = *(const u32x4*)(gls + off); float f[8]; unpack8(w, f);
                    u32x4 o;
#pragma unroll
                    for (int e = 0; e < 2; ++e) { o[e] = cvt_pk_bf16(acc[ai][bj][m][0][2 * e] * f[2 * e], acc[ai][bj][m][0][2 * e + 1] * f[2 * e + 1]);
                        o[2 + e] = cvt_pk_bf16(acc[ai][bj][m][1][2 * e] * f[4 + 2 * e], acc[ai][bj][m][1][2 * e + 1] * f[4 + 2 * e + 1]); }
                    *(u32x4*)(merged + off) = o; }
    }
};
struct EpiX1 {
    static constexpr bool PERM = false, HAS_MID = false;
    struct Pre {}; __device__ __forceinline__ Pre load_pre(const Unit&, int, int, int, int) const { return Pre{}; }
    const float* x; float* x1;
    __device__ __forceinline__ void mid(f32x4 (&)[2][2][4][2], const Unit&, int, int, int, int) const {}
    __device__ __forceinline__ void operator()(const f32x4 (&acc)[2][2][4][2], const Unit& u, int wr, int wc, int fr, int fq, const Pre& pre) const {
        const int row0 = u.pm * BM + wr * 64 + fr, col0 = u.pn * BM + wc * 32 + 4 * fq;
#pragma unroll
        for (int ai = 0; ai < 2; ++ai)
#pragma unroll
            for (int m = 0; m < 4; ++m)
#pragma unroll
                for (int bj = 0; bj < 2; ++bj)
#pragma unroll
                    for (int n = 0; n < 2; ++n) { const size_t off = (size_t)(row0 + ai * HALF + m * 16) * DM + col0 + bj * HALF + n * 16; *(f32x4*)(x1 + off) = *(const f32x4*)(x + off) + acc[ai][bj][m][n]; }
    }
};
struct EpiD {
    static constexpr bool PERM = true, HAS_MID = false;
    struct Pre {}; __device__ __forceinline__ Pre load_pre(const Unit&, int, int, int, int) const { return Pre{}; }
    bf16_t* d;
    __device__ __forceinline__ void mid(f32x4 (&)[2][2][4][2], const Unit&, int, int, int, int) const {}
    __device__ __forceinline__ void operator()(const f32x4 (&acc)[2][2][4][2], const Unit& u, int wr, int wc, int fr, int fq, const Pre& pre) const {
        const int row0 = u.pm * BM + wr * 64 + fr, col0 = u.pn * BM + wc * 32 + 8 * fq;
#pragma unroll
        for (int ai = 0; ai < 2; ++ai)
#pragma unroll
            for (int m = 0; m < 4; ++m)
#pragma unroll
                for (int bj = 0; bj < 2; ++bj) { const f32x4 v0 = acc[ai][bj][m][0], v1 = acc[ai][bj][m][1]; u32x4 w;
                    w[0] = cvt_pk_bf16(v0[0], v0[1]); w[1] = cvt_pk_bf16(v0[2], v0[3]); w[2] = cvt_pk_bf16(v1[0], v1[1]); w[3] = cvt_pk_bf16(v1[2], v1[3]);
                    *(u32x4*)(d + (size_t)(row0 + ai * HALF + m * 16) * DM + col0 + bj * HALF) = w; }
    }
};
struct EpiAct {
    static constexpr bool PERM = true, HAS_MID = false;
    const float* bgu; void* act; float sc;
    struct Pre { f32x4 b[4]; };
    __device__ __forceinline__ Pre load_pre(const Unit& u, int wr, int wc, int fr, int fq) const { const float* bp = bgu + (size_t)u.e * 2048 + u.pn * 128 + wc * 32 + 8 * fq;
        Pre p; p.b[0] = *(const f32x4*)bp; p.b[1] = *(const f32x4*)(bp + 4); p.b[2] = *(const f32x4*)(bp + 1024); p.b[3] = *(const f32x4*)(bp + 1028); return p; }
    __device__ __forceinline__ void mid(f32x4 (&)[2][2][4][2], const Unit&, int, int, int, int) const {}
    __device__ __forceinline__ void operator()(const f32x4 (&acc)[2][2][4][2], const Unit& u, int wr, int wc, int fr, int fq, const Pre& pre) const {
        const int row0 = u.pm * BM + wr * 64 + fr, j0 = u.pn * 128 + wc * 32 + 8 * fq;
        typedef float f2 __attribute__((ext_vector_type(2)));
        f2 bg[4], bu[4];
#pragma unroll
        for (int q = 0; q < 2; ++q) { bg[q] = (f2){pre.b[0][2 * q], pre.b[0][2 * q + 1]}; bg[2 + q] = (f2){pre.b[1][2 * q], pre.b[1][2 * q + 1]}; bu[q] = (f2){pre.b[2][2 * q], pre.b[2][2 * q + 1]}; bu[2 + q] = (f2){pre.b[3][2 * q], pre.b[3][2 * q + 1]}; }
#pragma unroll
        for (int ai = 0; ai < 2; ++ai)
#pragma unroll
            for (int m = 0; m < 4; ++m) {
                float o[8];
#pragma unroll
                for (int q = 0; q < 4; ++q) {
                    const f32x4 ga = acc[ai][0][m][q >> 1], ua = acc[ai][1][m][q >> 1]; const int e0 = 2 * (q & 1);
                    f2 g = (f2){ga[e0], ga[e0 + 1]} * sc + bg[q], uu = (f2){ua[e0], ua[e0 + 1]} * sc + bu[q];
                    g.x = fminf(g.x, 7.0f); g.y = fminf(g.y, 7.0f); uu.x = __builtin_amdgcn_fmed3f(uu.x, -7.0f, 7.0f); uu.y = __builtin_amdgcn_fmed3f(uu.y, -7.0f, 7.0f);
                    const f2 z = g * (-1.702f * 1.4426950408889634f); f2 d; d.x = __builtin_amdgcn_exp2f(z.x); d.y = __builtin_amdgcn_exp2f(z.y); d = d + 1.0f;
                    f2 r; r.x = __builtin_amdgcn_rcpf(d.x); r.y = __builtin_amdgcn_rcpf(d.y);
                    const f2 res = (uu + 1.0f) * (g * r); o[2 * q] = res.x; o[2 * q + 1] = res.y; }
                const size_t off = (size_t)(row0 + ai * HALF + m * 16) * DE + j0;
                if (MOE_FP8) { *(unsigned long long*)((unsigned char*)act + off) = (unsigned long long)pk4_fp8(o[0], o[1], o[2], o[3]) | ((unsigned long long)pk4_fp8(o[4], o[5], o[6], o[7]) << 32); }
                else { u32x4 w;
#pragma unroll
                    for (int e = 0; e < 4; ++e) w[e] = cvt_pk_bf16(o[2 * e], o[2 * e + 1]);
                    *(u32x4*)((bf16_t*)act + off) = w; }
            }
    }
};
struct EpiY {
    static constexpr bool PERM = true, HAS_MID = false;
    const float* bd; bf16_t* y; float sc;
    struct Pre { f32x4 b[4]; };
    __device__ __forceinline__ Pre load_pre(const Unit& u, int wr, int wc, int fr, int fq) const {
        Pre p;
        if (MOE_FP8 && Y_FP8) { const float* bp = bd + (size_t)u.e * DM + u.pn * BM + wc * 64 + 16 * fq; p.b[0] = *(const f32x4*)bp; p.b[1] = *(const f32x4*)(bp + 4); p.b[2] = *(const f32x4*)(bp + 8); p.b[3] = *(const f32x4*)(bp + 12); }
        else { const float* bp = bd + (size_t)u.e * DM + u.pn * BM + wc * 32 + 8 * fq; p.b[0] = *(const f32x4*)bp; p.b[1] = *(const f32x4*)(bp + 4); p.b[2] = *(const f32x4*)(bp + HALF); p.b[3] = *(const f32x4*)(bp + HALF + 4); }
        return p; }
    __device__ __forceinline__ void mid(f32x4 (&)[2][2][4][2], const Unit&, int, int, int, int) const {}
    __device__ __forceinline__ void operator()(const f32x4 (&acc)[2][2][4][2], const Unit& u, int wr, int wc, int fr, int fq, const Pre& pre) const {
        const int row0 = u.pm * BM + wr * 64 + fr;
        if (MOE_FP8 && Y_FP8) {
            const int colb = u.pn * BM + wc * 64 + 16 * fq;
#pragma unroll
            for (int ai = 0; ai < 2; ++ai)
#pragma unroll
                for (int m = 0; m < 4; ++m) { u32x4 w;
#pragma unroll
                    for (int bj = 0; bj < 2; ++bj) { const f32x4 v0 = acc[ai][bj][m][0] * sc + pre.b[2 * bj], v1 = acc[ai][bj][m][1] * sc + pre.b[2 * bj + 1];
                        w[2 * bj] = pk4_fp8(clamp448(v0[0]), clamp448(v0[1]), clamp448(v0[2]), clamp448(v0[3])); w[2 * bj + 1] = pk4_fp8(clamp448(v1[0]), clamp448(v1[1]), clamp448(v1[2]), clamp448(v1[3])); }
                    *(u32x4*)((unsigned char*)y + (size_t)(row0 + ai * HALF + m * 16) * DM + colb) = w; }
        } else {
            const int col0 = u.pn * BM + wc * 32 + 8 * fq;
#pragma unroll
            for (int bj = 0; bj < 2; ++bj) {
                const f32x4 b0 = pre.b[2 * bj], b1 = pre.b[2 * bj + 1];
#pragma unroll
                for (int ai = 0; ai < 2; ++ai)
#pragma unroll
                    for (int m = 0; m < 4; ++m) { const f32x4 v0 = acc[ai][bj][m][0] * sc + b0, v1 = acc[ai][bj][m][1] * sc + b1;
                        const size_t off = (size_t)(row0 + ai * HALF + m * 16) * DM + col0 + bj * HALF;
                        u32x4 w; w[0] = cvt_pk_bf16(v0[0], v0[1]); w[1] = cvt_pk_bf16(v0[2], v0[3]); w[2] = cvt_pk_bf16(v1[0], v1[1]); w[3] = cvt_pk_bf16(v1[2], v1[3]);
                        *(u32x4*)(y + off) = w; }
            }
        }
    }
};
}

struct Frame {
    LAS unsigned char* lds; volatile LAS unsigned* MISC; unsigned* ctl;
    int tid, lane, wave, vcu, G;
    const float *x, *norm_mix_g, *w_in, *conv_w, *conv_b, *w_rg, *b_rg, *w_ig, *b_ig, *lam, *sinks, *w_attn_o, *w_lru_o, *w_out, *norm_ffn_g, *w_router, *b_router, *w_gu, *b_gu, *w_down, *b_down, *norm_final_g;
    const int* positions; float* out;
    unsigned char* ws;
    __device__ __forceinline__ bf16_t* Win_t() const { return (bf16_t*)(ws + WS_WIN); }
    __device__ __forceinline__ bf16_t* Wcat_t() const { return (bf16_t*)(ws + WS_WCAT); }
    __device__ __forceinline__ bf16_t* Wout_t() const { return (bf16_t*)(ws + WS_WOUT); }
    __device__ __forceinline__ bf16_t* Wgu_t() const { return (bf16_t*)(ws + WS_WGU); }
    __device__ __forceinline__ bf16_t* Wd_t() const { return (bf16_t*)(ws + WS_WD); }
    __device__ __forceinline__ bf16_t* Wrg_t() const { return (bf16_t*)(ws + WS_WRG); }
    __device__ __forceinline__ bf16_t* Wig_t() const { return (bf16_t*)(ws + WS_WIG); }
    __device__ __forceinline__ bf16_t* Wrt() const { return (bf16_t*)(ws + WS_WRT); }
    __device__ __forceinline__ bf16_t* h() const { return (bf16_t*)(ws + WS_H); }
    __device__ __forceinline__ bf16_t* q() const { return (bf16_t*)(ws + WS_Q); }
    __device__ __forceinline__ bf16_t* k() const { return (bf16_t*)(ws + WS_K); }
    __device__ __forceinline__ bf16_t* v() const { return (bf16_t*)(ws + WS_V); }
    __device__ __forceinline__ bf16_t* xr() const { return (bf16_t*)(ws + WS_XR); }
    __device__ __forceinline__ bf16_t* yg() const { return (bf16_t*)(ws + WS_YG); }
    __device__ __forceinline__ bf16_t* ratio() const { return (bf16_t*)(ws + WS_RATIO); }
    __device__ __forceinline__ bf16_t* gls() const { return (bf16_t*)(ws + WS_GLS); }
    __device__ __forceinline__ bf16_t* ao() const { return (bf16_t*)(ws + WS_AO); }
    __device__ __forceinline__ bf16_t* merged() const { return (bf16_t*)(ws + WS_MERGED); }
    __device__ __forceinline__ bf16_t* h2() const { return (bf16_t*)(ws + WS_H2); }
    __device__ __forceinline__ bf16_t* act() const { return (bf16_t*)(ws + WS_ACT); }
    __device__ __forceinline__ bf16_t* y() const { return (bf16_t*)(ws + WS_Y); }
    __device__ __forceinline__ float* x1() const { return (float*)(ws + WS_X1); }
    __device__ __forceinline__ bf16_t* dmix() const { return (bf16_t*)(ws + WS_X1); }
    __device__ __forceinline__ float* tok_w() const { return (float*)(ws + WS_TOKW); }
    __device__ __forceinline__ int* tok_e() const { return (int*)(ws + WS_TOKE); }
    __device__ __forceinline__ int* tok_p() const { return (int*)(ws + WS_TOKP); }
    __device__ __forceinline__ int* slot_tok() const { return (int*)(ws + WS_SLOT); }
};

struct XDesc { const float* src; unsigned char* dst; int N, ldd, kind, n0; };
constexpr int XA_IN = 16 * 60, XA_AO = 8 * 16, XA_OUT = 16 * 16, XA_G = LH, XA_N = XA_IN + 2 * XA_AO + XA_OUT + 2 * XA_G;
constexpr int XB_GU = NE * 16 * 32, XB_D = NE * 16 * 16, XB_N = XB_GU + XB_D;
__device__ __forceinline__ XDesc x_desc(const Frame& F, int list, int r) {
    XDesc d;
    if (list == 1) {
        if (r < XB_GU) { const int e = r >> 9, rr = r & 511, kb = rr >> 5, nb = rr & 31; d.src = F.w_gu + (size_t)e * DM * 2048 + (size_t)(64 * kb) * 2048 + 64 * nb; d.N = 2048; d.n0 = 64 * nb; d.ldd = DM;
            d.kind = MOE_FP8 ? 2 : 4; d.dst = (unsigned char*)F.Wgu_t() + ((size_t)e * 2048 * DM + 64 * kb) * (MOE_FP8 ? 1 : 2); return d; }
        r -= XB_GU; { const int e = r >> 8, rr = r & 255, kb = rr >> 4, nb = rr & 15; d.src = F.w_down + (size_t)e * DE * DM + (size_t)(64 * kb) * DM + 64 * nb; d.N = DM; d.n0 = 64 * nb; d.ldd = DE;
            d.kind = MOE_FP8 ? (Y_FP8 ? 6 : 3) : 0; d.dst = (unsigned char*)F.Wd_t() + ((size_t)e * DM * DE + 64 * kb) * (MOE_FP8 ? 1 : 2); return d; }
    }
    if (r < XA_IN) { const int kb = r / 60, nb = r % 60; d.src = F.w_in + (size_t)(64 * kb) * INW + 64 * nb; d.N = INW; d.n0 = 64 * nb; d.ldd = DM; d.kind = 1; d.dst = (unsigned char*)(F.Win_t() + 64 * kb); return d; } r -= XA_IN;
    if (r < XA_AO) { const int kb = r >> 4, nb = r & 15; d.src = F.w_attn_o + (size_t)(64 * kb) * DM + 64 * nb; d.N = DM; d.n0 = 64 * nb; d.ldd = DM; d.kind = 0; d.dst = (unsigned char*)(F.Wcat_t() + 64 * kb); return d; } r -= XA_AO;
    if (r < XA_AO) { const int kb = r >> 4, nb = r & 15; d.src = F.w_lru_o + (size_t)(64 * kb) * DM + 64 * nb; d.N = DM; d.n0 = 64 * nb; d.ldd = DM; d.kind = 0; d.dst = (unsigned char*)(F.Wcat_t() + 512 + 64 * kb); return d; } r -= XA_AO;
    if (r < XA_OUT) { const int kb = r >> 4, nb = r & 15; d.src = F.w_out + (size_t)(64 * kb) * DM + 64 * nb; d.N = DM; d.n0 = 64 * nb; d.ldd = DM; d.kind = 0; d.dst = (unsigned char*)(F.Wout_t() + 64 * kb); return d; } r -= XA_OUT;
    if (r < XA_G) { d.src = F.w_rg + r * 4096; d.N = 64; d.n0 = 0; d.ldd = 64; d.kind = 0; d.dst = (unsigned char*)(F.Wrg_t() + r * 4096); return d; } r -= XA_G;
    d.src = F.w_ig + r * 4096; d.N = 64; d.n0 = 0; d.ldd = 64; d.kind = 0; d.dst = (unsigned char*)(F.Wig_t() + r * 4096); return d;
}
__device__ __forceinline__ void xpose_write(LAS float* scr, const float (&v)[64], int lane) {
#pragma unroll
    for (int i = 0; i < 64; ++i) scr[i * 64 + (lane ^ (i & 31))] = v[i];
    asm volatile("" ::: "memory");
}
__device__ __forceinline__ void xpose_store(const XDesc& d, LAS float* scr, int lane) {
    const int c = lane & 7, nn = lane >> 3;
#pragma unroll
    for (int j = 0; j < 8; ++j) {
        const int n = nn + 8 * j, o = d.n0 + n;
        const int row = d.kind == 1 ? g1_inv(o) : (d.kind == 2 || d.kind == 4) ? gu_inv(o) : d.kind == 6 ? y16_inv(o) : o;
        float f[8];
#pragma unroll
        for (int e = 0; e < 8; ++e) { const int kx = 8 * c + e; f[e] = scr[kx * 64 + (n ^ (kx & 31))]; }
        if (d.kind == 2 || d.kind == 3 || d.kind == 6) {
#pragma unroll
            for (int e = 0; e < 8; ++e) f[e] = clamp448(f[e] * W8_SCALE);
            *(unsigned long long*)(d.dst + (size_t)row * d.ldd + 8 * c) = (unsigned long long)pk4_fp8(f[0], f[1], f[2], f[3]) | ((unsigned long long)pk4_fp8(f[4], f[5], f[6], f[7]) << 32);
        } else { u32x4 w; w.x = cvt_pk_bf16(f[0], f[1]); w.y = cvt_pk_bf16(f[2], f[3]); w.z = cvt_pk_bf16(f[4], f[5]); w.w = cvt_pk_bf16(f[6], f[7]);
            *(u32x4*)(d.dst + ((size_t)row * d.ldd + 8 * c) * 2) = w; }
    }
    asm volatile("s_waitcnt lgkmcnt(0)" ::: "memory");
}
__device__ __forceinline__ void xpose_run(const Frame& F, int list, int first, int count, int stride) {
    LAS float* scr = (LAS float*)(F.lds + F.wave * 16384);
    const int lane = F.lane;
    float va[64], vb[64];
    int ia = first, ib = first + stride;
    if (ia >= count) return;
    XDesc da = x_desc(F, list, ia), db = da;
#pragma unroll
    for (int i = 0; i < 64; ++i) va[i] = da.src[(size_t)i * da.N + lane];
    if (ib < count) { db = x_desc(F, list, ib);
#pragma unroll
        for (int i = 0; i < 64; ++i) vb[i] = db.src[(size_t)i * db.N + lane]; }
    for (;;) {
        {
            xpose_write(scr, va, lane);
            const XDesc dc = da; const int na = ia + 2 * stride;
            if (na < count) { da = x_desc(F, list, na);
#pragma unroll
                for (int i = 0; i < 64; ++i) va[i] = da.src[(size_t)i * da.N + lane]; }
            xpose_store(dc, scr, lane); ia = na;
        }
        if (ib >= count) break;
        {
            xpose_write(scr, vb, lane);
            const XDesc dc = db; const int nb = ib + 2 * stride;
            if (nb < count) { db = x_desc(F, list, nb);
#pragma unroll
                for (int i = 0; i < 64; ++i) vb[i] = db.src[(size_t)i * db.N + lane]; }
            xpose_store(dc, scr, lane); ib = nb;
        }
        if (ia >= count) break;
    }
}
__device__ __forceinline__ void xq8_load(const XDesc& d, f32x4 (&v)[16], int lane) {
    const float* p = d.src + (size_t)(lane & 3) * d.N + 4 * (lane >> 2);
#pragma unroll
    for (int i = 0; i < 16; ++i) v[i] = *(const f32x4*)(p + (size_t)(4 * i) * d.N);
}
__device__ __forceinline__ void xq8_store(const XDesc& d, const f32x4 (&v)[16], int lane) {
    const int kq = lane & 3; const unsigned selA = 0x0c0c0000u | ((4u + kq) << 8) | (unsigned)kq, selB = ((4u + kq) << 24) | ((unsigned)kq << 16) | 0x0c0cu;
    unsigned T[16];
#pragma unroll
    for (int i = 0; i < 16; ++i) {
        const int D = (int)pk4_fp8(clamp448(v[i].x * W8_SCALE), clamp448(v[i].y * W8_SCALE), clamp448(v[i].z * W8_SCALE), clamp448(v[i].w * W8_SCALE));
        const unsigned x0 = (unsigned)__builtin_amdgcn_mov_dpp(D, 0x00, 0xf, 0xf, true), x1 = (unsigned)__builtin_amdgcn_mov_dpp(D, 0x55, 0xf, 0xf, true),
                       x2 = (unsigned)__builtin_amdgcn_mov_dpp(D, 0xaa, 0xf, 0xf, true), x3 = (unsigned)__builtin_amdgcn_mov_dpp(D, 0xff, 0xf, 0xf, true);
        T[i] = __builtin_amdgcn_perm(x1, x0, selA) | __builtin_amdgcn_perm(x3, x2, selB);
    }
    const int o = d.n0 + 4 * (lane >> 2) + kq; const int row = d.kind == 2 ? gu_inv(o) : o;
    unsigned char* op = d.dst + (size_t)row * d.ldd;
#pragma unroll
    for (int q = 0; q < 4; ++q) *(u32x4*)(op + 16 * q) = (u32x4){T[4 * q], T[4 * q + 1], T[4 * q + 2], T[4 * q + 3]};
}
__device__ __forceinline__ void xq8_run(const Frame& F, int first, int count) {
    const int lane = F.lane; f32x4 va[16], vb[16];
    int ia = first, ib = first + 1; if (ia >= count) return;
    XDesc da = x_desc(F, 1, ia), db = da; xq8_load(da, va, lane);
    if (ib < count) { db = x_desc(F, 1, ib); xq8_load(db, vb, lane); }
    for (;;) {
        { const XDesc dc = da; f32x4 t[16];
#pragma unroll
          for (int i = 0; i < 16; ++i) t[i] = va[i];
          ia += 2; if (ia < count) { da = x_desc(F, 1, ia); xq8_load(da, va, lane); }
          xq8_store(dc, t, lane); }
        if (ib >= count) break;
        { const XDesc dc = db; f32x4 t[16];
#pragma unroll
          for (int i = 0; i < 16; ++i) t[i] = vb[i];
          ib += 2; if (ib < count) { db = x_desc(F, 1, ib); xq8_load(db, vb, lane); }
          xq8_store(dc, t, lane); }
        if (ia >= count) break;
    }
}
#ifndef XQ_DPP
#define XQ_DPP 0
#endif
#ifndef P1_XWG
#define P1_XWG 42
#endif
constexpr int XQ_TILES = 16, XQ_ITEMS = XB_N / XQ_TILES;
#ifndef XQ_P1
#define XQ_P1 576
#endif
constexpr int CW_XQ1 = 12288 + 64, CW_XQ2 = 12288 + 128;
__device__ __forceinline__ int wg_pull(Frame& F, int cw) {
    if (F.tid == 0) F.MISC[MW_Q] = atomicAdd(&F.ctl[cw], 1u);
    __syncthreads();
    const int item = (int)F.MISC[MW_Q];
    __syncthreads();
    return item;
}
__device__ __forceinline__ void xq_item(Frame& F, int idx) { const int t0 = idx * XQ_TILES + F.wave * 2; if (MOE_FP8 && XQ_DPP) xq8_run(F, t0, t0 + 2); else xpose_run(F, 1, t0, t0 + 2, 1); }
__device__ __forceinline__ void p0_prologue(Frame& F) {
    const int gw = F.vcu * NWAVES + F.wave, NGW = F.G * NWAVES;
    xpose_run(F, 0, gw, XA_N, NGW);
    for (int idx = gw * 64 + F.lane; idx < NE * DM; idx += NGW * 64) { const int e = idx >> 10, kx = idx & 1023; F.Wrt()[idx] = f2bf(F.w_router[kx * NE + e]); }
    f32x4 gv[4];
#pragma unroll
    for (int j = 0; j < 4; ++j) gv[j] = *(const f32x4*)(F.norm_mix_g + 4 * F.lane + 256 * j);
    for (int m0 = gw * 4; m0 < NTOK; m0 += NGW * 4) {
        f32x4 v[4][4];
#pragma unroll
        for (int r = 0; r < 4; ++r)
#pragma unroll
            for (int j = 0; j < 4; ++j) v[r][j] = *((const f32x4*)(F.x + (size_t)(m0 + r) * DM) + F.lane + 64 * j);
#pragma unroll
        for (int r = 0; r < 4; ++r) { float s = 0.f;
#pragma unroll
            for (int j = 0; j < 4; ++j) s += (v[r][j].x * v[r][j].x + v[r][j].y * v[r][j].y) + (v[r][j].z * v[r][j].z + v[r][j].w * v[r][j].w);
            const float rs = rsqrtf(wave_sum(s) * (1.0f / DM) + 1e-6f);
            unsigned long long* o8 = (unsigned long long*)(F.h() + (size_t)(m0 + r) * DM) + F.lane;
#pragma unroll
            for (int j = 0; j < 4; ++j) o8[64 * j] = (unsigned long long)cvt_pk_bf16(v[r][j].x * rs * gv[j].x, v[r][j].y * rs * gv[j].y) | ((unsigned long long)cvt_pk_bf16(v[r][j].z * rs * gv[j].z, v[r][j].w * rs * gv[j].w) << 32); }
    }
}

__device__ __forceinline__ s16x4 vtr(const LAS unsigned char* p) { typedef short v4i16_t __attribute__((ext_vector_type(4))); return __builtin_bit_cast(s16x4, __builtin_amdgcn_ds_read_tr16_b64_v4i16((LAS v4i16_t*)p)); }
constexpr int AT_KS = 0, AT_VS = 36864, AT_LS = 36864 + 32768;
__device__ __forceinline__ void attn_unit(Frame& F, int unit) {
    const int b = unit >> 5, kvh = (unit >> 4) & 1, qb = unit & 15;
    const int tid = F.tid, lane = F.lane, wid = F.wave, hi = lane >> 5, iq = lane & 31;
    const size_t n0 = (size_t)b * SEQ + 128 * qb;
    LAS unsigned char* Ks = F.lds + AT_KS; LAS unsigned char* Vs = F.lds + AT_VS; LAS float* Ls = (LAS float*)(F.lds + AT_LS) + wid * 32;
#pragma unroll
    for (int i = 0; i < 4; ++i) {
        const int ch = tid + 512 * i, key = ch >> 3, c = ch & 7; const bool valid = (qb > 0) || (key >= 128);
        u32x4 kv = (u32x4){0u, 0u, 0u, 0u}, vv = (u32x4){0u, 0u, 0u, 0u};
        if (valid) { const size_t tok = n0 - 128 + key; kv = *(const u32x4*)(F.k() + tok * KVW + kvh * 64 + c * 8); vv = *(const u32x4*)(F.v() + tok * KVW + kvh * 64 + c * 8); }
        *(LAS u32x4*)(Ks + key * 144 + c * 16) = kv;
        *(LAS u32x4*)(Vs + ((key >> 3) * 2 + (c >> 2)) * 512 + (key & 7) * 64 + (c & 3) * 16) = vv;
    }
    __syncthreads();
    const int g = wid >> 1, qh = wid & 1, hq = kvh * 4 + g;
    const float sink2 = F.sinks[hq] * 1.4426950408889634f; const float c2 = 0.125f * 1.4426950408889634f;
    const int voff = (4 * hi + ((lane & 15) >> 2)) * 64 + ((lane >> 4) & 1) * 32 + (lane & 3) * 8;
#pragma unroll 1
    for (int sb = 0; sb < 2; ++sb) {
        const int s1 = 2 * qh + sb; const size_t nq = n0 + 32 * s1 + iq;
        bf16x8 qf[4];
#pragma unroll
        for (int s = 0; s < 4; ++s) qf[s] = *(const bf16x8*)(F.q() + nq * AW + hq * 64 + 16 * s + 8 * hi);
        f32x16 p[5];
#pragma unroll
        for (int tt = 0; tt < 5; ++tt) {
            p[tt] = (f32x16){0.f, 0.f, 0.f, 0.f, 0.f, 0.f, 0.f, 0.f, 0.f, 0.f, 0.f, 0.f, 0.f, 0.f, 0.f, 0.f};
#pragma unroll
            for (int s = 0; s < 4; ++s) { const bf16x8 kf = *(const LAS bf16x8*)(Ks + (32 * (s1 + tt) + iq) * 144 + (16 * s + 8 * hi) * 2); p[tt] = __builtin_amdgcn_mfma_f32_32x32x16_bf16(kf, qf[s], p[tt], 0, 0, 0); }
        }
        float mx = sink2;
#pragma unroll
        for (int tt = 0; tt < 5; ++tt) {
            const bool tile_ok = (qb > 0) || (s1 + tt >= 4);
#pragma unroll
            for (int r = 0; r < 16; ++r) { const int kk = crow(r, hi); bool ok = tile_ok; if (tt == 0) ok = ok && (kk >= iq + 1); if (tt == 4) ok = ok && (kk <= iq);
                const float sc = ok ? p[tt][r] * c2 : -INFINITY; p[tt][r] = sc; mx = fmaxf(mx, sc); }
        }
        mx = fmaxf(mx, __shfl_xor(mx, 32));
        float l = 0.f;
#pragma unroll
        for (int tt = 0; tt < 5; ++tt)
#pragma unroll
            for (int r = 0; r < 16; ++r) { const float e = __builtin_amdgcn_exp2f(p[tt][r] - mx); p[tt][r] = e; l += e; }
        l += __shfl_xor(l, 32); l += __builtin_amdgcn_exp2f(sink2 - mx);
        f32x16 o[2];
        o[0] = (f32x16){0.f, 0.f, 0.f, 0.f, 0.f, 0.f, 0.f, 0.f, 0.f, 0.f, 0.f, 0.f, 0.f, 0.f, 0.f, 0.f}; o[1] = o[0];
#pragma unroll
        for (int tt = 0; tt < 5; ++tt)
#pragma unroll
            for (int s2 = 0; s2 < 2; ++s2) {
                u32x4 pw;
#pragma unroll
                for (int e = 0; e < 4; ++e) pw[e] = cvt_pk_bf16(p[tt][8 * s2 + 2 * e], p[tt][8 * s2 + 2 * e + 1]);
                const bf16x8 pa = __builtin_bit_cast(bf16x8, pw);
                const int sub = 4 * (s1 + tt) + 2 * s2;
#pragma unroll
                for (int db = 0; db < 2; ++db) {
                    const s16x4 lo = vtr(Vs + (sub * 2 + db) * 512 + voff), hi4 = vtr(Vs + ((sub + 1) * 2 + db) * 512 + voff);
                    const bf16x8 vb = (bf16x8){lo[0], lo[1], lo[2], lo[3], hi4[0], hi4[1], hi4[2], hi4[3]};
                    o[db] = __builtin_amdgcn_mfma_f32_32x32x16_bf16(pa, vb, o[db], 0, 0, 0);
                }
            }
        if (hi == 0) Ls[iq] = __builtin_amdgcn_rcpf(l);
        asm volatile("s_waitcnt lgkmcnt(0)" ::: "memory");
#pragma unroll
        for (int r = 0; r < 16; ++r) { const int qr = crow(r, hi); const float il = Ls[qr]; bf16_t* op = F.ao() + (n0 + 32 * s1 + qr) * DM + hq * 64 + iq;
            op[0] = f2bf(o[0][r] * il); op[32] = f2bf(o[1][r] * il); }
        asm volatile("s_waitcnt lgkmcnt(0)" ::: "memory");
    }
    __syncthreads();
}
constexpr int LR_XA = 0, LR_AS = 18432, LR_US = LR_AS + 32768, LR_CH = LR_US + 32768, LR_HC = LR_CH + 4096;
__device__ __forceinline__ void lru_unit(Frame& F, int unit) {
    const int b = unit >> 3, hh = unit & 7, C0 = 64 * hh;
    const int tid = F.tid, lane = F.lane, wid = F.wave, hi = lane >> 5;
    LAS unsigned char* XA = F.lds + LR_XA; LAS float* AS = (LAS float*)(F.lds + LR_AS); LAS float* US = (LAS float*)(F.lds + LR_US); LAS float* CH = (LAS float*)(F.lds + LR_CH); LAS float* HC = (LAS float*)(F.lds + LR_HC);
    const int tb = wid >> 1, cb = wid & 1, cm = 32 * cb + (lane & 31), Cm = C0 + cm;
    bf16x8 brg[4], big[4];
#pragma unroll
    for (int s = 0; s < 4; ++s) { brg[s] = *(const bf16x8*)(F.Wrg_t() + hh * 4096 + cm * 64 + 16 * s + 8 * hi); big[s] = *(const bf16x8*)(F.Wig_t() + hh * 4096 + cm * 64 + 16 * s + 8 * hi); }
    const float brg_b = F.b_rg[Cm], big_b = F.b_ig[Cm], sp8 = 8.0f * log1pf(__expf(-F.lam[Cm])) * 1.4426950408889634f;
    const int cs = tid & 63, js = wid, Cs = C0 + cs;
    const int tokc = tid >> 2, cq = tid & 3, Cq = C0 + 16 * cq;
    if (tid < 64) HC[tid] = 0.f;
    u32x4 xn[4][2];
    {
#pragma unroll
        for (int j = 0; j < 4; ++j) { const int tt = tokc - 3 + j;
#pragma unroll
            for (int hf = 0; hf < 2; ++hf) xn[j][hf] = tt >= 0 ? *(const u32x4*)(F.xr() + ((size_t)b * SEQ + tt) * LW + Cq + 8 * hf) : (u32x4){0u, 0u, 0u, 0u}; }
    }
#pragma unroll 1
    for (int tile = 0; tile < SEQ / 128; ++tile) {
        const int t0 = 128 * tile;
        {
            float xc[16];
#pragma unroll
            for (int e4 = 0; e4 < 4; ++e4) { const f32x4 cbv = *(const f32x4*)(F.conv_b + Cq + 4 * e4); xc[4 * e4] = cbv.x; xc[4 * e4 + 1] = cbv.y; xc[4 * e4 + 2] = cbv.z; xc[4 * e4 + 3] = cbv.w; }
#pragma unroll
            for (int j = 0; j < 4; ++j) { float xf[16]; { float t8[8]; unpack8(xn[j][0], t8);
#pragma unroll
                    for (int e = 0; e < 8; ++e) xf[e] = t8[e]; unpack8(xn[j][1], t8);
#pragma unroll
                    for (int e = 0; e < 8; ++e) xf[8 + e] = t8[e]; }
#pragma unroll
                for (int e4 = 0; e4 < 4; ++e4) { const f32x4 w = *(const f32x4*)(F.conv_w + j * LW + Cq + 4 * e4); xc[4 * e4] += xf[4 * e4] * w.x; xc[4 * e4 + 1] += xf[4 * e4 + 1] * w.y; xc[4 * e4 + 2] += xf[4 * e4 + 2] * w.z; xc[4 * e4 + 3] += xf[4 * e4 + 3] * w.w; } }
            u32x4 w0, w1;
#pragma unroll
            for (int e = 0; e < 4; ++e) { w0[e] = cvt_pk_bf16(xc[2 * e], xc[2 * e + 1]); w1[e] = cvt_pk_bf16(xc[8 + 2 * e], xc[8 + 2 * e + 1]); }
            *(LAS u32x4*)(XA + tokc * 144 + cq * 32) = w0; *(LAS u32x4*)(XA + tokc * 144 + cq * 32 + 16) = w1;
        }
        if (tile + 1 < SEQ / 128) {
#pragma unroll
            for (int j = 0; j < 4; ++j) { const size_t tt = (size_t)b * SEQ + t0 + 128 + tokc - 3 + j;
                xn[j][0] = *(const u32x4*)(F.xr() + tt * LW + Cq); xn[j][1] = *(const u32x4*)(F.xr() + tt * LW + Cq + 8); }
        }
        bf16_t ygv[16];
#pragma unroll
        for (int tt = 0; tt < 16; ++tt) ygv[tt] = F.yg()[((size_t)b * SEQ + t0 + 16 * js + tt) * LW + Cs];
        __syncthreads();
        {
            f32x16 drg = (f32x16){0.f, 0.f, 0.f, 0.f, 0.f, 0.f, 0.f, 0.f, 0.f, 0.f, 0.f, 0.f, 0.f, 0.f, 0.f, 0.f}, dig = drg;
#pragma unroll
            for (int s = 0; s < 4; ++s) { const bf16x8 af = *(const LAS bf16x8*)(XA + (32 * tb + (lane & 31)) * 144 + (16 * s + 8 * hi) * 2);
                drg = __builtin_amdgcn_mfma_f32_32x32x16_bf16(af, brg[s], drg, 0, 0, 0); dig = __builtin_amdgcn_mfma_f32_32x32x16_bf16(af, big[s], dig, 0, 0, 0); }
#pragma unroll
            for (int r = 0; r < 16; ++r) { const int t = 32 * tb + crow(r, hi);
                const float xcv = bf2f(*(const LAS bf16_t*)(XA + t * 144 + cm * 2));
                const float rg = fsig(drg[r] + brg_b), ig = fsig(dig[r] + big_b);
                const float la2 = -rg * sp8;
                const float a = __builtin_amdgcn_exp2f(la2);
                const float x2 = 2.0f * 0.6931471805599453f * la2;
                const float omp = -x2 * (1.0f + x2 * (0.5f + x2 * (0.16666667f + x2 * 0.041666668f))), omd = __builtin_fmaf(-a, a, 1.0f);
                const float om = x2 > -0.4f ? omp : omd;
                AS[t * 64 + cm] = a; US[t * 64 + cm] = __builtin_amdgcn_sqrtf(om) * (ig * xcv); }
        }
        __syncthreads();
        float av[16], uv[16]; float Ap = 1.f, Hp = 0.f;
#pragma unroll
        for (int tt = 0; tt < 16; ++tt) { av[tt] = AS[(16 * js + tt) * 64 + cs]; uv[tt] = US[(16 * js + tt) * 64 + cs]; }
#pragma unroll
        for (int tt = 0; tt < 16; ++tt) { Hp = av[tt] * Hp + uv[tt]; Ap *= av[tt]; }
        CH[js * 64 + cs] = Ap; CH[512 + js * 64 + cs] = Hp;
        __syncthreads();
        float hcur = HC[cs];
        for (int jj = 0; jj < js; ++jj) hcur = CH[jj * 64 + cs] * hcur + CH[512 + jj * 64 + cs];
#pragma unroll
        for (int tt = 0; tt < 16; ++tt) { hcur = av[tt] * hcur + uv[tt]; F.ao()[((size_t)b * SEQ + t0 + 16 * js + tt) * DM + 512 + Cs] = f2bf(hcur * bf2f(ygv[tt])); }
        __syncthreads();
        if (js == 7) HC[cs] = hcur;
    }
    __syncthreads();
}
__device__ __forceinline__ void p2_mixers(Frame& F) {
    constexpr int NLRU = NB * LH, NATT = NB * NKVH * (SEQ / 128);
    for (;;) {
        const int item = wg_pull(F, CW_QUEUE);
        if (item >= NLRU + NATT) break;
        if (item < NLRU) lru_unit(F, item); else attn_unit(F, item - NLRU);
    }
    for (;;) { const int idx = XQ_P1 + wg_pull(F, CW_XQ2); if (idx >= XQ_ITEMS) break; xq_item(F, idx); }
}

__device__ __forceinline__ void moe_tables(Frame& F) {
    if (F.tid < 64) {
        const int e = F.tid & 31; const int c = (int)__hip_atomic_load(&F.ctl[CW_GCOUNT + 64 * e], __ATOMIC_RELAXED, __HIP_MEMORY_SCOPE_AGENT);
        const int nt = (c + 255) >> 8; int inc = nt;
#pragma unroll
        for (int o = 1; o < 32; o <<= 1) { const int v = __shfl_up(inc, o, 32); if ((F.tid & 31) >= o) inc += v; }
        if (F.tid < 32) { F.MISC[MW_TS + e] = (unsigned)(inc - nt); F.MISC[MW_CNT + e] = (unsigned)c; if (e == 31) F.MISC[MW_TS + NE] = (unsigned)inc; }
    }
    __syncthreads();
    for (int m = F.tid; m < MAXTILES; m += NWAVES * 64) { int e = 0; for (int ee = 1; ee < NE; ++ee) e = (m >= (int)F.MISC[MW_TS + ee]) ? ee : e; F.MISC[MW_TE + m] = (unsigned)e; }
    __syncthreads();
}

__device__ __forceinline__ f32x4 x1_piece(const Frame& F, size_t row, int lane, int j) {
    const f32x4 xv = *((const f32x4*)(F.x + row * DM) + lane + 64 * j);
    const unsigned long long t = *((const unsigned long long*)(F.dmix() + row * DM) + lane + 64 * j); const unsigned lo = (unsigned)t, hi = (unsigned)(t >> 32);
    return xv + (f32x4){__uint_as_float(lo << 16), __uint_as_float(lo & 0xffff0000u), __uint_as_float(hi << 16), __uint_as_float(hi & 0xffff0000u)};
}
constexpr int P5_WT = 0, P5_AT = 66048, P5_ROW = 2064;
__device__ __forceinline__ void p5_router(Frame& F) {
    LAS unsigned char* WT = F.lds + P5_WT; LAS unsigned char* AT = F.lds + P5_AT;
    LAS float* PART = (LAS float*)AT;
    LAS float* LG = (LAS float*)(F.lds + MISC_OFF) + MW_P5;
    LAS float* RS = LG + 32 * 33;
    volatile LAS int* LCNT = (volatile LAS int*)(F.lds + MISC_OFF) + MW_P5 + 1280;
    volatile LAS int* LBASE = LCNT + 32;
    LAS int* PE = (LAS int*)(F.lds + MISC_OFF) + MW_P5 + 1280 + 64;
    LAS float* PW = (LAS float*)(PE + 512);
    const int tid = F.tid, lane = F.lane, wid = F.wave, hi = lane >> 5;
    for (int i = tid; i < NE * 128; i += NWAVES * 64) { const int e = i >> 7, c = i & 127; *(LAS u32x4*)(WT + e * P5_ROW + c * 16) = *(const u32x4*)(F.Wrt() + e * DM + c * 8); }
    if (tid < 32) LCNT[tid] = 0;
    const int row_base = F.vcu * 128;
    f32x4 gv[4];
#pragma unroll
    for (int j = 0; j < 4; ++j) gv[j] = *(const f32x4*)(F.norm_ffn_g + 4 * lane + 256 * j);
    f32x4 xn[4][4];
#pragma unroll
    for (int rr = 0; rr < 4; ++rr)
#pragma unroll
        for (int j = 0; j < 4; ++j) xn[rr][j] = x1_piece(F, (size_t)(row_base + wid * 4 + rr), lane, j);
#pragma unroll 1
    for (int it = 0; it < 4; ++it) {
        const int r0 = row_base + it * 32 + wid * 4;
#pragma unroll
        for (int rr = 0; rr < 4; ++rr) { float s = 0.f;
#pragma unroll
            for (int j = 0; j < 4; ++j) s += (xn[rr][j].x * xn[rr][j].x + xn[rr][j].y * xn[rr][j].y) + (xn[rr][j].z * xn[rr][j].z + xn[rr][j].w * xn[rr][j].w);
            const float rs = rsqrtf(wave_sum(s) * (1.0f / DM) + 1e-6f);
            unsigned long long* o8 = (unsigned long long*)(F.h2() + (size_t)(r0 + rr) * DM) + lane;
            unsigned* o4 = (unsigned*)((unsigned char*)F.h2() + (size_t)(r0 + rr) * DM) + lane;
#pragma unroll
            for (int j = 0; j < 4; ++j) { const f32x4 hv = xn[rr][j] * gv[j] * rs;
                if (MOE_FP8) o4[64 * j] = pk4_fp8(clamp448(hv.x), clamp448(hv.y), clamp448(hv.z), clamp448(hv.w));
                else o8[64 * j] = (unsigned long long)cvt_pk_bf16(hv.x, hv.y) | ((unsigned long long)cvt_pk_bf16(hv.z, hv.w) << 32);
                *(LAS unsigned long long*)(AT + (wid * 4 + rr) * P5_ROW + (4 * lane + 256 * j) * 2) = (unsigned long long)cvt_pk_bf16(hv.x, hv.y) | ((unsigned long long)cvt_pk_bf16(hv.z, hv.w) << 32); } }
        if (it + 1 < 4) {
#pragma unroll
            for (int rr = 0; rr < 4; ++rr)
#pragma unroll
                for (int j = 0; j < 4; ++j) xn[rr][j] = x1_piece(F, (size_t)(r0 + 32 + rr), lane, j);
        }
        __syncthreads();
        {
            f32x16 acc = (f32x16){0.f, 0.f, 0.f, 0.f, 0.f, 0.f, 0.f, 0.f, 0.f, 0.f, 0.f, 0.f, 0.f, 0.f, 0.f, 0.f};
#pragma unroll
            for (int s = 0; s < 8; ++s) { const int ko = (16 * (8 * wid + s) + 8 * hi) * 2;
                const bf16x8 af = *(const LAS bf16x8*)(AT + (lane & 31) * P5_ROW + ko), bfr = *(const LAS bf16x8*)(WT + (lane & 31) * P5_ROW + ko);
                acc = __builtin_amdgcn_mfma_f32_32x32x16_bf16(af, bfr, acc, 0, 0, 0); }
            __syncthreads();
#pragma unroll
            for (int r = 0; r < 16; ++r) PART[(wid * 16 + r) * 64 + lane] = acc[r];
        }
        __syncthreads();
#pragma unroll
        for (int q = 0; q < 2; ++q) { const int r = (tid >> 6) + 8 * q, ln = tid & 63; float sum = 0.f;
#pragma unroll
            for (int w = 0; w < 8; ++w) sum += PART[(w * 16 + r) * 64 + ln];
            LG[crow(r, ln >> 5) * 33 + (ln & 31)] = sum + F.b_router[ln & 31]; }
        __syncthreads();
        if (tid < 32) {
            const LAS float* lg = LG + tid * 33; unsigned used = 0; float tv[4]; int te[4];
#pragma unroll
            for (int kk = 0; kk < 4; ++kk) { float best = -3.0e38f; int bi = 0;
                for (int e = 0; e < NE; ++e) { const float vv = lg[e]; if (!((used >> e) & 1u) && vv > best) { best = vv; bi = e; } }
                used |= 1u << bi; tv[kk] = best; te[kk] = bi; }
            float ex[4], sum = 0.f;
#pragma unroll
            for (int kk = 0; kk < 4; ++kk) { ex[kk] = __expf(tv[kk] - tv[0]); sum += ex[kk]; }
            const float inv = 1.0f / sum; const int lr = it * 32 + tid;
#pragma unroll
            for (int kk = 0; kk < 4; ++kk) { const int lp = __hip_atomic_fetch_add((LAS int*)&LCNT[te[kk]], 1, __ATOMIC_RELAXED, __HIP_MEMORY_SCOPE_WORKGROUP); PE[lr * 4 + kk] = te[kk] | (lp << 8); PW[lr * 4 + kk] = ex[kk] * inv; }
        }
    }
    __syncthreads();
    if (tid < 32) { const int c = LCNT[tid]; LBASE[tid] = c ? (int)atomicAdd(&F.ctl[CW_GCOUNT + 64 * tid], (unsigned)c) : 0; }
    __syncthreads();
    { const int pe = PE[tid], e = pe & 255, lp = pe >> 8, pos = LBASE[e] + lp, row = row_base + (tid >> 2);
      F.tok_e()[row * 4 + (tid & 3)] = e; F.tok_w()[row * 4 + (tid & 3)] = PW[tid]; F.tok_p()[row * 4 + (tid & 3)] = pos; F.slot_tok()[(size_t)e * CAP + pos] = row; }
}

struct P8Row { f32x4 x[4]; unsigned yv[4][4]; float w[4]; };
__device__ __forceinline__ void p8_load(const Frame& F, int m, int lane, P8Row& r) {
    const int4 e4 = *(const int4*)(F.tok_e() + m * 4), p4 = *(const int4*)(F.tok_p() + m * 4); const f32x4 w4 = *(const f32x4*)(F.tok_w() + m * 4);
    const int ee[4] = {e4.x, e4.y, e4.z, e4.w}, pp[4] = {p4.x, p4.y, p4.z, p4.w}; r.w[0] = w4.x; r.w[1] = w4.y; r.w[2] = w4.z; r.w[3] = w4.w;
#pragma unroll
    for (int kk = 0; kk < 4; ++kk) { const size_t yrow = (size_t)256 * F.MISC[MW_TS + ee[kk]] + pp[kk];
        const unsigned* yp = (const unsigned*)((const unsigned char*)F.y() + yrow * DM) + lane;
#pragma unroll
        for (int j = 0; j < 4; ++j) r.yv[kk][j] = yp[64 * j]; }
#pragma unroll
    for (int j = 0; j < 4; ++j) r.x[j] = x1_piece(F, (size_t)m, lane, j);
}
__device__ __forceinline__ void p8_final(Frame& F) {
    static_assert(Y_FP8 && MOE_FP8, "p8_final reads fp8 y rows");
    const int gw = F.vcu * NWAVES + F.wave, NGW = F.G * NWAVES, lane = F.lane;
    f32x4 gv[4];
#pragma unroll
    for (int j = 0; j < 4; ++j) gv[j] = *(const f32x4*)(F.norm_final_g + 4 * lane + 256 * j);
    if (gw >= NTOK) return;
    P8Row cur, nxt; p8_load(F, gw, lane, cur);
    for (int m = gw; m < NTOK; m += NGW) {
        const int mn = m + NGW;
        if (mn < NTOK) p8_load(F, mn, lane, nxt);
        f32x4 v[4];
#pragma unroll
        for (int j = 0; j < 4; ++j) v[j] = cur.x[j];
#pragma unroll
        for (int kk = 0; kk < 4; ++kk)
#pragma unroll
            for (int j = 0; j < 4; ++j) { const int t = (int)cur.yv[kk][j]; const auto lo2 = __builtin_amdgcn_cvt_pk_f32_fp8(t, false), hi2 = __builtin_amdgcn_cvt_pk_f32_fp8(t, true); const float w = cur.w[kk];
                v[j].x += w * lo2[0]; v[j].y += w * lo2[1]; v[j].z += w * hi2[0]; v[j].w += w * hi2[1]; }
        float s = 0.f;
#pragma unroll
        for (int j = 0; j < 4; ++j) s += (v[j].x * v[j].x + v[j].y * v[j].y) + (v[j].z * v[j].z + v[j].w * v[j].w);
        const float rs = rsqrtf(wave_sum(s) * (1.0f / DM) + 1e-6f);
#pragma unroll
        for (int j = 0; j < 4; ++j) *((f32x4*)(F.out + (size_t)m * DM) + lane + 64 * j) = v[j] * rs * gv[j];
        cur = nxt;
    }
}

constexpr int NPHASE = 9;
struct Args { const void* in[23]; float* out; unsigned char* ws; int ph_lo, ph_hi; };
__global__ void __launch_bounds__(NWAVES * 64, 2) mega_fwd(Args args) {
    extern __shared__ __attribute__((aligned(16))) unsigned char lds_raw[];
    Frame F;
    F.lds = (LAS unsigned char*)lds_raw; F.MISC = (volatile LAS unsigned*)(F.lds + MISC_OFF);
    F.tid = threadIdx.x; F.lane = F.tid & 63; F.wave = __builtin_amdgcn_readfirstlane(F.tid >> 6);
    F.G = gridDim.x; { const int bx = blockIdx.x; F.vcu = (F.G % 8 == 0) ? (bx % 8) * (F.G / 8) + bx / 8 : bx; }
    unsigned char* ws = args.ws; F.ctl = (unsigned*)(ws + WS_CTL);
    F.x = (const float*)args.in[0]; F.positions = (const int*)args.in[1]; F.norm_mix_g = (const float*)args.in[2]; F.w_in = (const float*)args.in[3];
    F.conv_w = (const float*)args.in[4]; F.conv_b = (const float*)args.in[5]; F.w_rg = (const float*)args.in[6]; F.b_rg = (const float*)args.in[7];
    F.w_ig = (const float*)args.in[8]; F.b_ig = (const float*)args.in[9]; F.lam = (const float*)args.in[10]; F.sinks = (const float*)args.in[11];
    F.w_attn_o = (const float*)args.in[12]; F.w_lru_o = (const float*)args.in[13]; F.w_out = (const float*)args.in[14]; F.norm_ffn_g = (const float*)args.in[15];
    F.w_router = (const float*)args.in[16]; F.b_router = (const float*)args.in[17]; F.w_gu = (const float*)args.in[18]; F.b_gu = (const float*)args.in[19];
    F.w_down = (const float*)args.in[20]; F.b_down = (const float*)args.in[21]; F.norm_final_g = (const float*)args.in[22]; F.out = args.out;
    F.ws = ws;
    for (int u = F.tid; u < (LDS_BYTES - MISC_OFF) / 4; u += NWAVES * 64) ((LAS unsigned*)(F.lds + MISC_OFF))[u] = 0u;
    __syncthreads();
    const int lo = args.ph_lo, hi = args.ph_hi;
    const bool multi = (hi - lo) > 1;
    XcdBarrier bar; bar.bar = F.ctl + CW_BAR; bar.x = 0; bar.st = nullptr;
    if (multi) bar = xcd_barrier_post(F.ctl + CW_BAR, F.MISC + 8);
#ifndef PH_ONLY
#define PH_ONLY -1
#endif
#define IN(k) ((PH_ONLY < 0 || PH_ONLY == (k)) && lo <= (k) && (k) < hi)
#define SEAM(k) do { if (IN(k) && IN((k) + 1)) xcd_barrier(bar); } while (0)
#ifndef PROBE_K
#define PROBE_K -1
#endif
    unsigned long long pr_t0 = 0, pr_t1 = 0;
#define PSTAMP(k) do { if (PROBE_K >= 0) { if ((k) == PROBE_K) pr_t0 = __builtin_amdgcn_s_memrealtime(); if ((k) == PROBE_K + 1) pr_t1 = __builtin_amdgcn_s_memrealtime(); } } while (0)
    PSTAMP(0);
    if (IN(0)) { p0_prologue(F); SEAM(0); }
    PSTAMP(1);
    if (IN(1)) {
        const int ngemm = (P1_XWG > 0 && (int)F.G > P1_XWG) ? (int)F.G - P1_XWG : (int)F.G;
        if ((int)blockIdx.x < ngemm) { pg8::DenseSched S; S.init(F.h(), F.Win_t(), NTOK, INW, ngemm, (int)blockIdx.x);
            pg8::EpiG1 E{F.positions, F.q(), F.k(), F.v(), F.xr(), F.yg(), F.ratio(), F.gls()};
            pg8::gemm_phase<pg8::EpiG1, pg8::DenseSched, true, 2>(F.lds, S, E); }
        else { for (;;) { const int idx = wg_pull(F, CW_XQ1); if (idx >= XQ_P1) break; xq_item(F, idx); } }
        SEAM(1); }
    PSTAMP(2);
    if (IN(2)) { p2_mixers(F); SEAM(2); }
    PSTAMP(3);
    if (IN(3)) { pg8::DenseSched S; S.init(F.ao(), F.Wcat_t(), NTOK, DM, F.G, (int)blockIdx.x);
        pg8::EpiMerged E{F.ratio(), F.gls(), F.merged()};
        pg8::gemm_phase<pg8::EpiMerged, pg8::DenseSched, true, 2>(F.lds, S, E); SEAM(3); }
    PSTAMP(4);
    if (IN(4)) { pg8::DenseSched S; S.init(F.merged(), F.Wout_t(), NTOK, DM, F.G, (int)blockIdx.x);
        pg8::EpiD E{F.dmix()};
        pg8::gemm_phase<pg8::EpiD, pg8::DenseSched, true, 2>(F.lds, S, E); SEAM(4); }
    PSTAMP(5);
    if (IN(5)) { p5_router(F); SEAM(5); }
    PSTAMP(6);
    if (IN(6)) { moe_tables(F); constexpr int EB = MOE_FP8 ? 1 : 2;
        pg8::MoeSched<true, EB> S; S.init(F.h2(), F.Wgu_t(), F.slot_tok(), (const volatile LAS int*)(F.MISC + MW_TS), (const volatile LAS int*)(F.MISC + MW_CNT), 8, F.G, (int)blockIdx.x);
        pg8::EpiAct E{F.b_gu, F.act(), MOE_FP8 ? W8_INV : 1.0f};
        pg8::gemm_phase<pg8::EpiAct, pg8::MoeSched<true, EB>, true, EB>(F.lds, S, E); SEAM(6); }
    PSTAMP(7);
    if (IN(7)) { moe_tables(F); constexpr int EB = MOE_FP8 ? 1 : 2;
        pg8::MoeSched<false, EB> S; S.init(F.act(), F.Wd_t(), F.slot_tok(), (const volatile LAS int*)(F.MISC + MW_TS), (const volatile LAS int*)(F.MISC + MW_CNT), 4, F.G, (int)blockIdx.x);
#ifndef KREP7
#define KREP7 1
#endif
        pg8::EpiY E{F.b_down, F.y(), (MOE_FP8 ? W8_INV : 1.0f) / KREP7};
        pg8::gemm_phase<pg8::EpiY, pg8::MoeSched<false, EB>, true, EB, KREP7>(F.lds, S, E); SEAM(7); }
    PSTAMP(8);
    if (IN(8)) { moe_tables(F); p8_final(F); }
    PSTAMP(9);
    if (PROBE_K >= 0 && blockIdx.x == 0 && F.tid == 0) { const unsigned long long d = pr_t1 - pr_t0, te = __builtin_amdgcn_s_memrealtime(); while (__builtin_amdgcn_s_memrealtime() - te < d) __builtin_amdgcn_s_sleep(8); }
#undef IN
#undef SEAM
}

#ifndef OPT_MASK
#define OPT_MASK 0x1FF
#define FORCE_MULTI 0
#endif
extern "C" void kernel_launch(void* const* d_in, const int* in_sizes, int n_in, void* d_out, int out_size, void* d_ws, size_t ws_size, hipStream_t stream) {
    if (n_in != 23 || ws_size < WS_END) { fprintf(stderr, "kernel_launch: unexpected inputs (%d) or workspace (%zu)\n", n_in, ws_size); return; }
    static int grid = 0;
    if (grid == 0) {
        int dev = 0, cus = 0;
        if (hipGetDevice(&dev) != hipSuccess || hipDeviceGetAttribute(&cus, hipDeviceAttributeMultiprocessorCount, dev) != hipSuccess) { grid = -1; return; }
        if (hipFuncSetAttribute((const void*)mega_fwd, hipFuncAttributeMaxDynamicSharedMemorySize, LDS_BYTES) != hipSuccess) { fprintf(stderr, "kernel_launch: hipFuncSetAttribute failed\n"); grid = -1; return; }
        int per_cu = 0; (void)hipOccupancyMaxActiveBlocksPerMultiprocessor(&per_cu, (const void*)mega_fwd, NWAVES * 64, LDS_BYTES); (void)hipGetLastError();
        grid = 256; if (cus != 256 || per_cu < 1) fprintf(stderr, "kernel_launch: note: %d CUs, occupancy %d\n", cus, per_cu);
    }
    if (grid < 0) return;
    const float* x = (const float*)d_in[0]; const int* positions = (const int*)d_in[1]; const float* norm_mix_g = (const float*)d_in[2]; const float* w_in = (const float*)d_in[3];
    const float* conv_w = (const float*)d_in[4]; const float* conv_b = (const float*)d_in[5]; const float* w_rg = (const float*)d_in[6]; const float* b_rg = (const float*)d_in[7];
    const float* w_ig = (const float*)d_in[8]; const float* b_ig = (const float*)d_in[9]; const float* lam = (const float*)d_in[10]; const float* sinks = (const float*)d_in[11];
    const float* w_attn_o = (const float*)d_in[12]; const float* w_lru_o = (const float*)d_in[13]; const float* w_out = (const float*)d_in[14]; const float* norm_ffn_g = (const float*)d_in[15];
    const float* w_router = (const float*)d_in[16]; const float* b_router = (const float*)d_in[17]; const float* w_gu = (const float*)d_in[18]; const float* b_gu = (const float*)d_in[19];
    const float* w_down = (const float*)d_in[20]; const float* b_down = (const float*)d_in[21]; const float* norm_final_g = (const float*)d_in[22];
    unsigned char* ws = (unsigned char*)d_ws; float* out = (float*)d_out;
    unsigned* ctl = (unsigned*)(ws + WS_CTL);
    bf16_t* Win_t = (bf16_t*)(ws + WS_WIN); bf16_t* Wcat_t = (bf16_t*)(ws + WS_WCAT); bf16_t* Wout_t = (bf16_t*)(ws + WS_WOUT); bf16_t* Wgu_t = (bf16_t*)(ws + WS_WGU); bf16_t* Wd_t = (bf16_t*)(ws + WS_WD);
    bf16_t* Wrg_t = (bf16_t*)(ws + WS_WRG); bf16_t* Wig_t = (bf16_t*)(ws + WS_WIG);
    float* x1 = (float*)(ws + WS_X1); bf16_t* h2 = (bf16_t*)(ws + WS_H2); bf16_t* act = (bf16_t*)(ws + WS_ACT); bf16_t* y = (bf16_t*)(ws + WS_Y);
    bf16_t* h = (bf16_t*)(ws + WS_H); bf16_t* q = (bf16_t*)(ws + WS_Q); bf16_t* k = (bf16_t*)(ws + WS_K); bf16_t* v = (bf16_t*)(ws + WS_V); bf16_t* xr = (bf16_t*)(ws + WS_XR); bf16_t* yg = (bf16_t*)(ws + WS_YG);
    bf16_t* ratio = (bf16_t*)(ws + WS_RATIO); bf16_t* gls = (bf16_t*)(ws + WS_GLS); bf16_t* ao = (bf16_t*)(ws + WS_AO); bf16_t* merged = (bf16_t*)(ws + WS_MERGED); float* xc = (float*)(ws + WS_XC);
    int* tok_e = (int*)(ws + WS_TOKE); float* tok_w = (float*)(ws + WS_TOKW); int* tok_p = (int*)(ws + WS_TOKP); int* slot_tok = (int*)(ws + WS_SLOT); float* logits = (float*)(ws + WS_LOGIT); float* rstd = (float*)(ws + WS_RSTD);

    (void)hipMemsetAsync(ws + WS_CTL, 0, CTL_BYTES, stream);
    Args a{};
    for (int i = 0; i < 23; ++i) a.in[i] = d_in[i];
    a.out = out; a.ws = ws;
#ifndef FORCE_MULTI
#define FORCE_MULTI 0
#endif
    if (OPT_MASK == 0x1FF && !FORCE_MULTI) { a.ph_lo = 0; a.ph_hi = NPHASE; hipLaunchKernelGGL(mega_fwd, dim3(grid), dim3(NWAVES * 64), LDS_BYTES, stream, a); return; }
    const int G = 2048, B = 256;
    for (int ph = 0; ph < NPHASE; ++ph) {
        if ((OPT_MASK >> ph) & 1) { a.ph_lo = ph; a.ph_hi = ph + 1; hipLaunchKernelGGL(mega_fwd, dim3(grid), dim3(NWAVES * 64), LDS_BYTES, stream, a); continue; }
        switch (ph) {
        case 0:
            nv_transpose<<<G, B, 0, stream>>>(w_in, DM, INW, Win_t, DM, 0, INW, 1, 1);
            nv_transpose<<<G, B, 0, stream>>>(w_attn_o, 512, DM, Wcat_t, DM, 0, DM, 0, 1);
            nv_transpose<<<G, B, 0, stream>>>(w_lru_o, 512, DM, Wcat_t, DM, 512, DM, 0, 1);
            nv_transpose<<<G, B, 0, stream>>>(w_out, DM, DM, Wout_t, DM, 0, DM, 0, 1);
            nv_transpose<<<G, B, 0, stream>>>(w_gu, DM, 2048, Wgu_t, DM, 0, 2048, 2, NE);
            nv_transpose<<<G, B, 0, stream>>>(w_down, DE, DM, Wd_t, DE, 0, DM, 0, NE);
            nv_transpose<<<G, B, 0, stream>>>(w_rg, 64, 64, Wrg_t, 64, 0, 64, 0, LH);
            nv_transpose<<<G, B, 0, stream>>>(w_ig, 64, 64, Wig_t, 64, 0, 64, 0, LH);
            nv_rmsnorm_bf16<<<G, B, 0, stream>>>(x, norm_mix_g, h, nullptr); break;
        case 1: nv_gemm1<<<G * 4, B, 0, stream>>>(h, Win_t, positions, q, k, v, xr, yg, ratio, gls); break;
        case 2:
            nv_attn<<<G, B, 0, stream>>>(q, k, v, sinks, ao);
            nv_conv<<<G, B, 0, stream>>>(xr, conv_w, conv_b, xc);
            nv_scan<<<NB * LW / 64, 64, 0, stream>>>(xc, w_rg, b_rg, w_ig, b_ig, lam, yg, ao); break;
        case 3: nv_merged<<<G * 4, B, 0, stream>>>(ao, Wcat_t, ratio, gls, merged); break;
        case 4: nv_wout<<<G * 4, B, 0, stream>>>(merged, Wout_t, x, x1); break;
        case 5:
            nv_rmsnorm_bf16<<<G, B, 0, stream>>>(x1, norm_ffn_g, h2, rstd);
            nv_logits<<<G, B, 0, stream>>>(x1, rstd, norm_ffn_g, w_router, b_router, logits);
            nv_topk<<<NTOK / 256, 256, 0, stream>>>(logits, ctl, tok_e, tok_w, tok_p, slot_tok); break;
        case 6: nv_moe1<<<G * 4, B, 0, stream>>>(ctl, slot_tok, h2, Wgu_t, b_gu, act); break;
        case 7: nv_moe2<<<G * 4, B, 0, stream>>>(ctl, act, Wd_t, b_down, y); break;
        case 8: nv_final<<<G, B, 0, stream>>>(ctl, x1, tok_e, tok_w, tok_p, y, norm_final_g, out); break;
        }
    }
}
```
